# Optimizing an MI355X kernel written in HIP

```python
import math
import jax, jax.numpy as jnp
from jax import lax
import numpy as np

D_MODEL = 1024
BATCH = 2
SEQ = 16384
DEPTH = 4

DN_ALPHA = (2.0 * DEPTH) ** 0.25
DN_BETA = (8.0 * DEPTH) ** -0.25
LN_EPS = 1e-5
RMS_EPS = 1e-6
ROPE_THETA = 10000.0
QBLK = 128
ADA_SCALE = 0.2
MLA_HEADS = 8
MLA_NOPE = 64
MLA_ROPE = 32
MLA_V = 64
MLA_Q_RANK = 3 * D_MODEL // 8
MLA_KV_RANK = D_MODEL // 4
SWA_HEADS = 8
SWA_KV_HEADS = 2
SWA_HD = 64
SWA_WINDOW = 128
RET_HEADS = 4
RET_DK = 128
RET_DV = 128
RET_CHUNK = 128
S5_WIDTH = D_MODEL // 2
S5_GROUP = 16
S5_GROUPS = S5_WIDTH // S5_GROUP
S5_STATE = 64
D_FF = 4 * D_MODEL
N_EVEN = (DEPTH + 1) // 2
N_ODD = DEPTH // 2
ATT_IN = MLA_Q_RANK + MLA_KV_RANK + MLA_ROPE + SWA_HEADS * SWA_HD + 2 * SWA_KV_HEADS * SWA_HD
ATT_OUT = MLA_HEADS * MLA_V + SWA_HEADS * SWA_HD
REC_IN = RET_HEADS * (2 * RET_DK + 2 * RET_DV) + S5_WIDTH
REC_OUT = RET_HEADS * RET_DV + S5_WIDTH

kernel_name = 'hybrid_mla_swa_retention_s5_deepnorm_adaln'


def layer_norm(x, g, b):
    xf = x.astype(jnp.float32)
    mu = jnp.mean(xf, axis=-1, keepdims=True)
    var = jnp.mean(jnp.square(xf - mu), axis=-1, keepdims=True)
    return ((xf - mu) * lax.rsqrt(var + LN_EPS)).astype(x.dtype) * g + b


def rms_norm(x, g):
    xf = x.astype(jnp.float32)
    return (xf * lax.rsqrt(jnp.mean(xf * xf, axis=-1, keepdims=True) + RMS_EPS)).astype(x.dtype) * g


def rope_tables(seq, dim):
    inv = ROPE_THETA ** (-jnp.arange(0, dim, 2, dtype=jnp.float32) / dim)
    ang = jnp.arange(seq, dtype=jnp.float32)[:, None] * inv[None, :]
    return jnp.cos(ang), jnp.sin(ang)


def apply_rope(x, cos, sin):
    x1, x2 = jnp.split(x, 2, axis=-1)
    out = jnp.concatenate([x1 * cos - x2 * sin, x2 * cos + x1 * sin], axis=-1)
    return out.astype(x.dtype)


def adaln(cond, w, b):
    mod = (cond @ w + b)[:, None, :]
    return jnp.split(mod, 3, axis=-1)


def mla_attention(c_q, c_kv, k_rope_in, q_norm, w_uq, kv_norm, w_ukv, cos, sin):
    B, S, _ = c_q.shape
    H = MLA_HEADS
    q = (rms_norm(c_q, q_norm) @ w_uq).reshape(B, S, H, MLA_NOPE + MLA_ROPE)
    q_nope = q[..., :MLA_NOPE]
    q_rope = apply_rope(q[..., MLA_NOPE:], cos[:, None], sin[:, None])
    kv = (rms_norm(c_kv, kv_norm) @ w_ukv).reshape(B, S, H, MLA_NOPE + MLA_V)
    k_nope, v = kv[..., :MLA_NOPE], kv[..., MLA_NOPE:]
    k_rope = apply_rope(k_rope_in, cos, sin)
    scale = (MLA_NOPE + MLA_ROPE) ** -0.5
    nq = S // QBLK
    qn_blk = q_nope.reshape(B, nq, QBLK, H, MLA_NOPE).transpose(1, 0, 2, 3, 4)
    qr_blk = q_rope.reshape(B, nq, QBLK, H, MLA_ROPE).transpose(1, 0, 2, 3, 4)
    kpos = jnp.arange(S)

    def block(args):
        qn, qr, i = args
        s = jnp.einsum('bqhd,bkhd->bhqk', qn, k_nope) + jnp.einsum('bqhr,bkr->bhqk', qr, k_rope)
        s = s.astype(jnp.float32) * scale
        qpos = i * QBLK + jnp.arange(QBLK)
        s = jnp.where(kpos[None, :] <= qpos[:, None], s, -jnp.inf)
        p = jax.nn.softmax(s, axis=-1).astype(v.dtype)
        return jnp.einsum('bhqk,bkhe->bqhe', p, v)

    o = lax.map(block, (qn_blk, qr_blk, jnp.arange(nq)))
    return o.transpose(1, 0, 2, 3, 4).reshape(B, S, H * MLA_V)


def swa_attention(q, k, v, sinks, cos, sin):
    B, S, _ = q.shape
    KV, HD, W = SWA_KV_HEADS, SWA_HD, SWA_WINDOW
    G = SWA_HEADS // KV
    q = apply_rope(q.reshape(B, S, KV, G, HD), cos[:, None, None], sin[:, None, None])
    k = apply_rope(k.reshape(B, S, KV, HD), cos[:, None], sin[:, None])
    v = v.reshape(B, S, KV, HD)
    nb = S // W
    qb = q.reshape(B, nb, W, KV, G, HD)
    kb = k.reshape(B, nb, W, KV, HD)
    vb = v.reshape(B, nb, W, KV, HD)
    shift = lambda t: jnp.concatenate([jnp.zeros_like(t[:, :1]), t[:, :-1]], axis=1)
    kc = jnp.concatenate([shift(kb), kb], axis=2)
    vc = jnp.concatenate([shift(vb), vb], axis=2)
    s = jnp.einsum('bnqhgd,bnshd->bnhgqs', qb, kc).astype(jnp.float32) * HD ** -0.5
    i = jnp.arange(W)[:, None]
    j = jnp.arange(2 * W)[None, :]
    band = (j > i) & (j <= i + W)
    blk = jnp.arange(nb)[:, None, None]
    valid = band[None] & ((blk > 0) | (j[None] >= W))
    s = jnp.where(valid[None, :, None, None], s, -jnp.inf)
    sink = sinks.astype(jnp.float32).reshape(KV, G)[None, None, :, :, None, None]
    m = jnp.maximum(jnp.max(s, axis=-1, keepdims=True), sink)
    p = jnp.exp(s - m)
    p = (p / (jnp.sum(p, axis=-1, keepdims=True) + jnp.exp(sink - m))).astype(v.dtype)
    o = jnp.einsum('bnhgqs,bnshd->bnqhgd', p, vc)
    return o.reshape(B, S, SWA_HEADS * HD)


def retention(q, k, v, g, cos, sin):
    B, S, _ = q.shape
    H, DK, DV, C = RET_HEADS, RET_DK, RET_DV, RET_CHUNK
    q = apply_rope(q.reshape(B, S, H, DK), cos[:, None], sin[:, None]).astype(jnp.float32)
    k = apply_rope(k.reshape(B, S, H, DK), cos[:, None], sin[:, None]).astype(jnp.float32) * DK ** -0.5
    v = v.reshape(B, S, H, DV).astype(jnp.float32)
    nc = S // C
    log_gamma = jnp.log(1.0 - 2.0 ** (-5.0 - jnp.arange(H, dtype=jnp.float32)))
    idx = jnp.arange(C, dtype=jnp.float32)
    diff = idx[:, None] - idx[None, :]
    decay = jnp.where(diff >= 0, jnp.exp(log_gamma[:, None, None] * jnp.maximum(diff, 0.0)), 0.0)
    qc = q.reshape(B, nc, C, H, DK)
    kc = k.reshape(B, nc, C, H, DK)
    vc = v.reshape(B, nc, C, H, DV)
    sc = jnp.einsum('bnihd,bnjhd->bnhij', qc, kc) * decay[None, None]
    intra = jnp.einsum('bnhij,bnjhe->bnihe', sc, vc)
    to_end = jnp.exp(log_gamma[:, None] * (C - 1.0 - idx)[None, :])
    kd = kc * to_end.T[None, None, :, :, None]
    U = jnp.einsum('bnjhd,bnjhe->nbhde', kd, vc)
    chunk_decay = jnp.exp(log_gamma * C)[None, :, None, None]

    def step(state, u):
        return chunk_decay * state + u, state

    _, s_prev = lax.scan(step, jnp.zeros((B, H, DK, DV), jnp.float32), U)
    from_start = jnp.exp((idx + 1.0)[:, None] * log_gamma[None, :])
    cross = jnp.einsum('bnihd,nbhde->bnihe', qc, s_prev) * from_start[None, None, :, :, None]
    o = (intra + cross).reshape(B, S, H, DV)
    mu = jnp.mean(o, axis=-1, keepdims=True)
    var = jnp.mean(jnp.square(o - mu), axis=-1, keepdims=True)
    o = ((o - mu) * lax.rsqrt(var + LN_EPS)).reshape(B, S, H * DV)
    return (jax.nn.silu(g.astype(jnp.float32)) * o).astype(g.dtype)


def s5_layer(u, a_re, a_im, log_step, b_re, b_im, c_re, c_im, d, glu_w, glu_b):
    B, S, W = u.shape
    G, P, N = S5_GROUPS, S5_GROUP, S5_STATE
    uf = u.astype(jnp.float32).reshape(B, S, G, P)
    dt = jnp.exp(log_step.astype(jnp.float32))[:, None]
    lr, li = a_re.astype(jnp.float32), a_im.astype(jnp.float32)
    mag = jnp.exp(lr * dt)
    ar, ai = mag * jnp.cos(li * dt), mag * jnp.sin(li * dt)
    den = lr * lr + li * li
    cr = ((ar - 1.0) * lr + ai * li) / den
    ci = (ai * lr - (ar - 1.0) * li) / den
    br, bi = b_re.astype(jnp.float32), b_im.astype(jnp.float32)
    bbar_r = cr[..., None] * br - ci[..., None] * bi
    bbar_i = cr[..., None] * bi + ci[..., None] * br
    bu_r = jnp.einsum('bsgp,gnp->bsgn', uf, bbar_r)
    bu_i = jnp.einsum('bsgp,gnp->bsgn', uf, bbar_i)
    a_r = jnp.broadcast_to(ar, (1, S, G, N))
    a_i = jnp.broadcast_to(ai, (1, S, G, N))

    def combine(e1, e2):
        a1r, a1i, b1r, b1i = e1
        a2r, a2i, b2r, b2i = e2
        return (a2r * a1r - a2i * a1i, a2r * a1i + a2i * a1r,
                a2r * b1r - a2i * b1i + b2r, a2r * b1i + a2i * b1r + b2i)

    _, _, xr, xi = lax.associative_scan(combine, (a_r, a_i, bu_r, bu_i), axis=1)
    y = (jnp.einsum('bsgn,gpn->bsgp', xr, c_re.astype(jnp.float32))
         - jnp.einsum('bsgn,gpn->bsgp', xi, c_im.astype(jnp.float32)))
    y = (y.reshape(B, S, W) + d * uf.reshape(B, S, W)).astype(u.dtype)
    y = jax.nn.gelu(y)
    return y * jax.nn.sigmoid(y @ glu_w + glu_b)


def attention_mixer(h, w_in, q_norm, w_uq, kv_norm, w_ukv, sinks, w_out, rope_mla, rope_swa):
    z = h @ w_in
    sizes = [MLA_Q_RANK, MLA_KV_RANK, MLA_ROPE, SWA_HEADS * SWA_HD, SWA_KV_HEADS * SWA_HD]
    c_q, c_kv, k_rope, sq, sk, sv = jnp.split(z, np.cumsum(sizes).tolist(), axis=-1)
    o_a = mla_attention(c_q, c_kv, k_rope, q_norm, w_uq, kv_norm, w_ukv, *rope_mla)
    o_b = swa_attention(sq, sk, sv, sinks, *rope_swa)
    return jnp.concatenate([o_a, o_b], axis=-1) @ w_out


def recurrent_mixer(h, w_in, a_re, a_im, log_step, b_re, b_im, c_re, c_im, d, glu_w, glu_b, w_out, rope_ret):
    z = h @ w_in
    sizes = [RET_HEADS * RET_DK, RET_HEADS * RET_DK, RET_HEADS * RET_DV, RET_HEADS * RET_DV]
    rq, rk, rv, rg, u = jnp.split(z, np.cumsum(sizes).tolist(), axis=-1)
    o_c = retention(rq, rk, rv, rg, *rope_ret)
    o_d = s5_layer(u, a_re, a_im, log_step, b_re, b_im, c_re, c_im, d, glu_w, glu_b)
    return jnp.concatenate([o_c, o_d], axis=-1) @ w_out


def setup_inputs(seed: int = 0) -> dict:
    key = jax.random.key(seed)
    ks = iter(jax.random.split(key, 32))
    f32 = jnp.float32
    nrm = lambda shape, scale: jax.random.normal(next(ks), shape, f32) * scale
    G, P, N = S5_GROUPS, S5_GROUP, S5_STATE
    return {
        'x': nrm((BATCH, SEQ, D_MODEL), 1.0),
        'c': nrm((BATCH, D_MODEL), 1.0),
        'ada_w': nrm((DEPTH, 2, D_MODEL, 3 * D_MODEL), ADA_SCALE * D_MODEL ** -0.5),
        'ada_b': nrm((DEPTH, 2, 3 * D_MODEL), 0.01),
        'ln_g': 1.0 + nrm((DEPTH, 2, D_MODEL), 0.02),
        'ln_b': nrm((DEPTH, 2, D_MODEL), 0.02),
        'att_w_in': nrm((N_EVEN, D_MODEL, ATT_IN), D_MODEL ** -0.5),
        'mla_q_norm': 1.0 + nrm((N_EVEN, MLA_Q_RANK), 0.02),
        'mla_w_uq': nrm((N_EVEN, MLA_Q_RANK, MLA_HEADS * (MLA_NOPE + MLA_ROPE)), MLA_Q_RANK ** -0.5),
        'mla_kv_norm': 1.0 + nrm((N_EVEN, MLA_KV_RANK), 0.02),
        'mla_w_ukv': nrm((N_EVEN, MLA_KV_RANK, MLA_HEADS * (MLA_NOPE + MLA_V)), MLA_KV_RANK ** -0.5),
        'swa_sinks': nrm((N_EVEN, SWA_HEADS), 0.5),
        'att_w_out': nrm((N_EVEN, ATT_OUT, D_MODEL), DN_BETA * ATT_OUT ** -0.5),
        'rec_w_in': nrm((N_ODD, D_MODEL, REC_IN), D_MODEL ** -0.5),
        's5_a_re': -0.5 + nrm((N_ODD, G, N), 0.01),
        's5_a_im': jnp.pi * jnp.arange(N, dtype=f32)[None, None, :] + nrm((N_ODD, G, N), 0.01),
        's5_log_step': jax.random.uniform(next(ks), (N_ODD, G), f32, math.log(1e-3), math.log(1e-1)),
        's5_b_re': nrm((N_ODD, G, N, P), (2.0 * P) ** -0.5),
        's5_b_im': nrm((N_ODD, G, N, P), (2.0 * P) ** -0.5),
        's5_c_re': nrm((N_ODD, G, P, N), N ** -0.5),
        's5_c_im': nrm((N_ODD, G, P, N), N ** -0.5),
        's5_d': nrm((N_ODD, S5_WIDTH), 1.0),
        's5_glu_w': nrm((N_ODD, S5_WIDTH, S5_WIDTH), S5_WIDTH ** -0.5),
        's5_glu_b': nrm((N_ODD, S5_WIDTH), 0.01),
        'rec_w_out': nrm((N_ODD, REC_OUT, D_MODEL), DN_BETA * REC_OUT ** -0.5),
        'mlp_w1': nrm((DEPTH, D_MODEL, D_FF), D_MODEL ** -0.5),
        'mlp_w2': nrm((DEPTH, D_FF, D_MODEL), DN_BETA * D_FF ** -0.5),
    }


def reference(x, c, ada_w, ada_b, ln_g, ln_b, att_w_in, mla_q_norm, mla_w_uq, mla_kv_norm, mla_w_ukv,
              swa_sinks, att_w_out, rec_w_in, s5_a_re, s5_a_im, s5_log_step, s5_b_re, s5_b_im,
              s5_c_re, s5_c_im, s5_d, s5_glu_w, s5_glu_b, rec_w_out, mlp_w1, mlp_w2):
    S = x.shape[1]
    cond = jax.nn.silu(c)
    rope_mla = rope_tables(S, MLA_ROPE)
    rope_swa = rope_tables(S, SWA_HD)
    rope_ret = rope_tables(S, RET_DK)
    for l in range(DEPTH):
        j = l // 2
        shift, scale, gate = adaln(cond, ada_w[l, 0], ada_b[l, 0])
        h = x * (1.0 + scale) + shift
        if l % 2 == 0:
            y = attention_mixer(h, att_w_in[j], mla_q_norm[j], mla_w_uq[j], mla_kv_norm[j], mla_w_ukv[j],
                                swa_sinks[j], att_w_out[j], rope_mla, rope_swa)
        else:
            y = recurrent_mixer(h, rec_w_in[j], s5_a_re[j], s5_a_im[j], s5_log_step[j], s5_b_re[j],
                                s5_b_im[j], s5_c_re[j], s5_c_im[j], s5_d[j], s5_glu_w[j], s5_glu_b[j],
                                rec_w_out[j], rope_ret)
        x = layer_norm(DN_ALPHA * x + (1.0 + gate) * y, ln_g[l, 0], ln_b[l, 0])
        shift, scale, gate = adaln(cond, ada_w[l, 1], ada_b[l, 1])
        h = x * (1.0 + scale) + shift
        y = jnp.square(jax.nn.relu(h @ mlp_w1[l])) @ mlp_w2[l]
        x = layer_norm(DN_ALPHA * x + (1.0 + gate) * y, ln_g[l, 1], ln_b[l, 1])
    return x
```

```cpp
#include <hip/hip_runtime.h>
#include <hip/hip_cooperative_groups.h>
#include <cstdio>
namespace cg = cooperative_groups;

typedef unsigned short u16;
using bf16x8 = __attribute__((ext_vector_type(8))) short;
using f32x16 = __attribute__((ext_vector_type(16))) float;
using u32x4 = __attribute__((ext_vector_type(4))) unsigned;
typedef __attribute__((address_space(3))) unsigned lds_u32;
using f32x4 = __attribute__((ext_vector_type(4))) float;
#define DI __device__ __forceinline__
#define MFMA(a, b, c) __builtin_amdgcn_mfma_f32_32x32x16_bf16((a), (b), (c), 0, 0, 0)

constexpr int T_ = 32768, S_ = 16384;
constexpr float LOG2E = 1.4426950408889634f;
constexpr float DN_ALPHA = 1.6817928305074290f;
constexpr float MLA_QSCALE = 0.10206207261596575f * LOG2E;
constexpr float SWA_QSCALE = 0.125f * LOG2E;
constexpr float RET_KSCALE = 0.08838834764831845f;
constexpr int LDH = 1088, LDHID = 4160, LDW1 = 1088, LDW2 = 4160, LDV = S_ + 64, LDKB = 832, LDZR = 2112, LDYT = 576, LDGLU = 576;

constexpr size_t OFF_MOD = 0;
constexpr size_t OFF_CTR = OFF_MOD + 8 * 2 * 3072 * 4;
constexpr size_t OFF_BAR = OFF_CTR + 256;
constexpr size_t OFF_RT32 = OFF_BAR + 16384;
constexpr size_t OFF_RT64 = OFF_RT32 + (size_t)S_ * 16 * 8;
constexpr size_t OFF_RT128 = OFF_RT64 + (size_t)S_ * 32 * 8;
constexpr size_t OFF_S5Z = OFF_RT128 + (size_t)S_ * 64 * 8;
constexpr size_t OFF_BBAR = OFF_S5Z + 2 * 32 * 64 * 16;
constexpr size_t OFF_KTAB = OFF_BBAR + 2 * 32 * 64 * 16 * 8;
constexpr size_t OFF_W_ATTIN = OFF_KTAB + 2 * 32 * 32 * 256 * 4;
constexpr size_t OFF_W_UQ = OFF_W_ATTIN + (size_t)2 * 1536 * LDW1 * 2;
constexpr size_t OFF_W_UKV = OFF_W_UQ + (size_t)2 * 768 * 384 * 2;
constexpr size_t OFF_W_ATTOUT = OFF_W_UKV + (size_t)2 * 1024 * 256 * 2;
constexpr size_t OFF_W_RECIN = OFF_W_ATTOUT + (size_t)2 * 1024 * LDW1 * 2;
constexpr size_t OFF_W_GLU = OFF_W_RECIN + (size_t)2 * 2560 * LDW1 * 2;
constexpr size_t OFF_W_RECOUT = OFF_W_GLU + (size_t)2 * 512 * LDGLU * 2;
constexpr size_t OFF_W1 = OFF_W_RECOUT + (size_t)2 * 1024 * LDW1 * 2;
constexpr size_t OFF_W2 = OFF_W1 + (size_t)4 * 4096 * LDW1 * 2;
constexpr size_t OFF_WE = OFF_W2 + (size_t)4 * 1024 * LDW2 * 2;
constexpr size_t OFF_WY = OFF_WE + (size_t)32 * 256 * 512 * 2;
constexpr size_t OFF_HY = OFF_WY + (size_t)32 * 512 * 640 * 2;
constexpr size_t OFF_RA = OFF_HY + (size_t)T_ * LDH * 2;
constexpr size_t OFF_ZC = OFF_RA;
constexpr size_t OFF_QB = OFF_ZC + (size_t)T_ * 640 * 2;
constexpr size_t OFF_KB = OFF_QB + (size_t)T_ * 768 * 2;
constexpr size_t OFF_VT = OFF_KB + (size_t)T_ * LDKB * 2;
constexpr size_t OFF_SQ = OFF_VT + (size_t)2 * 8 * 64 * LDV * 2;
constexpr size_t OFF_SK = OFF_SQ + (size_t)T_ * 512 * 2;
constexpr size_t OFF_SV = OFF_SK + (size_t)T_ * 128 * 2;
constexpr size_t OFF_OE = OFF_SV + (size_t)T_ * 128 * 2;
constexpr size_t END_EVEN = OFF_OE + (size_t)T_ * LDH * 2;
constexpr size_t OFF_ZR = OFF_RA;
constexpr size_t OFF_UG = OFF_ZR + (size_t)T_ * LDZR * 2;
constexpr size_t OFF_UO = OFF_UG + (size_t)T_ * 512 * 2;
constexpr size_t OFF_SP = OFF_UO + (size_t)T_ * LDH * 2;
constexpr size_t OFF_EB = OFF_SP + (size_t)T_ * 512 * 2;
constexpr size_t OFF_XP = OFF_EB + (size_t)32 * 1024 * 128 * 4;
constexpr size_t OFF_YT = OFF_HY;
constexpr size_t END_ODD = OFF_XP + (size_t)32 * 1024 * 128 * 2;
constexpr size_t OFF_HID = OFF_RA;
constexpr size_t END_MLP = OFF_HID + (size_t)T_ * LDHID * 2;
constexpr size_t WS_NEED = END_ODD > END_EVEN ? (END_ODD > END_MLP ? END_ODD : END_MLP) : (END_EVEN > END_MLP ? END_EVEN : END_MLP);

constexpr int NTHR = 512;
constexpr int HALF_SMEM = 73728 + 1024;
constexpr int SMEM_GEMM = 131072;
constexpr int SMEM_BYTES = 2 * HALF_SMEM;
constexpr int NPHASE = 38;

struct Params {
  const float *x, *c, *ada_w, *ada_b, *ln_g, *ln_b, *att_w_in, *mla_q_norm, *mla_w_uq, *mla_kv_norm, *mla_w_ukv,
      *swa_sinks, *att_w_out, *rec_w_in, *s5_a_re, *s5_a_im, *s5_log_step, *s5_b_re, *s5_b_im, *s5_c_re, *s5_c_im,
      *s5_d, *s5_glu_w, *s5_glu_b, *rec_w_out, *mlp_w1, *mlp_w2;
  float* out;
  char* ws;
};

#define XB_TMO      128
#define XB_XCNT(j)  (256  + 64 * (j))
#define XB_XSUB(j)  (1280 + 64 * (j))
#define XB_XGEN(j)  (2304 + 64 * (j))
#define XB_TOP      3328
#define XB_TOPGEN   3392
#define XCD_BAR_WORDS 3456
#define XB_SPIN_CAP (1u << 18)
#define LAS __attribute__((address_space(3)))

__device__ __forceinline__ unsigned xb_ld(unsigned* p)              { return __hip_atomic_load(p, __ATOMIC_RELAXED, __HIP_MEMORY_SCOPE_AGENT); }
__device__ __forceinline__ unsigned xb_add(unsigned* p, unsigned v) { return __hip_atomic_fetch_add(p, v, __ATOMIC_RELAXED, __HIP_MEMORY_SCOPE_AGENT); }
__device__ __forceinline__ unsigned xb_xcc_id() { return (unsigned)__builtin_amdgcn_s_getreg((3 << 11) | 20) & 0xFu; }
#define XB_SPIN(cond, bar) do { unsigned _sp = 0; while (cond) { __builtin_amdgcn_s_sleep(1); \
    if ((++_sp & 255u) == 0u) { if (xb_ld(&(bar)[XB_TMO])) break; if (_sp > XB_SPIN_CAP) { atomicAdd(&(bar)[XB_TMO], 1u); break; } } } } while (0)

struct XcdBarrier {
    unsigned* bar; unsigned x;
    volatile LAS unsigned* st;
};

__device__ __forceinline__ XcdBarrier xcd_barrier_post(unsigned* bar, volatile LAS unsigned* st) {
    XcdBarrier b; b.bar = bar; b.x = xb_xcc_id(); b.st = st;
    if (threadIdx.x == 0) (void)xb_add(&bar[XB_XCNT(b.x)], 1u);
    return b;
}
__device__ __forceinline__ void xcd_barrier_complete(unsigned* bar, unsigned x, unsigned& nloc, unsigned& nx) {
    const unsigned G = gridDim.x * gridDim.y * gridDim.z;
    unsigned sum, cnt, mine, sp = 0u;
    for (;;) {
        sum = 0u; cnt = 0u; mine = 0u;
#pragma unroll
        for (unsigned j = 0; j < 16; ++j) { const unsigned c = xb_ld(&bar[XB_XCNT(j)]); sum += c; cnt += (c > 0u) ? 1u : 0u; mine = (j == x) ? c : mine; }
        if (sum == G) break;
        __builtin_amdgcn_s_sleep(1);
        if ((++sp & 255u) == 0u) { if (xb_ld(&bar[XB_TMO])) break; if (sp > XB_SPIN_CAP) { atomicAdd(&bar[XB_TMO], 1u); break; } }
    }
    nloc = mine > 0u ? mine : 1u; nx = cnt > 0u ? cnt : 1u;
}

__device__ __forceinline__ void xcd_barrier(const XcdBarrier& b) {
    asm volatile("s_waitcnt vmcnt(0)" ::: "memory");
    __syncthreads();
    if (threadIdx.x == 0) {
        unsigned* bar = b.bar;
        __builtin_amdgcn_s_waitcnt(0);
        unsigned nloc = b.st[0], nx = b.st[1];
        if (nloc == 0u) { xcd_barrier_complete(bar, b.x, nloc, nx); b.st[0] = nloc; b.st[1] = nx; }
        const unsigned old = xb_add(&bar[XB_XSUB(b.x)], 1u);
        const unsigned gen = old / nloc;
        if (old + 1u == (gen + 1u) * nloc) {
            __builtin_amdgcn_fence(__ATOMIC_RELEASE, "agent");
            asm volatile("s_waitcnt vmcnt(0)" ::: "memory");
            const unsigned og = xb_add(&bar[XB_TOP], 1u);
            const unsigned tg = og / nx;
            if (og + 1u == (tg + 1u) * nx) xb_add(&bar[XB_TOPGEN], 1u);
            else XB_SPIN(xb_ld(&bar[XB_TOPGEN]) == tg, bar);
            __builtin_amdgcn_fence(__ATOMIC_ACQUIRE, "agent");
            xb_add(&bar[XB_XGEN(b.x)], 1u);
            asm volatile("s_waitcnt vmcnt(0)" ::: "memory");
        } else {
            XB_SPIN(xb_ld(&bar[XB_XGEN(b.x)]) == gen, bar);
            __builtin_amdgcn_fence(__ATOMIC_ACQUIRE, "agent");
            asm volatile("s_waitcnt vmcnt(0)" ::: "memory");
        }
    }
    __syncthreads();
}


typedef __bf16 bf2_t __attribute__((ext_vector_type(2)));
typedef float f2_t __attribute__((ext_vector_type(2)));
DI u16 f2bf(float x) { __bf16 r = (__bf16)x; return __builtin_bit_cast(u16, r); }
DI float bf2f(unsigned h) { return __uint_as_float(h << 16); }
DI unsigned pack2(float a, float b) { f2_t v = {a, b}; bf2_t r = __builtin_convertvector(v, bf2_t); return __builtin_bit_cast(unsigned, r); }
DI int crow(int r, int hf) { return (r & 3) + 8 * (r >> 2) + 4 * hf; }
DI float ex2(float x) { return __builtin_amdgcn_exp2f(x); }
DI bf16x8 pack8(const f32x16& x, int s) {
  uint4 u;
  u.x = pack2(x[8 * s + 0], x[8 * s + 1]); u.y = pack2(x[8 * s + 2], x[8 * s + 3]);
  u.z = pack2(x[8 * s + 4], x[8 * s + 5]); u.w = pack2(x[8 * s + 6], x[8 * s + 7]);
  return __builtin_bit_cast(bf16x8, u);
}
DI bf16x8 join8(uint2 lo, uint2 hi) { uint4 u = make_uint4(lo.x, lo.y, hi.x, hi.y); return __builtin_bit_cast(bf16x8, u); }
DI f32x16 zero16() { f32x16 z; for (int i = 0; i < 16; ++i) z[i] = 0.f; return z; }
DI int opqv(int x) { asm volatile("" : "+v"(x)); return x; }
DI char* opq(char* p) { asm volatile("" : "+s"(p)); return p; }
DI void sincos_(float x, float& sn, float& cs) { float s_, c_; sincosf(x, &s_, &c_); sn = s_; cs = c_; }
DI float lg2gamma(int h) { return log2f(1.0f - exp2f(-5.0f - (float)h)); }

template <int V = 0, class Epi>
DI void gemm_tile(const u16* A1, long lda1, int nk1, const u16* A2, long lda2, int nk2, const u16* Bt, long ldb,
                  char* smem, Epi&& epi) {
  const int tid = opqv(threadIdx.x), lane = tid & 63, w = tid >> 6, wm = w >> 2, wn = w & 3, l32 = lane & 31, hf = lane >> 5;
  f32x16 acc[2][2][2];
#pragma unroll
  for (int h = 0; h < 2; ++h)
#pragma unroll
    for (int i = 0; i < 2; ++i)
#pragma unroll
      for (int j = 0; j < 2; ++j) acc[h][i][j] = zero16();
  const int nk = nk1 + nk2;
  const int drow = lane >> 3, dslot = lane & 7, x7 = (l32 >> 1) & 7;
#define GLDS(KT, BUF) { const int kt_ = (KT); const u16* Ab; long lda; \
    if (kt_ < nk1) { Ab = A1 + kt_ * 64; lda = lda1; } else { Ab = A2 + (kt_ - nk1) * 64; lda = lda2; } \
    _Pragma("unroll") for (int q = 0; q < 4; ++q) { \
      const int r = (w * 4 + q) * 8 + drow; const int c = dslot ^ ((r >> 1) & 7); \
      __builtin_amdgcn_global_load_lds((const unsigned*)(Ab + (long)r * lda + c * 8), (lds_u32*)(smem + (BUF) * 65536 + (w * 4 + q) * 1024), 16, 0, 0); \
      __builtin_amdgcn_global_load_lds((const unsigned*)(Bt + (long)r * ldb + kt_ * 64 + c * 8), (lds_u32*)(smem + (BUF) * 65536 + 32768 + (w * 4 + q) * 1024), 16, 0, 0); } }
#define LFR(AF, BF, BUF, S0) { const char* a = smem + (BUF) * 65536; const char* b = a + 32768; \
    _Pragma("unroll") for (int i = 0; i < 4; ++i) AF[i] = *(const bf16x8*)(a + (wm * 128 + i * 32 + l32) * 128 + (((2 * (S0) + hf) ^ x7) << 4)); \
    _Pragma("unroll") for (int j = 0; j < 2; ++j) BF[j] = *(const bf16x8*)(b + (wn * 64 + j * 32 + l32) * 128 + (((2 * (S0) + hf) ^ x7) << 4)); }
#define MMA8(AF, BF) { \
    _Pragma("unroll") for (int i = 0; i < 4; ++i) \
      _Pragma("unroll") for (int j = 0; j < 2; ++j) acc[i >> 1][i & 1][j] = MFMA(AF[i], BF[j], acc[i >> 1][i & 1][j]); }
#define COMPUTE(BUF) { bf16x8 af0[4], bf0[2], af1[4], bf1[2]; \
    LFR(af0, bf0, BUF, 0); __builtin_amdgcn_sched_barrier(0); \
    LFR(af1, bf1, BUF, 1); MMA8(af0, bf0); __builtin_amdgcn_sched_barrier(0); \
    LFR(af0, bf0, BUF, 2); MMA8(af1, bf1); __builtin_amdgcn_sched_barrier(0); \
    LFR(af1, bf1, BUF, 3); MMA8(af0, bf0); __builtin_amdgcn_sched_barrier(0); \
    MMA8(af1, bf1); __builtin_amdgcn_sched_barrier(0); }
#define RAWBAR() { asm volatile("s_waitcnt vmcnt(0) lgkmcnt(0)" ::: "memory"); __builtin_amdgcn_s_barrier(); }
  if (V != 1) GLDS(0, 0);
  RAWBAR();
  for (int kt = 0; kt < nk; kt += 2) {
    if (V != 1) GLDS(kt + 1, 1);
    if (V != 2) COMPUTE(0);
    RAWBAR();
    if (V != 1) if (kt + 2 < nk) GLDS(kt + 2, 0);
    if (V != 2) COMPUTE(1);
    RAWBAR();
  }
#undef GLDS
#undef LFR
#undef MMA8
#undef COMPUTE
#undef RAWBAR
  epi(acc[0], wm * 64);
  epi(acc[1], wm * 64 + 64);
}

DI void tile_map(int lt, int nM8, int nN, int GM, int GN, int& mt, int& nt) {
  const int G = GM * GN, xcd = blockIdx.x & 7, group = lt / G, within = lt - group * G, ngn = nN / GN;
  const int mg = group / ngn, ng = group - mg * ngn;
  mt = xcd * nM8 + mg * GM + within / GN;
  nt = ng * GN + within % GN;
}

DI int colmap(int mode, int n) {
  if (mode == 1) { if (n < 640) return n; if (n < 1408) return n + 32; if (n < 1440) return n - 1408 + 640; return -1; }
  if (mode == 2) { if (n < 512) return (n >> 6) * 96 + (n & 63); int m = n - 512; return (m >> 5) * 96 + 64 + (m & 31); }
  if (mode == 3) { if (n < 1024) { int dl = n & 127, b4 = dl >> 5; int sb = (b4 == 1) ? 2 : (b4 == 2 ? 1 : b4); return (n & ~127) + sb * 32 + (dl & 31); } return n; }
  return n;
}
DI void conv_job(const float* src, int K, int N, u16* dst, int ldk, int Npad, const float* kscale, int mode, float* lds) {
  const int tid = opqv(threadIdx.x);
  const int nKt = K / 64, nNt = Npad / 64;
  for (int tile = blockIdx.x; tile < nKt * nNt; tile += gridDim.x) {
    const int nt = tile / nKt, kt = tile % nKt;
    const int nl = tid & 63, kq = tid >> 6;
    const int col = colmap(mode, nt * 64 + nl);
    for (int i = 0; i < 8; ++i) {
      const int kl = kq + 8 * i, k = kt * 64 + kl;
      float v = 0.f;
      if (col >= 0) { v = src[(size_t)k * N + col]; if (kscale) v *= kscale[k]; }
      lds[kl * 65 + nl] = v;
    }
    __syncthreads();
    for (int i = 0; i < 8; ++i) {
      const int n2 = kq + 8 * i;
      dst[(size_t)(nt * 64 + n2) * ldk + kt * 64 + nl] = f2bf(lds[nl * 65 + n2]);
    }
    __syncthreads();
  }
}

DI void phase0(const Params& p, char* smem) {
  const int tid = opqv(threadIdx.x), nb = gridDim.x, bid = blockIdx.x;
  char* ws = opq(p.ws);
  if (bid == 0 && tid < 64) ((int*)(ws + OFF_CTR))[tid] = 0;
  {
    float* cond = (float*)smem; float* red = cond + 2048; float* mod = (float*)(ws + OFF_MOD);
    for (int i = tid; i < 2048; i += NTHR) { float v = p.c[i]; cond[i] = v / (1.f + expf(-v)); }
    __syncthreads();
    for (int it = bid; it < 8 * 48; it += nb) {
      const int ls = it / 48, cgp = it % 48, tx = tid & 15, ty = tid >> 4;
      const float* wp = p.ada_w + (size_t)ls * 1024 * 3072 + cgp * 64 + tx * 4;
      float4 a0 = make_float4(0, 0, 0, 0), a1 = make_float4(0, 0, 0, 0);
      for (int k = ty * 32; k < ty * 32 + 32; ++k) {
        const float4 wv = *(const float4*)(wp + (size_t)k * 3072);
        const float c0 = cond[k], c1 = cond[1024 + k];
        a0.x += c0 * wv.x; a0.y += c0 * wv.y; a0.z += c0 * wv.z; a0.w += c0 * wv.w;
        a1.x += c1 * wv.x; a1.y += c1 * wv.y; a1.z += c1 * wv.z; a1.w += c1 * wv.w;
      }
      *(float4*)(red + (ty * 2 + 0) * 64 + tx * 4) = a0;
      *(float4*)(red + (ty * 2 + 1) * 64 + tx * 4) = a1;
      __syncthreads();
      if (tid < 128) {
        const int b = tid >> 6, col = tid & 63; float s = 0.f;
        for (int y = 0; y < 32; ++y) s += red[(y * 2 + b) * 64 + col];
        const int j = cgp * 64 + col;
        mod[(ls * 2 + b) * 3072 + j] = s + p.ada_b[ls * 3072 + j];
      }
      __syncthreads();
    }
  }
  {
    float* lds = (float*)smem;
    for (int j = 0; j < 2; ++j) {
      conv_job(p.att_w_in + (size_t)j * 1024 * 1440, 1024, 1440, (u16*)(ws + OFF_W_ATTIN) + (size_t)j * 1536 * LDW1, LDW1, 1536, nullptr, 1, lds);
      conv_job(p.mla_w_uq + (size_t)j * 384 * 768, 384, 768, (u16*)(ws + OFF_W_UQ) + (size_t)j * 768 * 384, 384, 768, p.mla_q_norm + j * 384, 2, lds);
      conv_job(p.mla_w_ukv + (size_t)j * 256 * 1024, 256, 1024, (u16*)(ws + OFF_W_UKV) + (size_t)j * 1024 * 256, 256, 1024, p.mla_kv_norm + j * 256, 0, lds);
      conv_job(p.att_w_out + (size_t)j * 1024 * 1024, 1024, 1024, (u16*)(ws + OFF_W_ATTOUT) + (size_t)j * 1024 * LDW1, LDW1, 1024, nullptr, 0, lds);
      conv_job(p.rec_w_in + (size_t)j * 1024 * 2560, 1024, 2560, (u16*)(ws + OFF_W_RECIN) + (size_t)j * 2560 * LDW1, LDW1, 2560, nullptr, 3, lds);
      conv_job(p.s5_glu_w + (size_t)j * 512 * 512, 512, 512, (u16*)(ws + OFF_W_GLU) + (size_t)j * 512 * LDGLU, LDGLU, 512, nullptr, 0, lds);
      conv_job(p.rec_w_out + (size_t)j * 1024 * 1024, 1024, 1024, (u16*)(ws + OFF_W_RECOUT) + (size_t)j * 1024 * LDW1, LDW1, 1024, nullptr, 0, lds);
    }
    for (int l = 0; l < 4; ++l) {
      conv_job(p.mlp_w1 + (size_t)l * 1024 * 4096, 1024, 4096, (u16*)(ws + OFF_W1) + (size_t)l * 4096 * LDW1, LDW1, 4096, nullptr, 0, lds);
      conv_job(p.mlp_w2 + (size_t)l * 4096 * 1024, 4096, 1024, (u16*)(ws + OFF_W2) + (size_t)l * 1024 * LDW2, LDW2, 1024, nullptr, 0, lds);
    }
  }
  {
    float2* rt32 = (float2*)(ws + OFF_RT32); float2* rt64 = (float2*)(ws + OFF_RT64); float2* rt128 = (float2*)(ws + OFF_RT128);
    for (int idx = bid * NTHR + tid; idx < S_ * 112; idx += nb * NTHR) {
      const int s = idx / 112, r = idx % 112;
      int dim, i; float2* dst;
      if (r < 16) { dim = 32; i = r; dst = rt32 + s * 16 + i; }
      else if (r < 48) { dim = 64; i = r - 16; dst = rt64 + s * 32 + i; }
      else { dim = 128; i = r - 48; dst = rt128 + s * 64 + i; }
      const float inv = powf(10000.0f, -((float)(2 * i)) / (float)dim);
      const float ang = (float)s * inv;
      float sn_, cs_; sincos_(ang, sn_, cs_);
      *dst = make_float2(cs_, sn_);
    }
  }
  {
    float4* s5z = (float4*)(ws + OFF_S5Z); float2* bbar = (float2*)(ws + OFF_BBAR);
    for (int idx = bid * NTHR + tid; idx < 2 * 32 * 64; idx += nb * NTHR) {
      const int jg = idx >> 6;
      const float dt = expf(p.s5_log_step[jg]);
      const float lr = p.s5_a_re[idx], li = p.s5_a_im[idx];
      const float zr = lr * dt, zi = li * dt, mag = expf(zr);
      float sn_, cs_; sincos_(zi, sn_, cs_);
      const float ar = mag * cs_, ai = mag * sn_;
      const float den = lr * lr + li * li;
      const float cr = ((ar - 1.f) * lr + ai * li) / den, ci = (ai * lr - (ar - 1.f) * li) / den;
      s5z[idx] = make_float4(zr, zi, ar, ai);
      for (int q = 0; q < 16; ++q) {
        const float br = p.s5_b_re[idx * 16 + q], bi = p.s5_b_im[idx * 16 + q];
        bbar[idx * 16 + q] = make_float2(cr * br - ci * bi, cr * bi + ci * br);
      }
    }
  }
}

DI void phase1(const Params& p) {
  const int tid = opqv(threadIdx.x), nb = gridDim.x, bid = blockIdx.x;
  char* ws = opq(p.ws);
  const float* mod = (const float*)(ws + OFF_MOD);
  u16* hy = (u16*)(ws + OFF_HY);
  for (int i = bid * NTHR + tid; i < T_ * 256; i += nb * NTHR) {
    const int t = i >> 8, c4 = (i & 255) * 4, b = t >> 14;
    const float4 xv = *(const float4*)(p.x + (size_t)i * 4);
    const float4 sh = *(const float4*)(mod + b * 3072 + c4);
    const float4 sc = *(const float4*)(mod + b * 3072 + 1024 + c4);
    uint2 o;
    o.x = pack2(xv.x * (1.f + sc.x) + sh.x, xv.y * (1.f + sc.y) + sh.y);
    o.y = pack2(xv.z * (1.f + sc.z) + sh.z, xv.w * (1.f + sc.w) + sh.w);
    *(uint2*)(hy + (size_t)t * LDH + c4) = o;
  }
  const float4* s5z = (const float4*)(ws + OFF_S5Z); const float2* bbar = (const float2*)(ws + OFF_BBAR);
  float* ktab = (float*)(ws + OFF_KTAB);
  for (int idx = bid * NTHR + tid; idx < 2 * 32 * 256; idx += nb * NTHR) {
    const int q = idx & 15, pp = (idx >> 4) & 15, jg = idx >> 8;
    float acc[32];
#pragma unroll
    for (int d = 0; d < 32; ++d) acc[d] = 0.f;
    for (int n = 0; n < 64; ++n) {
      const float4 z = s5z[jg * 64 + n];
      const float2 bb = bbar[(jg * 64 + n) * 16 + q];
      const float cr = p.s5_c_re[(jg * 16 + pp) * 64 + n], ci = p.s5_c_im[(jg * 16 + pp) * 64 + n];
      const float wr = cr * bb.x - ci * bb.y, wi = cr * bb.y + ci * bb.x;
      float er = 1.f, ei = 0.f;
#pragma unroll
      for (int d = 0; d < 32; ++d) {
        acc[d] += wr * er - wi * ei;
        const float nr = er * z.z - ei * z.w, ni = er * z.w + ei * z.z;
        er = nr; ei = ni;
      }
    }
#pragma unroll
    for (int d = 0; d < 32; ++d) ktab[(jg * 32 + d) * 256 + pp * 16 + q] = acc[d];
  }
}

DI void ln_phase(const Params& p, int ls) {
  const int tid = opqv(threadIdx.x), lane = tid & 63, w = tid >> 6;
  char* ws = opq(p.ws);
  const float* mod = (const float*)(ws + OFF_MOD);
  u16* hy = (u16*)(ws + OFF_HY);
  const float* xin = (ls == 0) ? p.x : p.out;
  const float* lg = p.ln_g + ls * 1024; const float* lb = p.ln_b + ls * 1024;
  const int stride = gridDim.x * 8;
  f32x4 xc[4], xn[4]; uint2 yc[4], yn[4];
  {
    const int row = blockIdx.x * 8 + w;
#pragma unroll
    for (int i = 0; i < 4; ++i) {
      const int col = lane * 4 + 256 * i;
      xc[i] = *(const f32x4*)(xin + (size_t)row * 1024 + col);
      yc[i] = *(const uint2*)(hy + (size_t)row * LDH + col);
    }
  }
  for (int row = blockIdx.x * 8 + w; row < T_; row += stride) {
    const int b = row >> 14;
    const float* gate = mod + (ls * 2 + b) * 3072 + 2048;
    const int rn = row + stride;
    if (rn < T_) {
#pragma unroll
      for (int i = 0; i < 4; ++i) {
        const int col = lane * 4 + 256 * i;
        xn[i] = *(const f32x4*)(xin + (size_t)rn * 1024 + col);
        yn[i] = *(const uint2*)(hy + (size_t)rn * LDH + col);
      }
    }
    float v[16];
    float sum = 0.f;
#pragma unroll
    for (int i = 0; i < 4; ++i) {
      const int col = lane * 4 + 256 * i;
      const f32x4 xv = xc[i];
      const uint2 yv = yc[i];
      const float4 g = *(const float4*)(gate + col);
      v[4 * i + 0] = DN_ALPHA * xv.x + (1.f + g.x) * bf2f(yv.x & 0xffffu);
      v[4 * i + 1] = DN_ALPHA * xv.y + (1.f + g.y) * bf2f(yv.x >> 16);
      v[4 * i + 2] = DN_ALPHA * xv.z + (1.f + g.z) * bf2f(yv.y & 0xffffu);
      v[4 * i + 3] = DN_ALPHA * xv.w + (1.f + g.w) * bf2f(yv.y >> 16);
      sum += v[4 * i] + v[4 * i + 1] + v[4 * i + 2] + v[4 * i + 3];
    }
#pragma unroll
    for (int m = 32; m >= 1; m >>= 1) sum += __shfl_xor(sum, m);
    const float mean = sum * (1.f / 1024.f);
    float vs = 0.f;
#pragma unroll
    for (int i = 0; i < 16; ++i) { const float d = v[i] - mean; vs += d * d; }
#pragma unroll
    for (int m = 32; m >= 1; m >>= 1) vs += __shfl_xor(vs, m);
    const float rstd = rsqrtf(vs * (1.f / 1024.f) + 1e-5f);
#pragma unroll
    for (int i = 0; i < 4; ++i) {
      const int col = lane * 4 + 256 * i;
      const float4 g = *(const float4*)(lg + col); const float4 bb = *(const float4*)(lb + col);
      float4 o;
      o.x = (v[4 * i + 0] - mean) * rstd * g.x + bb.x; o.y = (v[4 * i + 1] - mean) * rstd * g.y + bb.y;
      o.z = (v[4 * i + 2] - mean) * rstd * g.z + bb.z; o.w = (v[4 * i + 3] - mean) * rstd * g.w + bb.w;
      *(float4*)(p.out + (size_t)row * 1024 + col) = o;
      if (ls < 7) {
        const float* m2 = mod + ((ls + 1) * 2 + b) * 3072;
        const float4 sh = *(const float4*)(m2 + col); const float4 sc = *(const float4*)(m2 + 1024 + col);
        uint2 h;
        h.x = pack2(o.x * (1.f + sc.x) + sh.x, o.y * (1.f + sc.y) + sh.y);
        h.y = pack2(o.z * (1.f + sc.z) + sh.z, o.w * (1.f + sc.w) + sh.w);
        *(uint2*)(hy + (size_t)row * LDH + col) = h;
      }
    }
#pragma unroll
    for (int i = 0; i < 4; ++i) { xc[i] = xn[i]; yc[i] = yn[i]; }
  }
}

template <int V = 0>
DI void gemm_plain(const u16* A, int lda, int K, const u16* Wt, int ldb, int N, u16* C, int ldc, int mode, char* smem) {
  const int tid = opqv(threadIdx.x), lane = tid & 63, w = tid >> 6, wm = w >> 2, wn = w & 3, l32 = lane & 31, hf = lane >> 5;
  const int nN = N / 256;
  for (int lt = blockIdx.x >> 3; lt < 16 * nN; lt += gridDim.x >> 3) {
    int mt, nt; tile_map(lt, 16, nN, 8, 4, mt, nt);
    const int m0 = mt * 256, n0 = nt * 256;
    gemm_tile<V>(A + (size_t)m0 * lda, lda, K / 64, nullptr, 0, 0, Wt + (size_t)n0 * ldb, ldb, smem, [&](f32x16(&acc)[2][2], int moff) {
      const int m0_ = m0 + moff;
      int l32_ = l32, hf_ = hf; asm volatile("" : "+v"(l32_), "+v"(hf_));
#pragma unroll
      for (int i = 0; i < 2; ++i)
#pragma unroll
        for (int j = 0; j < 2; ++j)
#pragma unroll
          for (int r = 0; r < 16; ++r) {
            const int row = m0_ + wm * 64 + i * 32 + crow(r, hf_), col = n0 + wn * 64 + j * 32 + l32_;
            float v = acc[i][j][r];
            if (mode == 1) { v = fmaxf(v, 0.f); v = v * v; }
            if (V == 0 || v == 123456.789f) C[(size_t)row * ldc + col] = f2bf(v);
          }
    });
  }
}

DI void att_in_phase(const Params& p, int j, char* smem) {
  const int tid = opqv(threadIdx.x), lane = tid & 63, w = tid >> 6, wm = w >> 2, wn = w & 3, l32 = lane & 31, hf = lane >> 5;
  char* ws = opq(p.ws);
  const u16* A = (const u16*)(ws + OFF_HY);
  const u16* Wt = (const u16*)(ws + OFF_W_ATTIN) + (size_t)j * 1536 * LDW1;
  u16* zc = (u16*)(ws + OFF_ZC); u16* SQ = (u16*)(ws + OFF_SQ); u16* SK = (u16*)(ws + OFF_SK); u16* SV = (u16*)(ws + OFF_SV);
  u16* Kb = (u16*)(ws + OFF_KB);
  const float2* rt64 = (const float2*)(ws + OFF_RT64); const float2* rt32 = (const float2*)(ws + OFF_RT32);
  const int nN = 6;
  for (int lt = blockIdx.x >> 3; lt < 16 * nN; lt += gridDim.x >> 3) {
    int mt, nt; tile_map(lt, 16, nN, 16, 2, mt, nt);
    const int m0 = mt * 256, n0 = nt * 256;
    gemm_tile(A + (size_t)m0 * LDH, LDH, 16, nullptr, 0, 0, Wt + (size_t)n0 * LDW1, LDW1, smem, [&](f32x16(&acc)[2][2], int moff) {
      const int m0_ = m0 + moff;
      int l32_ = l32, hf_ = hf; asm volatile("" : "+v"(l32_), "+v"(hf_));
      const int C64 = n0 + wn * 64;
#pragma unroll
      for (int i = 0; i < 2; ++i) {
        const int rb = m0_ + wm * 64 + i * 32;
        if (C64 < 640) {
#pragma unroll
          for (int jn = 0; jn < 2; ++jn)
#pragma unroll
            for (int r = 0; r < 16; ++r) zc[(size_t)(rb + crow(r, hf_)) * 640 + C64 + jn * 32 + l32_] = f2bf(acc[i][jn][r]);
        } else if (C64 < 1280) {
          const bool isq = C64 < 1152;
          u16* dst = isq ? SQ : SK; const int pitch = isq ? 512 : 128; const int cb = isq ? (C64 - 640) : (C64 - 1152);
          const float sc = isq ? SWA_QSCALE : 1.f;
#pragma unroll
          for (int r = 0; r < 16; ++r) {
            const int t = rb + crow(r, hf_), pos = t & (S_ - 1);
            const float2 cs = rt64[pos * 32 + l32_];
            const float x1 = acc[i][0][r], x2 = acc[i][1][r];
            dst[(size_t)t * pitch + cb + l32_] = f2bf((x1 * cs.x - x2 * cs.y) * sc);
            dst[(size_t)t * pitch + cb + 32 + l32_] = f2bf((x2 * cs.x + x1 * cs.y) * sc);
          }
        } else if (C64 < 1408) {
#pragma unroll
          for (int jn = 0; jn < 2; ++jn)
#pragma unroll
            for (int r = 0; r < 16; ++r) SV[(size_t)(rb + crow(r, hf_)) * 128 + (C64 - 1280) + jn * 32 + l32_] = f2bf(acc[i][jn][r]);
        } else if (C64 == 1408) {
#pragma unroll
          for (int r = 0; r < 16; ++r) {
            const int t = rb + crow(r, hf_), pos = t & (S_ - 1);
            const float x = acc[i][0][r];
            const float xp = __shfl_xor(x, 16);
            const float2 cs = rt32[pos * 16 + (l32_ & 15)];
            const float o = (l32_ < 16) ? (x * cs.x - xp * cs.y) : (x * cs.x + xp * cs.y);
            const u16 v = f2bf(o);
#pragma unroll
            for (int h = 0; h < 8; ++h) Kb[(size_t)t * LDKB + h * 96 + 64 + l32_] = v;
          }
        }
      }
    });
  }
}

DI void qkv_phase(const Params& p, int j, char* smem) {
  const int tid = opqv(threadIdx.x), lane = tid & 63, w = tid >> 6, wm = w >> 2, wn = w & 3, l32 = lane & 31, hf = lane >> 5;
  char* ws = opq(p.ws);
  const u16* zc = (const u16*)(ws + OFF_ZC);
  const u16* Wq = (const u16*)(ws + OFF_W_UQ) + (size_t)j * 768 * 384;
  const u16* Wkv = (const u16*)(ws + OFF_W_UKV) + (size_t)j * 1024 * 256;
  u16* Qb = (u16*)(ws + OFF_QB); u16* Kb = (u16*)(ws + OFF_KB); u16* Vt = (u16*)(ws + OFF_VT);
  const float2* rt32 = (const float2*)(ws + OFF_RT32);
  float* rsc = (float*)(smem + SMEM_GEMM);
  for (int lt0 = blockIdx.x >> 3; lt0 < 16 * 7; lt0 += gridDim.x >> 3) {
    const bool isq = lt0 < 16 * 3;
    int mt, nt;
    if (isq) tile_map(lt0, 16, 3, 16, 1, mt, nt); else tile_map(lt0 - 16 * 3, 16, 4, 8, 4, mt, nt);
    const int m0 = mt * 256, n0 = nt * 256;
    const int coff = isq ? 0 : 384, ncols = isq ? 384 : 256;
    {
      const int row = tid >> 1, half = tid & 1, nh = ncols / 2;
      const u16* src = zc + (size_t)(m0 + row) * 640 + coff + half * nh;
      float s = 0.f;
      for (int c = 0; c < nh; c += 8) {
        const uint4 v = *(const uint4*)(src + c);
        float f;
        f = bf2f(v.x & 0xffffu); s += f * f; f = bf2f(v.x >> 16); s += f * f;
        f = bf2f(v.y & 0xffffu); s += f * f; f = bf2f(v.y >> 16); s += f * f;
        f = bf2f(v.z & 0xffffu); s += f * f; f = bf2f(v.z >> 16); s += f * f;
        f = bf2f(v.w & 0xffffu); s += f * f; f = bf2f(v.w >> 16); s += f * f;
      }
      s += __shfl_xor(s, 1);
      if (half == 0) rsc[row] = rsqrtf(s / (float)ncols + 1e-6f);
    }
    __syncthreads();
    if (isq) {
      gemm_tile(zc + (size_t)m0 * 640, 640, 6, nullptr, 0, 0, Wq + (size_t)n0 * 384, 384, smem, [&](f32x16(&acc)[2][2], int moff) {
      const int m0_ = m0 + moff;
      int l32_ = l32, hf_ = hf; asm volatile("" : "+v"(l32_), "+v"(hf_));
        const int C64 = n0 + wn * 64;
#pragma unroll
        for (int i = 0; i < 2; ++i) {
          const int rl = wm * 64 + i * 32;
#pragma unroll
          for (int jn = 0; jn < 2; ++jn)
#pragma unroll
            for (int r = 0; r < 16; ++r) {
              const int rr = rl + crow(r, hf_), t = m0_ + rr;
              const float x = acc[i][jn][r] * rsc[moff + rr] * MLA_QSCALE;
              if (C64 < 512) {
                Qb[(size_t)t * 768 + (C64 >> 6) * 96 + jn * 32 + l32_] = f2bf(x);
              } else {
                const int hq = ((C64 - 512) >> 5) + jn, pos = t & (S_ - 1);
                const float xp = __shfl_xor(x, 16);
                const float2 cs = rt32[pos * 16 + (l32_ & 15)];
                const float o = (l32_ < 16) ? (x * cs.x - xp * cs.y) : (x * cs.x + xp * cs.y);
                Qb[(size_t)t * 768 + hq * 96 + 64 + l32_] = f2bf(o);
              }
            }
        }
      });
    } else {
      gemm_tile(zc + (size_t)m0 * 640 + 384, 640, 4, nullptr, 0, 0, Wkv + (size_t)n0 * 256, 256, smem, [&](f32x16(&acc)[2][2], int moff) {
      const int m0_ = m0 + moff;
      int l32_ = l32, hf_ = hf; asm volatile("" : "+v"(l32_), "+v"(hf_));
        const int C64 = n0 + wn * 64, h = C64 >> 7, part = (C64 >> 6) & 1;
#pragma unroll
        for (int i = 0; i < 2; ++i) {
          const int rl = wm * 64 + i * 32;
#pragma unroll
          for (int jn = 0; jn < 2; ++jn) {
            if (part == 0) {
#pragma unroll
              for (int r = 0; r < 16; ++r) {
                const int rr = rl + crow(r, hf_), t = m0_ + rr;
                Kb[(size_t)t * LDKB + h * 96 + jn * 32 + l32_] = f2bf(acc[i][jn][r] * rsc[moff + rr]);
              }
            } else {
              const int e = jn * 32 + l32_;
#pragma unroll
              for (int qd = 0; qd < 4; ++qd) {
                const int rr = rl + 8 * qd + 4 * hf_, t0 = m0_ + rr, b = t0 >> 14, s0 = t0 & (S_ - 1);
                uint2 o;
                o.x = pack2(acc[i][jn][4 * qd + 0] * rsc[moff + rr + 0], acc[i][jn][4 * qd + 1] * rsc[moff + rr + 1]);
                o.y = pack2(acc[i][jn][4 * qd + 2] * rsc[moff + rr + 2], acc[i][jn][4 * qd + 3] * rsc[moff + rr + 3]);
                *(uint2*)(Vt + ((size_t)((b * 8 + h) * 64 + e)) * LDV + s0) = o;
              }
            }
          }
        }
      });
    }
    __syncthreads();
  }
}

constexpr int MLA_BUF = 64 * 208 + 64 * 136;
constexpr int MLA_SVP = 264;
constexpr int MLA_BUF2 = 128 * 208 + 64 * MLA_SVP;
DI void mla_item(const Params& p, int qb, int b, int h, char* smem) {
  const int tid = opqv(threadIdx.x), lane = tid & 63, w = tid >> 6, l32 = lane & 31, hf = lane >> 5;
  char* ws = opq(p.ws);
  const u16* Qb = (const u16*)(ws + OFF_QB); u16* o = (u16*)(ws + OFF_OE);
  const int q0 = qb * 256 + w * 32;
  const size_t tq = (size_t)b * S_ + q0 + l32;
  bf16x8 qf[6];
#pragma unroll
  for (int s = 0; s < 6; ++s) qf[s] = *(const bf16x8*)(Qb + tq * 768 + h * 96 + s * 16 + hf * 8);
  f32x16 ot[2]; ot[0] = zero16(); ot[1] = zero16();
  float m = -1e30f, l = 0.f;
  const int ntile = 2 * qb + 2;
  const u16* Kg = (const u16*)(ws + OFF_KB) + ((size_t)b * S_) * LDKB + h * 96;
  const u16* Vg = (const u16*)(ws + OFF_VT) + ((size_t)(b * 8 + h) * 64) * LDV;
  u32x4 rk[2][3], rv[2][2];
#define MGLOAD(SET, KT) { const int kt_ = (KT); \
    _Pragma("unroll") for (int i = 0; i < 3; ++i) { const int c = tid + 512 * i, row = c / 12, ch = c % 12; rk[SET][i] = *(const u32x4*)(Kg + (size_t)(kt_ * 128 + row) * LDKB + ch * 8); } \
    _Pragma("unroll") for (int i = 0; i < 2; ++i) { const int c = tid + 512 * i, row = c >> 4, ch = c & 15; rv[SET][i] = *(const u32x4*)(Vg + (size_t)row * LDV + kt_ * 128 + ch * 8); } }
#define MSWRITE(SET, BUF) { char* sk_ = smem + (BUF) * MLA_BUF2; char* sv_ = sk_ + 128 * 208; \
    _Pragma("unroll") for (int i = 0; i < 3; ++i) { const int c = tid + 512 * i, row = c / 12, ch = c % 12; *(u32x4*)(sk_ + row * 208 + ch * 16) = rk[SET][i]; } \
    _Pragma("unroll") for (int i = 0; i < 2; ++i) { const int c = tid + 512 * i, row = c >> 4, ch = c & 15; \
      *(uint2*)(sv_ + row * MLA_SVP + ch * 16) = make_uint2(rv[SET][i].x, rv[SET][i].y); \
      *(uint2*)(sv_ + row * MLA_SVP + ch * 16 + 8) = make_uint2(rv[SET][i].z, rv[SET][i].w); } }
  auto compute = [&](int kt, int sub) {
    const char* sk = smem + (kt & 1) * MLA_BUF2 + sub * (64 * 208); const char* sv = smem + (kt & 1) * MLA_BUF2 + 128 * 208 + sub * 128;
    const int k0 = kt * 128 + sub * 64;
    if (k0 <= q0 + 31) {
      f32x16 st[2];
      bf16x8 kf[2][6];
#pragma unroll
      for (int t32 = 0; t32 < 2; ++t32)
#pragma unroll
        for (int s = 0; s < 6; ++s) kf[t32][s] = *(const bf16x8*)(sk + (t32 * 32 + l32) * 208 + (s * 16 + hf * 8) * 2);
      __builtin_amdgcn_sched_barrier(0);
      if (w < 4) __builtin_amdgcn_s_setprio(1);
#pragma unroll
      for (int t32 = 0; t32 < 2; ++t32) {
        st[t32] = zero16();
#pragma unroll
        for (int s = 0; s < 6; ++s) st[t32] = MFMA(kf[t32][s], qf[s], st[t32]);
      }
      __builtin_amdgcn_s_setprio(0);
      bf16x8 vf[2][2][2];
#pragma unroll
      for (int t32 = 0; t32 < 2; ++t32)
#pragma unroll
        for (int s = 0; s < 2; ++s)
#pragma unroll
          for (int mt = 0; mt < 2; ++mt) {
            const char* vp = sv + (mt * 32 + l32) * MLA_SVP + (t32 * 32 + s * 16 + hf * 4) * 2;
            vf[t32][s][mt] = join8(*(const uint2*)vp, *(const uint2*)(vp + 16));
          }
      __builtin_amdgcn_sched_barrier(0);
      if (k0 + 63 > q0) {
        const int qpos = q0 + l32;
#pragma unroll
        for (int t32 = 0; t32 < 2; ++t32)
#pragma unroll
          for (int r = 0; r < 16; ++r) { const int key = k0 + t32 * 32 + crow(r, hf); if (key > qpos) st[t32][r] = -1e30f; }
      }
      float mx = -1e30f;
#pragma unroll
      for (int t32 = 0; t32 < 2; ++t32)
#pragma unroll
        for (int r = 0; r < 16; ++r) mx = fmaxf(mx, st[t32][r]);
      mx = fmaxf(mx, __shfl_xor(mx, 32));
      const float mn = fmaxf(m, mx);
      const float alpha = ex2(m - mn);
      m = mn;
      float ps = 0.f;
#pragma unroll
      for (int t32 = 0; t32 < 2; ++t32)
#pragma unroll
        for (int r = 0; r < 16; ++r) { const float pv = ex2(st[t32][r] - mn); st[t32][r] = pv; ps += pv; }
      l = l * alpha + ps;
#pragma unroll
      for (int mt = 0; mt < 2; ++mt)
#pragma unroll
        for (int r = 0; r < 16; ++r) ot[mt][r] *= alpha;
      if (w < 4) __builtin_amdgcn_s_setprio(1);
#pragma unroll
      for (int t32 = 0; t32 < 2; ++t32)
#pragma unroll
        for (int s = 0; s < 2; ++s) {
          const bf16x8 pf = pack8(st[t32], s);
#pragma unroll
          for (int mt = 0; mt < 2; ++mt) ot[mt] = MFMA(vf[t32][s][mt], pf, ot[mt]);
        }
      __builtin_amdgcn_s_setprio(0);
    }
  };
  MGLOAD(0, 0); MGLOAD(1, 1);
  MSWRITE(0, 0); __syncthreads();
  for (int kt = 0; kt < ntile; kt += 2) {
    if (kt + 2 < ntile) MGLOAD(0, kt + 2);
    __builtin_amdgcn_sched_barrier(0);
    compute(kt, 0); compute(kt, 1);
    MSWRITE(1, 1);
    __syncthreads();
    if (kt + 3 < ntile) MGLOAD(1, kt + 3);
    __builtin_amdgcn_sched_barrier(0);
    compute(kt + 1, 0); compute(kt + 1, 1);
    if (kt + 2 < ntile) MSWRITE(0, 0);
    __syncthreads();
  }
#undef MGLOAD
#undef MSWRITE
  l += __shfl_xor(l, 32);
  const float inv = 1.f / l;
#pragma unroll
  for (int mt = 0; mt < 2; ++mt)
#pragma unroll
    for (int qd = 0; qd < 4; ++qd) {
      const int e0 = mt * 32 + 8 * qd + 4 * hf;
      uint2 ov;
      ov.x = pack2(ot[mt][4 * qd + 0] * inv, ot[mt][4 * qd + 1] * inv);
      ov.y = pack2(ot[mt][4 * qd + 2] * inv, ot[mt][4 * qd + 3] * inv);
      *(uint2*)(o + tq * LDH + h * 64 + e0) = ov;
    }
}

DI void swa_item(const Params& p, int j, int b, int nblk, int kvh, char* smem) {
  const int tid = opqv(threadIdx.x) & 255, lane = tid & 63, w = tid >> 6, l32 = lane & 31, hf = lane >> 5;
  char* ws = opq(p.ws);
  const u16* SQ = (const u16*)(ws + OFF_SQ); const u16* SK = (const u16*)(ws + OFF_SK); const u16* SV = (const u16*)(ws + OFF_SV);
  u16* o = (u16*)(ws + OFF_OE);
  char* sk = smem; char* sv = smem + 256 * 144;
  const int ws0 = 128 * (nblk - 1);
#pragma unroll
  for (int i = 0; i < 8; ++i) {
    const int c = tid + 256 * i, row = c >> 3, ch = c & 7, pos = ws0 + row;
    uint4 kv = make_uint4(0, 0, 0, 0), vv = make_uint4(0, 0, 0, 0);
    if (pos >= 0) {
      kv = *(const uint4*)(SK + ((size_t)b * S_ + pos) * 128 + kvh * 64 + ch * 8);
      vv = *(const uint4*)(SV + ((size_t)b * S_ + pos) * 128 + kvh * 64 + ch * 8);
    }
    *(uint4*)(sk + row * 144 + ch * 16) = kv;
    char* vb = sv + (ch * 8) * 528 + row * 2;
    *(u16*)(vb + 0 * 528) = (u16)(vv.x & 0xffffu); *(u16*)(vb + 1 * 528) = (u16)(vv.x >> 16);
    *(u16*)(vb + 2 * 528) = (u16)(vv.y & 0xffffu); *(u16*)(vb + 3 * 528) = (u16)(vv.y >> 16);
    *(u16*)(vb + 4 * 528) = (u16)(vv.z & 0xffffu); *(u16*)(vb + 5 * 528) = (u16)(vv.z >> 16);
    *(u16*)(vb + 6 * 528) = (u16)(vv.w & 0xffffu); *(u16*)(vb + 7 * 528) = (u16)(vv.w >> 16);
  }
  __syncthreads();
  const size_t tq = (size_t)b * S_ + nblk * 128 + w * 32 + l32;
  const int qloc = 128 + w * 32 + l32;
#pragma unroll 1
  for (int g = 0; g < 4; ++g) {
    const int head = kvh * 4 + g;
    bf16x8 qf[4];
#pragma unroll
    for (int s = 0; s < 4; ++s) qf[s] = *(const bf16x8*)(SQ + tq * 512 + head * 64 + s * 16 + hf * 8);
    f32x16 st[5];
    const float sink2 = p.swa_sinks[j * 8 + head] * LOG2E;
    float mx = sink2;
#pragma unroll
    for (int tt = 0; tt < 5; ++tt) {
      const int kb = w * 32 + tt * 32;
      st[tt] = zero16();
#pragma unroll
      for (int s = 0; s < 4; ++s) {
        const bf16x8 kf = *(const bf16x8*)(sk + (kb + l32) * 144 + (s * 16 + hf * 8) * 2);
        st[tt] = MFMA(kf, qf[s], st[tt]);
      }
#pragma unroll
      for (int r = 0; r < 16; ++r) {
        const int kloc = kb + crow(r, hf);
        const bool valid = (kloc <= qloc) && (kloc > qloc - 128) && (ws0 + kloc >= 0);
        const float v = valid ? st[tt][r] : -1e30f;
        st[tt][r] = v; mx = fmaxf(mx, v);
      }
    }
    mx = fmaxf(mx, __shfl_xor(mx, 32));
    float ps = 0.f;
#pragma unroll
    for (int tt = 0; tt < 5; ++tt)
#pragma unroll
      for (int r = 0; r < 16; ++r) { const float pv = ex2(st[tt][r] - mx); st[tt][r] = pv; ps += pv; }
    ps += __shfl_xor(ps, 32);
    const float inv = 1.f / (ps + ex2(sink2 - mx));
    f32x16 ot[2]; ot[0] = zero16(); ot[1] = zero16();
#pragma unroll
    for (int tt = 0; tt < 5; ++tt) {
      const int kb = w * 32 + tt * 32;
#pragma unroll
      for (int s = 0; s < 2; ++s) {
        const bf16x8 pf = pack8(st[tt], s);
#pragma unroll
        for (int mt = 0; mt < 2; ++mt) {
          const char* vp = sv + (mt * 32 + l32) * 528 + (kb + s * 16 + hf * 4) * 2;
          const bf16x8 vf = join8(*(const uint2*)vp, *(const uint2*)(vp + 16));
          ot[mt] = MFMA(vf, pf, ot[mt]);
        }
      }
    }
#pragma unroll
    for (int mt = 0; mt < 2; ++mt)
#pragma unroll
      for (int qd = 0; qd < 4; ++qd) {
        const int e0 = mt * 32 + 8 * qd + 4 * hf;
        uint2 ov;
        ov.x = pack2(ot[mt][4 * qd + 0] * inv, ot[mt][4 * qd + 1] * inv);
        ov.y = pack2(ot[mt][4 * qd + 2] * inv, ot[mt][4 * qd + 3] * inv);
        *(uint2*)(o + tq * LDH + 512 + head * 64 + e0) = ov;
      }
  }
  __syncthreads();
}

DI void attn_phase(const Params& p, int j, int ctr_idx, char* smem) {
  __shared__ int s_item;
  int* ctr = (int*)(p.ws + OFF_CTR) + ctr_idx;
  const int nmla = 1024, nswa = 256;
  const int half = opqv(threadIdx.x) >> 8;
  char* sm = smem + half * HALF_SMEM;
  for (;;) {
    __syncthreads();
    if (threadIdx.x == 0) s_item = atomicAdd(ctr, 1);
    __syncthreads();
    const int it = s_item;
    if (it >= nmla + nswa) break;
    if (it < nmla) {
      const int qb = 63 - (it >> 4), bh = it & 15;
      mla_item(p, qb, bh >> 3, bh & 7, smem);
    } else {
      const int k = (it - nmla) * 2 + half;
      swa_item(p, j, k >> 8, (k >> 1) & 127, k & 1, sm);
    }
  }
}

DI void rec_in_phase(const Params& p, int j, char* smem) {
  const int tid = opqv(threadIdx.x), lane = tid & 63, w = tid >> 6, wm = w >> 2, wn = w & 3, l32 = lane & 31, hf = lane >> 5;
  char* ws = opq(p.ws);
  const u16* A = (const u16*)(ws + OFF_HY);
  const u16* Wt = (const u16*)(ws + OFF_W_RECIN) + (size_t)j * 2560 * LDW1;
  u16* zr = (u16*)(ws + OFF_ZR); u16* ug = (u16*)(ws + OFF_UG);
  const float2* rt128 = (const float2*)(ws + OFF_RT128);
  const int nN = 10;
  for (int lt = blockIdx.x >> 3; lt < 16 * nN; lt += gridDim.x >> 3) {
    int mt, nt; tile_map(lt, 16, nN, 16, 2, mt, nt);
    const int m0 = mt * 256, n0 = nt * 256;
    gemm_tile(A + (size_t)m0 * LDH, LDH, 16, nullptr, 0, 0, Wt + (size_t)n0 * LDW1, LDW1, smem, [&](f32x16(&acc)[2][2], int moff) {
      const int m0_ = m0 + moff;
      int l32_ = l32, hf_ = hf; asm volatile("" : "+v"(l32_), "+v"(hf_));
      const int C64 = n0 + wn * 64;
#pragma unroll
      for (int i = 0; i < 2; ++i) {
        const int rb = m0_ + wm * 64 + i * 32;
        if (C64 < 1024) {
          const int fi = ((C64 & 127) >> 1) + l32_, cbase = C64 & ~127;
          const float sc = (C64 >= 512) ? RET_KSCALE : 1.f;
#pragma unroll
          for (int r = 0; r < 16; ++r) {
            const int t = rb + crow(r, hf_), pos = t & (S_ - 1);
            const float2 cs = rt128[pos * 64 + fi];
            const float x1 = acc[i][0][r], x2 = acc[i][1][r];
            zr[(size_t)t * LDZR + cbase + fi] = f2bf((x1 * cs.x - x2 * cs.y) * sc);
            zr[(size_t)t * LDZR + cbase + 64 + fi] = f2bf((x2 * cs.x + x1 * cs.y) * sc);
          }
        } else if (C64 < 2048) {
#pragma unroll
          for (int jn = 0; jn < 2; ++jn)
#pragma unroll
            for (int r = 0; r < 16; ++r) zr[(size_t)(rb + crow(r, hf_)) * LDZR + C64 + jn * 32 + l32_] = f2bf(acc[i][jn][r]);
        } else {
#pragma unroll
          for (int jn = 0; jn < 2; ++jn) {
            const int cl = C64 - 2048 + jn * 32 + l32_, g = cl >> 4, pp = cl & 15;
#pragma unroll
            for (int r = 0; r < 16; ++r) ug[((size_t)g * T_ + rb + crow(r, hf_)) * 16 + pp] = f2bf(acc[i][jn][r]);
          }
        }
      }
    });
  }
}

DI void s5_fill(const Params& p, int j) {
  const int tid = opqv(threadIdx.x), nb = gridDim.x, bid = blockIdx.x;
  char* ws = opq(p.ws);
  const float4* s5z = (const float4*)(ws + OFF_S5Z) + j * 2048; const float2* bbar = (const float2*)(ws + OFF_BBAR) + j * 2048 * 16;
  const float* ktab = (const float*)(ws + OFF_KTAB) + (size_t)j * 32 * 32 * 256;
  u16* WE = (u16*)(ws + OFF_WE); u16* WY = (u16*)(ws + OFF_WY);
  for (int idx = bid * NTHR + tid; idx < 32 * 256 * 512; idx += nb * NTHR) {
    const int g = idx >> 17, n2 = (idx >> 9) & 255, k = idx & 511, jj = k >> 4, q = k & 15, n = n2 & 63;
    if (n2 >= 128) { WE[idx] = 0; continue; }
    const float4 z = s5z[g * 64 + n];
    const float d = (float)(31 - jj);
    const float mg = expf(d * z.x), ang = d * z.y; float sn_, cs_; sincos_(ang, sn_, cs_);
    const float er = mg * cs_, ei = mg * sn_;
    const float2 bb = bbar[(g * 64 + n) * 16 + q];
    const float v = (n2 < 64) ? (er * bb.x - ei * bb.y) : (er * bb.y + ei * bb.x);
    WE[idx] = f2bf(v);
  }
  for (int idx = bid * NTHR + tid; idx < 32 * 512 * 640; idx += nb * NTHR) {
    const int g = idx / (512 * 640), rem = idx - g * (512 * 640), mrow = rem / 640, k = rem - mrow * 640;
    const int i = mrow >> 4, pp = mrow & 15;
    float v;
    if (k < 512) {
      const int jj = k >> 4, q = k & 15, d = i - jj;
      v = (d >= 0) ? ktab[(g * 32 + d) * 256 + pp * 16 + q] : 0.f;
      if (d == 0 && q == pp) v += p.s5_d[j * 512 + g * 16 + pp];
    } else {
      const int n2 = k - 512, n = n2 & 63;
      const float4 z = s5z[g * 64 + n];
      const float d = (float)(i + 1);
      const float mg = expf(d * z.x), ang = d * z.y; float sn_, cs_; sincos_(ang, sn_, cs_);
    const float er = mg * cs_, ei = mg * sn_;
      const float cr = p.s5_c_re[((j * 32 + g) * 16 + pp) * 64 + n], ci = p.s5_c_im[((j * 32 + g) * 16 + pp) * 64 + n];
      v = (n2 < 64) ? (cr * er - ci * ei) : -(cr * ei + ci * er);
    }
    WY[idx] = f2bf(v);
  }
}

DI void ret_u_item(const Params& p, int b, int n, int h, char* smem) {
  const int tid = opqv(threadIdx.x) & 255, lane = tid & 63, w = tid >> 6, wm = w >> 1, wn = w & 1, l32 = lane & 31, hf = lane >> 5;
  char* ws = opq(p.ws);
  const u16* zr = (const u16*)(ws + OFF_ZR); float* U = (float*)(ws + OFF_UO);
  char* sKt = smem; char* sVt = smem + 128 * 272;
  const size_t t0 = (size_t)b * S_ + n * 128;
  const float lg = lg2gamma(h);
#pragma unroll
  for (int i = 0; i < 8; ++i) {
    const int c = tid + 256 * i, row = c >> 4, ch = c & 15;
    const uint4 kv = *(const uint4*)(zr + (t0 + row) * LDZR + 512 + h * 128 + ch * 8);
    const uint4 vv = *(const uint4*)(zr + (t0 + row) * LDZR + 1024 + h * 128 + ch * 8);
    const float te = ex2((float)(127 - row) * lg);
    char* kb = sKt + (ch * 8) * 272 + row * 2; char* vb = sVt + (ch * 8) * 272 + row * 2;
    *(u16*)(kb + 0 * 272) = f2bf(bf2f(kv.x & 0xffffu) * te); *(u16*)(kb + 1 * 272) = f2bf(bf2f(kv.x >> 16) * te);
    *(u16*)(kb + 2 * 272) = f2bf(bf2f(kv.y & 0xffffu) * te); *(u16*)(kb + 3 * 272) = f2bf(bf2f(kv.y >> 16) * te);
    *(u16*)(kb + 4 * 272) = f2bf(bf2f(kv.z & 0xffffu) * te); *(u16*)(kb + 5 * 272) = f2bf(bf2f(kv.z >> 16) * te);
    *(u16*)(kb + 6 * 272) = f2bf(bf2f(kv.w & 0xffffu) * te); *(u16*)(kb + 7 * 272) = f2bf(bf2f(kv.w >> 16) * te);
    *(u16*)(vb + 0 * 272) = (u16)(vv.x & 0xffffu); *(u16*)(vb + 1 * 272) = (u16)(vv.x >> 16);
    *(u16*)(vb + 2 * 272) = (u16)(vv.y & 0xffffu); *(u16*)(vb + 3 * 272) = (u16)(vv.y >> 16);
    *(u16*)(vb + 4 * 272) = (u16)(vv.z & 0xffffu); *(u16*)(vb + 5 * 272) = (u16)(vv.z >> 16);
    *(u16*)(vb + 6 * 272) = (u16)(vv.w & 0xffffu); *(u16*)(vb + 7 * 272) = (u16)(vv.w >> 16);
  }
  __syncthreads();
  f32x16 acc[2][2];
#pragma unroll
  for (int i = 0; i < 2; ++i)
#pragma unroll
    for (int jn = 0; jn < 2; ++jn) acc[i][jn] = zero16();
#pragma unroll
  for (int s = 0; s < 8; ++s) {
    bf16x8 af[2], bfr[2];
#pragma unroll
    for (int i = 0; i < 2; ++i) af[i] = *(const bf16x8*)(sVt + (wm * 64 + i * 32 + l32) * 272 + (s * 16 + hf * 8) * 2);
#pragma unroll
    for (int jn = 0; jn < 2; ++jn) bfr[jn] = *(const bf16x8*)(sKt + (wn * 64 + jn * 32 + l32) * 272 + (s * 16 + hf * 8) * 2);
#pragma unroll
    for (int i = 0; i < 2; ++i)
#pragma unroll
      for (int jn = 0; jn < 2; ++jn) acc[i][jn] = MFMA(af[i], bfr[jn], acc[i][jn]);
  }
  float* Ub = U + ((size_t)((b * 4 + h) * 128 + n)) * 16384;
#pragma unroll
  for (int i = 0; i < 2; ++i)
#pragma unroll
    for (int jn = 0; jn < 2; ++jn)
#pragma unroll
      for (int r = 0; r < 16; ++r) Ub[(wm * 64 + i * 32 + crow(r, hf)) * 128 + wn * 64 + jn * 32 + l32] = acc[i][jn][r];
  __syncthreads();
}

DI void rec_state_phase(const Params& p, int j, char* smem) {
  const int tid = opqv(threadIdx.x), lane = tid & 63, w = tid >> 6, wm = w >> 2, wn = w & 3, l32 = lane & 31, hf = lane >> 5;
  char* ws = opq(p.ws);
  {
    const int half = opqv(threadIdx.x) >> 8;
    char* sm = smem + half * HALF_SMEM;
    for (int it = blockIdx.x; it < 512; it += gridDim.x) { const int item = it * 2 + half; ret_u_item(p, item >> 9, (item >> 2) & 127, item & 3, sm); }
  }
  for (int it = blockIdx.x; it < 128; it += gridDim.x) {
    const int g = it >> 2, mt = it & 3, m0 = mt * 256;
    const u16* A = (const u16*)(ws + OFF_UG) + (size_t)g * T_ * 16 + (size_t)m0 * 512;
    const u16* Bt = (const u16*)(ws + OFF_WE) + (size_t)g * 256 * 512;
    float* E = (float*)(ws + OFF_EB) + (size_t)g * 1024 * 128;
    gemm_tile(A, 512, 8, nullptr, 0, 0, Bt, 512, smem, [&](f32x16(&acc)[2][2], int moff) {
      int l32_ = l32, hf_ = hf; asm volatile("" : "+v"(l32_), "+v"(hf_));
      const int m0_ = m0 + moff;
      if (wn < 2) {
#pragma unroll
        for (int i = 0; i < 2; ++i)
#pragma unroll
          for (int jn = 0; jn < 2; ++jn)
#pragma unroll
            for (int r = 0; r < 16; ++r)
              E[(size_t)(m0_ + wm * 64 + i * 32 + crow(r, hf_)) * 128 + wn * 64 + jn * 32 + l32_] = acc[i][jn][r];
      }
    });
  }
}

DI void scan_phase(const Params& p, int j) {
  const int tid = opqv(threadIdx.x) & 255;
  char* ws = opq(p.ws);
  for (int vb = blockIdx.x * 2 + (opqv(threadIdx.x) >> 8); vb < 128 + 16; vb += gridDim.x * 2) {
    if (vb < 128) {
      const int idx = vb * 256 + tid, bh = idx >> 12, e4 = (idx & 4095) * 4, h = bh & 3;
      const float cd = ex2(128.f * lg2gamma(h));
      const float* U = (const float*)(ws + OFF_UO) + (size_t)bh * 128 * 16384 + e4;
      u16* Sp = (u16*)(ws + OFF_SP) + (size_t)bh * 128 * 16384 + e4;
      float4 S = make_float4(0, 0, 0, 0);
      for (int n0 = 0; n0 < 128; n0 += 16) {
        f32x4 u[16];
#pragma unroll
        for (int k = 0; k < 16; ++k) u[k] = *(const f32x4*)(U + (size_t)(n0 + k) * 16384);
#pragma unroll
        for (int k = 0; k < 16; ++k) {
          *(uint2*)(Sp + (size_t)(n0 + k) * 16384) = make_uint2(pack2(S.x, S.y), pack2(S.z, S.w));
          S.x = cd * S.x + u[k].x; S.y = cd * S.y + u[k].y; S.z = cd * S.z + u[k].z; S.w = cd * S.w + u[k].w;
        }
      }
    } else {
      const int idx = (vb - 128) * 256 + tid, b = idx >> 11, g = (idx >> 6) & 31, n = idx & 63;
      const float4 z = ((const float4*)(ws + OFF_S5Z))[(j * 32 + g) * 64 + n];
      const float mg = expf(32.f * z.x), ang = 32.f * z.y; float sn_, cs_; sincos_(ang, sn_, cs_);
      const float a32r = mg * cs_, a32i = mg * sn_;
      const float* E = (const float*)(ws + OFF_EB) + ((size_t)g * 1024 + b * 512) * 128;
      u16* Xp = (u16*)(ws + OFF_XP) + ((size_t)g * 1024 + b * 512) * 128;
      float xr = 0.f, xi = 0.f;
      for (int c0 = 0; c0 < 512; c0 += 32) {
        float er[32], ei[32];
#pragma unroll
        for (int k = 0; k < 32; ++k) { er[k] = E[(c0 + k) * 128 + n]; ei[k] = E[(c0 + k) * 128 + 64 + n]; }
#pragma unroll
        for (int k = 0; k < 32; ++k) {
          Xp[(c0 + k) * 128 + n] = f2bf(xr); Xp[(c0 + k) * 128 + 64 + n] = f2bf(xi);
          const float nr = a32r * xr - a32i * xi + er[k], ni = a32r * xi + a32i * xr + ei[k];
          xr = nr; xi = ni;
        }
      }
    }
  }
}

DI void ret_out_item(const Params& p, int b, int n, int h, char* smem) {
  const int tid = opqv(threadIdx.x) & 255, lane = tid & 63, w = tid >> 6, l32 = lane & 31, hf = lane >> 5;
  char* ws = opq(p.ws);
  const u16* zr = (const u16*)(ws + OFF_ZR); u16* o = (u16*)(ws + OFF_UO);
  char* sK = smem; char* sVt = smem + 128 * 272;
  const size_t t0 = (size_t)b * S_ + n * 128;
  const float lg = lg2gamma(h);
#pragma unroll
  for (int i = 0; i < 8; ++i) {
    const int c = tid + 256 * i, row = c >> 4, ch = c & 15;
    const uint4 kv = *(const uint4*)(zr + (t0 + row) * LDZR + 512 + h * 128 + ch * 8);
    const uint4 vv = *(const uint4*)(zr + (t0 + row) * LDZR + 1024 + h * 128 + ch * 8);
    *(uint4*)(sK + row * 272 + ch * 16) = kv;
    char* vb = sVt + (ch * 8) * 272 + row * 2;
    *(u16*)(vb + 0 * 272) = (u16)(vv.x & 0xffffu); *(u16*)(vb + 1 * 272) = (u16)(vv.x >> 16);
    *(u16*)(vb + 2 * 272) = (u16)(vv.y & 0xffffu); *(u16*)(vb + 3 * 272) = (u16)(vv.y >> 16);
    *(u16*)(vb + 4 * 272) = (u16)(vv.z & 0xffffu); *(u16*)(vb + 5 * 272) = (u16)(vv.z >> 16);
    *(u16*)(vb + 6 * 272) = (u16)(vv.w & 0xffffu); *(u16*)(vb + 7 * 272) = (u16)(vv.w >> 16);
  }
  __syncthreads();
  const size_t tq = t0 + w * 32 + l32;
  const int qi = w * 32 + l32;
  bf16x8 qf[8];
#pragma unroll
  for (int s = 0; s < 8; ++s) qf[s] = *(const bf16x8*)(zr + tq * LDZR + h * 128 + s * 16 + hf * 8);
  f32x16 ot[4];
  const u16* Sp = (const u16*)(ws + OFF_SP) + ((size_t)((b * 4 + h) * 128 + n)) * 16384;
#pragma unroll
  for (int mt = 0; mt < 4; ++mt) {
    ot[mt] = zero16();
#pragma unroll
    for (int s = 0; s < 8; ++s) {
      const bf16x8 sf = *(const bf16x8*)(Sp + (mt * 32 + l32) * 128 + s * 16 + hf * 8);
      ot[mt] = MFMA(sf, qf[s], ot[mt]);
    }
  }
  const float fs = ex2((float)(qi + 1) * lg);
#pragma unroll
  for (int mt = 0; mt < 4; ++mt)
#pragma unroll
    for (int r = 0; r < 16; ++r) ot[mt][r] *= fs;
#pragma unroll
  for (int tt = 0; tt < 4; ++tt) {
    if (tt <= w) {
      f32x16 st = zero16();
#pragma unroll
      for (int s = 0; s < 8; ++s) {
        const bf16x8 kf = *(const bf16x8*)(sK + (tt * 32 + l32) * 272 + (s * 16 + hf * 8) * 2);
        st = MFMA(kf, qf[s], st);
      }
#pragma unroll
      for (int r = 0; r < 16; ++r) {
        const int dd = qi - (tt * 32 + crow(r, hf));
        st[r] = (dd >= 0) ? st[r] * ex2((float)dd * lg) : 0.f;
      }
#pragma unroll
      for (int s2 = 0; s2 < 2; ++s2) {
        const bf16x8 pf = pack8(st, s2);
#pragma unroll
        for (int mt = 0; mt < 4; ++mt) {
          const char* vp = sVt + (mt * 32 + l32) * 272 + (tt * 32 + s2 * 16 + hf * 4) * 2;
          const bf16x8 vf = join8(*(const uint2*)vp, *(const uint2*)(vp + 16));
          ot[mt] = MFMA(vf, pf, ot[mt]);
        }
      }
    }
  }
  float sum = 0.f;
#pragma unroll
  for (int mt = 0; mt < 4; ++mt)
#pragma unroll
    for (int r = 0; r < 16; ++r) sum += ot[mt][r];
  sum += __shfl_xor(sum, 32);
  const float mean = sum * (1.f / 128.f);
  float vs = 0.f;
#pragma unroll
  for (int mt = 0; mt < 4; ++mt)
#pragma unroll
    for (int r = 0; r < 16; ++r) { const float d = ot[mt][r] - mean; vs += d * d; }
  vs += __shfl_xor(vs, 32);
  const float rstd = rsqrtf(vs * (1.f / 128.f) + 1e-5f);
#pragma unroll
  for (int mt = 0; mt < 4; ++mt)
#pragma unroll
    for (int qd = 0; qd < 4; ++qd) {
      const int e0 = mt * 32 + 8 * qd + 4 * hf;
      const uint2 gv = *(const uint2*)(zr + tq * LDZR + 1536 + h * 128 + e0);
      const float g0 = bf2f(gv.x & 0xffffu), g1 = bf2f(gv.x >> 16), g2 = bf2f(gv.y & 0xffffu), g3 = bf2f(gv.y >> 16);
      const float o0 = g0 / (1.f + __expf(-g0)) * (ot[mt][4 * qd + 0] - mean) * rstd;
      const float o1 = g1 / (1.f + __expf(-g1)) * (ot[mt][4 * qd + 1] - mean) * rstd;
      const float o2 = g2 / (1.f + __expf(-g2)) * (ot[mt][4 * qd + 2] - mean) * rstd;
      const float o3 = g3 / (1.f + __expf(-g3)) * (ot[mt][4 * qd + 3] - mean) * rstd;
      *(uint2*)(o + tq * LDH + h * 128 + e0) = make_uint2(pack2(o0, o1), pack2(o2, o3));
    }
  __syncthreads();
}

DI float gelu_tanh(float y) {
  const float u = 0.7978845608028654f * (y + 0.044715f * y * y * y);
  const float e = __expf(2.f * u);
  const float th = 1.f - 2.f / (e + 1.f);
  return 0.5f * y * (1.f + th);
}

DI void rec_out_phase(const Params& p, int j, char* smem) {
  const int tid = opqv(threadIdx.x), lane = tid & 63, w = tid >> 6, wm = w >> 2, wn = w & 3, l32 = lane & 31, hf = lane >> 5;
  char* ws = opq(p.ws);
  {
    const int half = opqv(threadIdx.x) >> 8;
    char* sm = smem + half * HALF_SMEM;
    for (int it = blockIdx.x; it < 512; it += gridDim.x) { const int item = it * 2 + half; ret_out_item(p, item >> 9, (item >> 2) & 127, item & 3, sm); }
  }
  for (int it = blockIdx.x; it < 256; it += gridDim.x) {
    {
      const int k = it, g = k >> 3, mt = (k >> 1) & 3, nt = k & 1, m0 = mt * 256, n0 = nt * 256;
      const u16* Ug = (const u16*)(ws + OFF_UG) + (size_t)g * T_ * 16;
      const u16* A1 = Ug + (size_t)m0 * 512;
      const u16* A2 = (const u16*)(ws + OFF_XP) + ((size_t)g * 1024 + m0) * 128;
      const u16* Bt = (const u16*)(ws + OFF_WY) + ((size_t)g * 512 + n0) * 640;
      u16* yt = (u16*)(ws + OFF_YT);
      gemm_tile(A1, 512, 8, A2, 128, 2, Bt, 640, smem, [&](f32x16(&acc)[2][2], int moff) {
      const int m0_ = m0 + moff;
      int l32_ = l32, hf_ = hf; asm volatile("" : "+v"(l32_), "+v"(hf_));
#pragma unroll
        for (int i = 0; i < 2; ++i)
#pragma unroll
          for (int jn = 0; jn < 2; ++jn)
#pragma unroll
            for (int r = 0; r < 16; ++r) {
              const int R = m0_ + wm * 64 + i * 32 + crow(r, hf_), col = n0 + wn * 64 + jn * 32 + l32_;
              const int ii = col >> 4, pp = col & 15;
              const size_t t = (size_t)R * 32 + ii;
              const float y = acc[i][jn][r];
              yt[t * LDYT + g * 16 + pp] = f2bf(gelu_tanh(y));
            }
      });
    }
  }
}

DI void glu_phase(const Params& p, int j, char* smem) {
  const int tid = opqv(threadIdx.x), lane = tid & 63, w = tid >> 6, wm = w >> 2, wn = w & 3, l32 = lane & 31, hf = lane >> 5;
  char* ws = opq(p.ws);
  const u16* yt = (const u16*)(ws + OFF_YT);
  const u16* Wt = (const u16*)(ws + OFF_W_GLU) + (size_t)j * 512 * LDGLU;
  u16* o = (u16*)(ws + OFF_UO);
  const float* gb = p.s5_glu_b + j * 512;
  const int nN = 2;
  for (int lt = blockIdx.x >> 3; lt < 16 * nN; lt += gridDim.x >> 3) {
    int mt, nt; tile_map(lt, 16, nN, 16, 2, mt, nt);
    const int m0 = mt * 256, n0 = nt * 256;
    gemm_tile(yt + (size_t)m0 * LDYT, LDYT, 8, nullptr, 0, 0, Wt + (size_t)n0 * LDGLU, LDGLU, smem, [&](f32x16(&acc)[2][2], int moff) {
      const int m0_ = m0 + moff;
      int l32_ = l32, hf_ = hf; asm volatile("" : "+v"(l32_), "+v"(hf_));
#pragma unroll
      for (int i = 0; i < 2; ++i)
#pragma unroll
        for (int jn = 0; jn < 2; ++jn)
#pragma unroll
          for (int r = 0; r < 16; ++r) {
            const int row = m0_ + wm * 64 + i * 32 + crow(r, hf_), col = n0 + wn * 64 + jn * 32 + l32_;
            const float gt = acc[i][jn][r] + gb[col];
            const float y = bf2f(yt[(size_t)row * LDYT + col]);
            o[(size_t)row * LDH + 512 + col] = f2bf(y / (1.f + __expf(-gt)));
          }
    });
  }
}

DI void run_phase(const Params& p, int ph, char* smem, int rep) {
  char* ws = opq(p.ws);
  if (ph == 0) { phase0(p, smem); return; }
  if (ph == 1) { phase1(p); return; }
  const int q = ph - 2, pair = q / 18, r = q % 18;
  const bool odd = r >= 8;
  const int k = odd ? r - 8 : r;
  const int l = pair * 2 + (odd ? 1 : 0), j = pair;
  int op = 2, pm = 0, ls = 0;
  if (!odd) {
    if (k == 3) { op = 0; pm = 0; } else if (k == 5) { op = 0; pm = 1; } else if (k == 6) { op = 0; pm = 2; }
    else if (k == 4) { op = 1; ls = 2 * l; } else if (k == 7) { op = 1; ls = 2 * l + 1; }
  } else {
    if (k == 5) { op = 0; pm = 0; } else if (k == 7) { op = 0; pm = 1; } else if (k == 8) { op = 0; pm = 2; }
    else if (k == 6) { op = 1; ls = 2 * l; } else if (k == 9) { op = 1; ls = 2 * l + 1; }
  }
  if (op == 0) {
    const u16* A; const u16* W; u16* C; int K, N, mode, lda, ldb, ldc;
    if (pm == 0) {
      A = (const u16*)(ws + (odd ? OFF_UO : OFF_OE)); lda = LDH;
      W = (const u16*)(ws + (odd ? OFF_W_RECOUT : OFF_W_ATTOUT)) + (size_t)j * 1024 * LDW1; ldb = LDW1;
      C = (u16*)(ws + OFF_HY); ldc = LDH; K = 1024; N = 1024; mode = 0;
    } else if (pm == 1) {
      A = (const u16*)(ws + OFF_HY); lda = LDH; W = (const u16*)(ws + OFF_W1) + (size_t)l * 4096 * LDW1; ldb = LDW1;
      C = (u16*)(ws + OFF_HID); ldc = LDHID; K = 1024; N = 4096; mode = 1;
    } else {
      A = (const u16*)(ws + OFF_HID); lda = LDHID; W = (const u16*)(ws + OFF_W2) + (size_t)l * 1024 * LDW2; ldb = LDW2;
      C = (u16*)(ws + OFF_HY); ldc = LDH; K = 4096; N = 1024; mode = 0;
    }
#ifdef PROBE_VARIANT
    if (rep) gemm_plain<PROBE_VARIANT>(A, lda, K, W, ldb, N, C, ldc, mode, smem); else
#endif
    gemm_plain<0>(A, lda, K, W, ldb, N, C, ldc, mode, smem);
  } else if (op == 1) {
    ln_phase(p, ls);
  } else if (!odd) {
    if (k == 0) att_in_phase(p, j, smem);
    else if (k == 1) qkv_phase(p, j, smem);
    else attn_phase(p, j, j + 4 * rep, smem);
  } else {
    if (k == 0) { rec_in_phase(p, j, smem); s5_fill(p, j); }
    else if (k == 1) rec_state_phase(p, j, smem);
    else if (k == 2) scan_phase(p, j);
    else if (k == 3) rec_out_phase(p, j, smem);
    else glu_phase(p, j, smem);
  }
}

__global__ void __launch_bounds__(512, 2) mega_kernel(Params p, int ph0, int ph1) {
  extern __shared__ __attribute__((aligned(16))) char smem[];
  cg::grid_group grid = cg::this_grid();
  __shared__ uint4 xb_words;
  if (threadIdx.x == 0) xb_words = make_uint4(0u, 0u, 0u, 0u);
  __syncthreads();
  XcdBarrier xb = xcd_barrier_post((unsigned*)(p.ws + OFF_BAR), (volatile LAS unsigned*)&xb_words);
  for (int ph = ph0; ph < ph1; ++ph) {
    run_phase(p, ph, smem, 0);
#ifdef PROBE_MASK
    if (ph >= 2 && ((PROBE_MASK >> ((ph - 2) % 18)) & 1)) { xcd_barrier(xb); run_phase(p, ph, smem, 1); }
#endif
    if (ph + 1 < ph1) { if (ph == ph0) grid.sync(); else xcd_barrier(xb); }
  }
}

__global__ void fail_fill(float* out, int n) {
  int i = blockIdx.x * 256 + threadIdx.x;
  if (i < n) out[i] = 0.f;
}

extern "C" void kernel_launch(void* const* d_in, const int* in_sizes, int n_in, void* d_out, int out_size, void* d_ws,
                              size_t ws_size, hipStream_t stream) {
  Params p{};
  const float** fp = (const float**)&p;
  for (int i = 0; i < 27; ++i) fp[i] = (const float*)d_in[i];
  p.out = (float*)d_out;
  p.ws = (char*)d_ws;
  if (ws_size < WS_NEED) {
    fail_fill<<<(out_size + 255) / 256, 256, 0, stream>>>((float*)d_out, out_size);
    return;
  }
  static int grid_blocks = 0;
  if (!grid_blocks) {
    hipFuncSetAttribute((const void*)mega_kernel, hipFuncAttributeMaxDynamicSharedMemorySize, SMEM_BYTES);
    int dev = 0, cus = 0, per_cu = 0;
    hipGetDevice(&dev);
    hipDeviceGetAttribute(&cus, hipDeviceAttributeMultiprocessorCount, dev);
    hipOccupancyMaxActiveBlocksPerMultiprocessor(&per_cu, mega_kernel, NTHR, SMEM_BYTES);
    if (per_cu > 1) per_cu = 1;
    if (per_cu < 1) per_cu = 1;
    grid_blocks = cus * per_cu;
  }
  (void)hipMemsetAsync((char*)d_ws + OFF_BAR, 0, XCD_BAR_WORDS * 4, stream);
  int ph0 = 0, ph1 = NPHASE;
  void* args[] = {&p, &ph0, &ph1};
  hipError_t e = hipLaunchCooperativeKernel((void*)mega_kernel, dim3(grid_blocks), dim3(NTHR), args, SMEM_BYTES, stream);
  if (e != hipSuccess) fprintf(stderr, "cooperative launch failed: %s (grid %d)\n", hipGetErrorString(e), grid_blocks);
}
static_assert(WS_NEED <= (size_t)536870912, "workspace budget exceeded");
```

```cpp
#include <hip/hip_runtime.h>
#include <hip/hip_cooperative_groups.h>
#include <cstdio>
namespace cg = cooperative_groups;

typedef unsigned short u16;
using bf16x8 = __attribute__((ext_vector_type(8))) short;
using f32x16 = __attribute__((ext_vector_type(16))) float;
using u32x4 = __attribute__((ext_vector_type(4))) unsigned;
typedef __attribute__((address_space(3))) unsigned lds_u32;
using f32x4 = __attribute__((ext_vector_type(4))) float;
#define DI __device__ __forceinline__
#define MFMA(a, b, c) __builtin_amdgcn_mfma_f32_32x32x16_bf16((a), (b), (c), 0, 0, 0)

constexpr int T_ = 32768, S_ = 16384;
constexpr float LOG2E = 1.4426950408889634f;
constexpr float DN_ALPHA = 1.6817928305074290f;
constexpr float MLA_QSCALE = 0.10206207261596575f * LOG2E;
constexpr float SWA_QSCALE = 0.125f * LOG2E;
constexpr float RET_KSCALE = 0.08838834764831845f;
constexpr int LDH = 1088, LDHID = 4160, LDW1 = 1088, LDW2 = 4160, LDV = S_ + 64, LDKB = 832, LDZR = 2112, LDYT = 576, LDGLU = 576;

constexpr size_t OFF_MOD = 0;
constexpr size_t OFF_CTR = OFF_MOD + 8 * 2 * 3072 * 4;
constexpr size_t OFF_BAR = OFF_CTR + 256;
constexpr size_t OFF_RT32 = OFF_BAR + 16384;
constexpr size_t OFF_RT64 = OFF_RT32 + (size_t)S_ * 16 * 8;
constexpr size_t OFF_RT128 = OFF_RT64 + (size_t)S_ * 32 * 8;
constexpr size_t OFF_S5Z = OFF_RT128 + (size_t)S_ * 64 * 8;
constexpr size_t OFF_BBAR = OFF_S5Z + 2 * 32 * 64 * 16;
constexpr size_t OFF_KTAB = OFF_BBAR + 2 * 32 * 64 * 16 * 8;
constexpr size_t OFF_W_ATTIN = OFF_KTAB + 2 * 32 * 32 * 256 * 4;
constexpr size_t OFF_W_UQ = OFF_W_ATTIN + (size_t)2 * 1536 * LDW1 * 2;
constexpr size_t OFF_W_UKV = OFF_W_UQ + (size_t)2 * 768 * 384 * 2;
constexpr size_t OFF_W_ATTOUT = OFF_W_UKV + (size_t)2 * 1024 * 256 * 2;
constexpr size_t OFF_W_RECIN = OFF_W_ATTOUT + (size_t)2 * 1024 * LDW1 * 2;
constexpr size_t OFF_W_GLU = OFF_W_RECIN + (size_t)2 * 2560 * LDW1 * 2;
constexpr size_t OFF_W_RECOUT = OFF_W_GLU + (size_t)2 * 512 * LDGLU * 2;
constexpr size_t OFF_W1 = OFF_W_RECOUT + (size_t)2 * 1024 * LDW1 * 2;
constexpr size_t OFF_W2 = OFF_W1 + (size_t)4 * 4096 * LDW1 * 2;
constexpr size_t OFF_WE = OFF_W2 + (size_t)4 * 1024 * LDW2 * 2;
constexpr size_t OFF_WY = OFF_WE + (size_t)32 * 256 * 512 * 2;
constexpr size_t OFF_HY = OFF_WY + (size_t)32 * 512 * 640 * 2;
constexpr size_t OFF_RA = OFF_HY + (size_t)T_ * LDH * 2;
constexpr size_t OFF_ZC = OFF_RA;
constexpr size_t OFF_QB = OFF_ZC + (size_t)T_ * 640 * 2;
constexpr size_t OFF_KB = OFF_QB + (size_t)T_ * 768 * 2;
constexpr size_t OFF_VT = OFF_KB + (size_t)T_ * LDKB * 2;
constexpr size_t OFF_SQ = OFF_VT + (size_t)2 * 8 * 64 * LDV * 2;
constexpr size_t OFF_SK = OFF_SQ + (size_t)T_ * 512 * 2;
constexpr size_t OFF_SV = OFF_SK + (size_t)T_ * 128 * 2;
constexpr size_t OFF_OE = OFF_SV + (size_t)T_ * 128 * 2;
constexpr size_t END_EVEN = OFF_OE + (size_t)T_ * LDH * 2;
constexpr size_t OFF_ZR = OFF_RA;
constexpr size_t OFF_UG = OFF_ZR + (size_t)T_ * LDZR * 2;
constexpr size_t OFF_UO = OFF_UG + (size_t)T_ * 512 * 2;
constexpr size_t OFF_SP = OFF_UO + (size_t)T_ * LDH * 2;
constexpr size_t OFF_EB = OFF_SP + (size_t)T_ * 512 * 2;
constexpr size_t OFF_XP = OFF_EB + (size_t)32 * 1024 * 128 * 4;
constexpr size_t OFF_YT = OFF_HY;
constexpr size_t END_ODD = OFF_XP + (size_t)32 * 1024 * 128 * 2;
constexpr size_t OFF_HID = OFF_RA;
constexpr size_t END_MLP = OFF_HID + (size_t)T_ * LDHID * 2;
constexpr size_t WS_NEED = END_ODD > END_EVEN ? (END_ODD > END_MLP ? END_ODD : END_MLP) : (END_EVEN > END_MLP ? END_EVEN : END_MLP);

constexpr int NTHR = 512;
constexpr int HALF_SMEM = 73728 + 1024;
constexpr int SMEM_GEMM = 131072;
constexpr int SMEM_BYTES = 2 * HALF_SMEM;
constexpr int NPHASE = 38;

struct Params {
  const float *x, *c, *ada_w, *ada_b, *ln_g, *ln_b, *att_w_in, *mla_q_norm, *mla_w_uq, *mla_kv_norm, *mla_w_ukv,
      *swa_sinks, *att_w_out, *rec_w_in, *s5_a_re, *s5_a_im, *s5_log_step, *s5_b_re, *s5_b_im, *s5_c_re, *s5_c_im,
      *s5_d, *s5_glu_w, *s5_glu_b, *rec_w_out, *mlp_w1, *mlp_w2;
  float* out;
  char* ws;
};

#define XB_TMO      128
#define XB_XCNT(j)  (256  + 64 * (j))
#define XB_XSUB(j)  (1280 + 64 * (j))
#define XB_XGEN(j)  (2304 + 64 * (j))
#define XB_TOP      3328
#define XB_TOPGEN   3392
#define XCD_BAR_WORDS 3456
#define XB_SPIN_CAP (1u << 18)
#define LAS __attribute__((address_space(3)))

__device__ __forceinline__ unsigned xb_ld(unsigned* p)              { return __hip_atomic_load(p, __ATOMIC_RELAXED, __HIP_MEMORY_SCOPE_AGENT); }
__device__ __forceinline__ unsigned xb_add(unsigned* p, unsigned v) { return __hip_atomic_fetch_add(p, v, __ATOMIC_RELAXED, __HIP_MEMORY_SCOPE_AGENT); }
__device__ __forceinline__ unsigned xb_xcc_id() { return (unsigned)__builtin_amdgcn_s_getreg((3 << 11) | 20) & 0xFu; }
#define XB_SPIN(cond, bar) do { unsigned _sp = 0; while (cond) { __builtin_amdgcn_s_sleep(1); \
    if ((++_sp & 255u) == 0u) { if (xb_ld(&(bar)[XB_TMO])) break; if (_sp > XB_SPIN_CAP) { atomicAdd(&(bar)[XB_TMO], 1u); break; } } } } while (0)

struct XcdBarrier {
    unsigned* bar; unsigned x;
    volatile LAS unsigned* st;
};

__device__ __forceinline__ XcdBarrier xcd_barrier_post(unsigned* bar, volatile LAS unsigned* st) {
    XcdBarrier b; b.bar = bar; b.x = xb_xcc_id(); b.st = st;
    if (threadIdx.x == 0) (void)xb_add(&bar[XB_XCNT(b.x)], 1u);
    return b;
}
__device__ __forceinline__ void xcd_barrier_complete(unsigned* bar, unsigned x, unsigned& nloc, unsigned& nx) {
    const unsigned G = gridDim.x * gridDim.y * gridDim.z;
    unsigned sum, cnt, mine, sp = 0u;
    for (;;) {
        sum = 0u; cnt = 0u; mine = 0u;
#pragma unroll
        for (unsigned j = 0; j < 16; ++j) { const unsigned c = xb_ld(&bar[XB_XCNT(j)]); sum += c; cnt += (c > 0u) ? 1u : 0u; mine = (j == x) ? c : mine; }
        if (sum == G) break;
        __builtin_amdgcn_s_sleep(1);
        if ((++sp & 255u) == 0u) { if (xb_ld(&bar[XB_TMO])) break; if (sp > XB_SPIN_CAP) { atomicAdd(&bar[XB_TMO], 1u); break; } }
    }
    nloc = mine > 0u ? mine : 1u; nx = cnt > 0u ? cnt : 1u;
}

__device__ __forceinline__ void xcd_barrier(const XcdBarrier& b) {
    asm volatile("s_waitcnt vmcnt(0)" ::: "memory");
    __syncthreads();
    if (threadIdx.x == 0) {
        unsigned* bar = b.bar;
        __builtin_amdgcn_s_waitcnt(0);
        unsigned nloc = b.st[0], nx = b.st[1];
        if (nloc == 0u) { xcd_barrier_complete(bar, b.x, nloc, nx); b.st[0] = nloc; b.st[1] = nx; }
        const unsigned old = xb_add(&bar[XB_XSUB(b.x)], 1u);
        const unsigned gen = old / nloc;
        if (old + 1u == (gen + 1u) * nloc) {
            __builtin_amdgcn_fence(__ATOMIC_RELEASE, "agent");
            asm volatile("s_waitcnt vmcnt(0)" ::: "memory");
            const unsigned og = xb_add(&bar[XB_TOP], 1u);
            const unsigned tg = og / nx;
            if (og + 1u == (tg + 1u) * nx) xb_add(&bar[XB_TOPGEN], 1u);
            else XB_SPIN(xb_ld(&bar[XB_TOPGEN]) == tg, bar);
            __builtin_amdgcn_fence(__ATOMIC_ACQUIRE, "agent");
            xb_add(&bar[XB_XGEN(b.x)], 1u);
            asm volatile("s_waitcnt vmcnt(0)" ::: "memory");
        } else {
            XB_SPIN(xb_ld(&bar[XB_XGEN(b.x)]) == gen, bar);
            __builtin_amdgcn_fence(__ATOMIC_ACQUIRE, "agent");
            asm volatile("s_waitcnt vmcnt(0)" ::: "memory");
        }
    }
    __syncthreads();
}


typedef __bf16 bf2_t __attribute__((ext_vector_type(2)));
typedef float f2_t __attribute__((ext_vector_type(2)));
DI u16 f2bf(float x) { __bf16 r = (__bf16)x; return __builtin_bit_cast(u16, r); }
DI float bf2f(unsigned h) { return __uint_as_float(h << 16); }
DI unsigned pack2(float a, float b) { f2_t v = {a, b}; bf2_t r = __builtin_convertvector(v, bf2_t); return __builtin_bit_cast(unsigned, r); }
DI int crow(int r, int hf) { return (r & 3) + 8 * (r >> 2) + 4 * hf; }
DI float ex2(float x) { return __builtin_amdgcn_exp2f(x); }
DI bf16x8 pack8(const f32x16& x, int s) {
  uint4 u;
  u.x = pack2(x[8 * s + 0], x[8 * s + 1]); u.y = pack2(x[8 * s + 2], x[8 * s + 3]);
  u.z = pack2(x[8 * s + 4], x[8 * s + 5]); u.w = pack2(x[8 * s + 6], x[8 * s + 7]);
  return __builtin_bit_cast(bf16x8, u);
}
DI bf16x8 join8(uint2 lo, uint2 hi) { uint4 u = make_uint4(lo.x, lo.y, hi.x, hi.y); return __builtin_bit_cast(bf16x8, u); }
DI f32x16 zero16() { f32x16 z; for (int i = 0; i < 16; ++i) z[i] = 0.f; return z; }
DI int opqv(int x) { asm volatile("" : "+v"(x)); return x; }
DI char* opq(char* p) { asm volatile("" : "+s"(p)); return p; }
DI void sincos_(float x, float& sn, float& cs) { float s_, c_; sincosf(x, &s_, &c_); sn = s_; cs = c_; }
DI float lg2gamma(int h) { return log2f(1.0f - exp2f(-5.0f - (float)h)); }

template <int V = 0, class Epi>
DI void gemm_tile(const u16* A1, long lda1, int nk1, const u16* A2, long lda2, int nk2, const u16* Bt, long ldb,
                  char* smem, Epi&& epi) {
  const int tid = opqv(threadIdx.x), lane = tid & 63, w = tid >> 6, wm = w >> 2, wn = w & 3, l32 = lane & 31, hf = lane >> 5;
  f32x16 acc[2][2][2];
#pragma unroll
  for (int h = 0; h < 2; ++h)
#pragma unroll
    for (int i = 0; i < 2; ++i)
#pragma unroll
      for (int j = 0; j < 2; ++j) acc[h][i][j] = zero16();
  const int nk = nk1 + nk2;
  const int drow = lane >> 3, dslot = lane & 7, x7 = (l32 >> 1) & 7;
#define GLDS(KT, BUF) { const int kt_ = (KT); const u16* Ab; long lda; \
    if (kt_ < nk1) { Ab = A1 + kt_ * 64; lda = lda1; } else { Ab = A2 + (kt_ - nk1) * 64; lda = lda2; } \
    _Pragma("unroll") for (int q = 0; q < 4; ++q) { \
      const int r = (w * 4 + q) * 8 + drow; const int c = dslot ^ ((r >> 1) & 7); \
      __builtin_amdgcn_global_load_lds((const unsigned*)(Ab + (long)r * lda + c * 8), (lds_u32*)(smem + (BUF) * 65536 + (w * 4 + q) * 1024), 16, 0, 0); \
      __builtin_amdgcn_global_load_lds((const unsigned*)(Bt + (long)r * ldb + kt_ * 64 + c * 8), (lds_u32*)(smem + (BUF) * 65536 + 32768 + (w * 4 + q) * 1024), 16, 0, 0); } }
#define LFR(AF, BF, BUF, S0) { const char* a = smem + (BUF) * 65536; const char* b = a + 32768; \
    _Pragma("unroll") for (int i = 0; i < 4; ++i) AF[i] = *(const bf16x8*)(a + (wm * 128 + i * 32 + l32) * 128 + (((2 * (S0) + hf) ^ x7) << 4)); \
    _Pragma("unroll") for (int j = 0; j < 2; ++j) BF[j] = *(const bf16x8*)(b + (wn * 64 + j * 32 + l32) * 128 + (((2 * (S0) + hf) ^ x7) << 4)); }
#define MMA8(AF, BF) { \
    _Pragma("unroll") for (int i = 0; i < 4; ++i) \
      _Pragma("unroll") for (int j = 0; j < 2; ++j) acc[i >> 1][i & 1][j] = MFMA(AF[i], BF[j], acc[i >> 1][i & 1][j]); }
#define COMPUTE(BUF) { bf16x8 af0[4], bf0[2], af1[4], bf1[2]; \
    LFR(af0, bf0, BUF, 0); __builtin_amdgcn_sched_barrier(0); \
    LFR(af1, bf1, BUF, 1); MMA8(af0, bf0); __builtin_amdgcn_sched_barrier(0); \
    LFR(af0, bf0, BUF, 2); MMA8(af1, bf1); __builtin_amdgcn_sched_barrier(0); \
    LFR(af1, bf1, BUF, 3); MMA8(af0, bf0); __builtin_amdgcn_sched_barrier(0); \
    MMA8(af1, bf1); __builtin_amdgcn_sched_barrier(0); }
#define RAWBAR() { asm volatile("s_waitcnt vmcnt(0) lgkmcnt(0)" ::: "memory"); __builtin_amdgcn_s_barrier(); }
  if (V != 1) GLDS(0, 0);
  RAWBAR();
  for (int kt = 0; kt < nk; kt += 2) {
    if (V != 1) GLDS(kt + 1, 1);
    if (V != 2) COMPUTE(0);
    RAWBAR();
    if (V != 1) if (kt + 2 < nk) GLDS(kt + 2, 0);
    if (V != 2) COMPUTE(1);
    RAWBAR();
  }
#undef GLDS
#undef LFR
#undef MMA8
#undef COMPUTE
#undef RAWBAR
  epi(acc[0], wm * 64);
  epi(acc[1], wm * 64 + 64);
}

DI void tile_map(int lt, int nM8, int nN, int GM, int GN, int& mt, int& nt) {
  const int G = GM * GN, xcd = blockIdx.x & 7, group = lt / G, within = lt - group * G, ngn = nN / GN;
  const int mg = group / ngn, ng = group - mg * ngn;
  mt = xcd * nM8 + mg * GM + within / GN;
  nt = ng * GN + within % GN;
}

DI int colmap(int mode, int n) {
  if (mode == 1) { if (n < 640) return n; if (n < 1408) return n + 32; if (n < 1440) return n - 1408 + 640; return -1; }
  if (mode == 2) { if (n < 512) return (n >> 6) * 96 + (n & 63); int m = n - 512; return (m >> 5) * 96 + 64 + (m & 31); }
  if (mode == 3) { if (n < 1024) { int dl = n & 127, b4 = dl >> 5; int sb = (b4 == 1) ? 2 : (b4 == 2 ? 1 : b4); return (n & ~127) + sb * 32 + (dl & 31); } return n; }
  return n;
}
DI void conv_job(const float* src, int K, int N, u16* dst, int ldk, int Npad, const float* kscale, int mode, float* lds) {
  const int tid = opqv(threadIdx.x);
  const int nKt = K / 64, nNt = Npad / 64;
  for (int tile = blockIdx.x; tile < nKt * nNt; tile += gridDim.x) {
    const int nt = tile / nKt, kt = tile % nKt;
    const int nl = tid & 63, kq = tid >> 6;
    const int col = colmap(mode, nt * 64 + nl);
    for (int i = 0; i < 8; ++i) {
      const int kl = kq + 8 * i, k = kt * 64 + kl;
      float v = 0.f;
      if (col >= 0) { v = src[(size_t)k * N + col]; if (kscale) v *= kscale[k]; }
      lds[kl * 65 + nl] = v;
    }
    __syncthreads();
    for (int i = 0; i < 8; ++i) {
      const int n2 = kq + 8 * i;
      dst[(size_t)(nt * 64 + n2) * ldk + kt * 64 + nl] = f2bf(lds[nl * 65 + n2]);
    }
    __syncthreads();
  }
}

DI void phase0(const Params& p, char* smem) {
  const int tid = opqv(threadIdx.x), nb = gridDim.x, bid = blockIdx.x;
  char* ws = opq(p.ws);
  if (bid == 0 && tid < 64) ((int*)(ws + OFF_CTR))[tid] = 0;
  {
    float* cond = (float*)smem; float* red = cond + 2048; float* mod = (float*)(ws + OFF_MOD);
    for (int i = tid; i < 2048; i += NTHR) { float v = p.c[i]; cond[i] = v / (1.f + expf(-v)); }
    __syncthreads();
    for (int it = bid; it < 8 * 48; it += nb) {
      const int ls = it / 48, cgp = it % 48, tx = tid & 15, ty = tid >> 4;
      const float* wp = p.ada_w + (size_t)ls * 1024 * 3072 + cgp * 64 + tx * 4;
      float4 a0 = make_float4(0, 0, 0, 0), a1 = make_float4(0, 0, 0, 0);
      for (int k = ty * 32; k < ty * 32 + 32; ++k) {
        const float4 wv = *(const float4*)(wp + (size_t)k * 3072);
        const float c0 = cond[k], c1 = cond[1024 + k];
        a0.x += c0 * wv.x; a0.y += c0 * wv.y; a0.z += c0 * wv.z; a0.w += c0 * wv.w;
        a1.x += c1 * wv.x; a1.y += c1 * wv.y; a1.z += c1 * wv.z; a1.w += c1 * wv.w;
      }
      *(float4*)(red + (ty * 2 + 0) * 64 + tx * 4) = a0;
      *(float4*)(red + (ty * 2 + 1) * 64 + tx * 4) = a1;
      __syncthreads();
      if (tid < 128) {
        const int b = tid >> 6, col = tid & 63; float s = 0.f;
        for (int y = 0; y < 32; ++y) s += red[(y * 2 + b) * 64 + col];
        const int j = cgp * 64 + col;
        mod[(ls * 2 + b) * 3072 + j] = s + p.ada_b[ls * 3072 + j];
      }
      __syncthreads();
    }
  }
  {
    float* lds = (float*)smem;
    for (int j = 0; j < 2; ++j) {
      conv_job(p.att_w_in + (size_t)j * 1024 * 1440, 1024, 1440, (u16*)(ws + OFF_W_ATTIN) + (size_t)j * 1536 * LDW1, LDW1, 1536, nullptr, 1, lds);
      conv_job(p.mla_w_uq + (size_t)j * 384 * 768, 384, 768, (u16*)(ws + OFF_W_UQ) + (size_t)j * 768 * 384, 384, 768, p.mla_q_norm + j * 384, 2, lds);
      conv_job(p.mla_w_ukv + (size_t)j * 256 * 1024, 256, 1024, (u16*)(ws + OFF_W_UKV) + (size_t)j * 1024 * 256, 256, 1024, p.mla_kv_norm + j * 256, 0, lds);
      conv_job(p.att_w_out + (size_t)j * 1024 * 1024, 1024, 1024, (u16*)(ws + OFF_W_ATTOUT) + (size_t)j * 1024 * LDW1, LDW1, 1024, nullptr, 0, lds);
      conv_job(p.rec_w_in + (size_t)j * 1024 * 2560, 1024, 2560, (u16*)(ws + OFF_W_RECIN) + (size_t)j * 2560 * LDW1, LDW1, 2560, nullptr, 3, lds);
      conv_job(p.s5_glu_w + (size_t)j * 512 * 512, 512, 512, (u16*)(ws + OFF_W_GLU) + (size_t)j * 512 * LDGLU, LDGLU, 512, nullptr, 0, lds);
      conv_job(p.rec_w_out + (size_t)j * 1024 * 1024, 1024, 1024, (u16*)(ws + OFF_W_RECOUT) + (size_t)j * 1024 * LDW1, LDW1, 1024, nullptr, 0, lds);
    }
    for (int l = 0; l < 4; ++l) {
      conv_job(p.mlp_w1 + (size_t)l * 1024 * 4096, 1024, 4096, (u16*)(ws + OFF_W1) + (size_t)l * 4096 * LDW1, LDW1, 4096, nullptr, 0, lds);
      conv_job(p.mlp_w2 + (size_t)l * 4096 * 1024, 4096, 1024, (u16*)(ws + OFF_W2) + (size_t)l * 1024 * LDW2, LDW2, 1024, nullptr, 0, lds);
    }
  }
  {
    float2* rt32 = (float2*)(ws + OFF_RT32); float2* rt64 = (float2*)(ws + OFF_RT64); float2* rt128 = (float2*)(ws + OFF_RT128);
    for (int idx = bid * NTHR + tid; idx < S_ * 112; idx += nb * NTHR) {
      const int s = idx / 112, r = idx % 112;
      int dim, i; float2* dst;
      if (r < 16) { dim = 32; i = r; dst = rt32 + s * 16 + i; }
      else if (r < 48) { dim = 64; i = r - 16; dst = rt64 + s * 32 + i; }
      else { dim = 128; i = r - 48; dst = rt128 + s * 64 + i; }
      const float inv = powf(10000.0f, -((float)(2 * i)) / (float)dim);
      const float ang = (float)s * inv;
      float sn_, cs_; sincos_(ang, sn_, cs_);
      *dst = make_float2(cs_, sn_);
    }
  }
  {
    float4* s5z = (float4*)(ws + OFF_S5Z); float2* bbar = (float2*)(ws + OFF_BBAR);
    for (int idx = bid * NTHR + tid; idx < 2 * 32 * 64; idx += nb * NTHR) {
      const int jg = idx >> 6;
      const float dt = expf(p.s5_log_step[jg]);
      const float lr = p.s5_a_re[idx], li = p.s5_a_im[idx];
      const float zr = lr * dt, zi = li * dt, mag = expf(zr);
      float sn_, cs_; sincos_(zi, sn_, cs_);
      const float ar = mag * cs_, ai = mag * sn_;
      const float den = lr * lr + li * li;
      const float cr = ((ar - 1.f) * lr + ai * li) / den, ci = (ai * lr - (ar - 1.f) * li) / den;
      s5z[idx] = make_float4(zr, zi, ar, ai);
      for (int q = 0; q < 16; ++q) {
        const float br = p.s5_b_re[idx * 16 + q], bi = p.s5_b_im[idx * 16 + q];
        bbar[idx * 16 + q] = make_float2(cr * br - ci * bi, cr * bi + ci * br);
      }
    }
  }
}

DI void phase1(const Params& p) {
  const int tid = opqv(threadIdx.x), nb = gridDim.x, bid = blockIdx.x;
  char* ws = opq(p.ws);
  const float* mod = (const float*)(ws + OFF_MOD);
  u16* hy = (u16*)(ws + OFF_HY);
  for (int i = bid * NTHR + tid; i < T_ * 256; i += nb * NTHR) {
    const int t = i >> 8, c4 = (i & 255) * 4, b = t >> 14;
    const float4 xv = *(const float4*)(p.x + (size_t)i * 4);
    const float4 sh = *(const float4*)(mod + b * 3072 + c4);
    const float4 sc = *(const float4*)(mod + b * 3072 + 1024 + c4);
    uint2 o;
    o.x = pack2(xv.x * (1.f + sc.x) + sh.x, xv.y * (1.f + sc.y) + sh.y);
    o.y = pack2(xv.z * (1.f + sc.z) + sh.z, xv.w * (1.f + sc.w) + sh.w);
    *(uint2*)(hy + (size_t)t * LDH + c4) = o;
  }
  const float4* s5z = (const float4*)(ws + OFF_S5Z); const float2* bbar = (const float2*)(ws + OFF_BBAR);
  float* ktab = (float*)(ws + OFF_KTAB);
  for (int idx = bid * NTHR + tid; idx < 2 * 32 * 256; idx += nb * NTHR) {
    const int q = idx & 15, pp = (idx >> 4) & 15, jg = idx >> 8;
    float acc[32];
#pragma unroll
    for (int d = 0; d < 32; ++d) acc[d] = 0.f;
    for (int n = 0; n < 64; ++n) {
      const float4 z = s5z[jg * 64 + n];
      const float2 bb = bbar[(jg * 64 + n) * 16 + q];
      const float cr = p.s5_c_re[(jg * 16 + pp) * 64 + n], ci = p.s5_c_im[(jg * 16 + pp) * 64 + n];
      const float wr = cr * bb.x - ci * bb.y, wi = cr * bb.y + ci * bb.x;
      float er = 1.f, ei = 0.f;
#pragma unroll
      for (int d = 0; d < 32; ++d) {
        acc[d] += wr * er - wi * ei;
        const float nr = er * z.z - ei * z.w, ni = er * z.w + ei * z.z;
        er = nr; ei = ni;
      }
    }
#pragma unroll
    for (int d = 0; d < 32; ++d) ktab[(jg * 32 + d) * 256 + pp * 16 + q] = acc[d];
  }
}

DI void ln_phase(const Params& p, int ls) {
  const int tid = opqv(threadIdx.x), lane = tid & 63, w = tid >> 6;
  char* ws = opq(p.ws);
  const float* mod = (const float*)(ws + OFF_MOD);
  u16* hy = (u16*)(ws + OFF_HY);
  const float* xin = (ls == 0) ? p.x : p.out;
  const float* lg = p.ln_g + ls * 1024; const float* lb = p.ln_b + ls * 1024;
  const int stride = gridDim.x * 8;
  f32x4 xc[4], xn[4]; uint2 yc[4], yn[4];
  {
    const int row = blockIdx.x * 8 + w;
#pragma unroll
    for (int i = 0; i < 4; ++i) {
      const int col = lane * 4 + 256 * i;
      xc[i] = *(const f32x4*)(xin + (size_t)row * 1024 + col);
      yc[i] = *(const uint2*)(hy + (size_t)row * LDH + col);
    }
  }
  for (int row = blockIdx.x * 8 + w; row < T_; row += stride) {
    const int b = row >> 14;
    const float* gate = mod + (ls * 2 + b) * 3072 + 2048;
    const int rn = row + stride;
    if (rn < T_) {
#pragma unroll
      for (int i = 0; i < 4; ++i) {
        const int col = lane * 4 + 256 * i;
        xn[i] = *(const f32x4*)(xin + (size_t)rn * 1024 + col);
        yn[i] = *(const uint2*)(hy + (size_t)rn * LDH + col);
      }
    }
    float v[16];
    float sum = 0.f;
#pragma unroll
    for (int i = 0; i < 4; ++i) {
      const int col = lane * 4 + 256 * i;
      const f32x4 xv = xc[i];
      const uint2 yv = yc[i];
      const float4 g = *(const float4*)(gate + col);
      v[4 * i + 0] = DN_ALPHA * xv.x + (1.f + g.x) * bf2f(yv.x & 0xffffu);
      v[4 * i + 1] = DN_ALPHA * xv.y + (1.f + g.y) * bf2f(yv.x >> 16);
      v[4 * i + 2] = DN_ALPHA * xv.z + (1.f + g.z) * bf2f(yv.y & 0xffffu);
      v[4 * i + 3] = DN_ALPHA * xv.w + (1.f + g.w) * bf2f(yv.y >> 16);
      sum += v[4 * i] + v[4 * i + 1] + v[4 * i + 2] + v[4 * i + 3];
    }
#pragma unroll
    for (int m = 32; m >= 1; m >>= 1) sum += __shfl_xor(sum, m);
    const float mean = sum * (1.f / 1024.f);
    float vs = 0.f;
#pragma unroll
    for (int i = 0; i < 16; ++i) { const float d = v[i] - mean; vs += d * d; }
#pragma unroll
    for (int m = 32; m >= 1; m >>= 1) vs += __shfl_xor(vs, m);
    const float rstd = rsqrtf(vs * (1.f / 1024.f) + 1e-5f);
#pragma unroll
    for (int i = 0; i < 4; ++i) {
      const int col = lane * 4 + 256 * i;
      const float4 g = *(const float4*)(lg + col); const float4 bb = *(const float4*)(lb + col);
      float4 o;
      o.x = (v[4 * i + 0] - mean) * rstd * g.x + bb.x; o.y = (v[4 * i + 1] - mean) * rstd * g.y + bb.y;
      o.z = (v[4 * i + 2] - mean) * rstd * g.z + bb.z; o.w = (v[4 * i + 3] - mean) * rstd * g.w + bb.w;
      *(float4*)(p.out + (size_t)row * 1024 + col) = o;
      if (ls < 7) {
        const float* m2 = mod + ((ls + 1) * 2 + b) * 3072;
        const float4 sh = *(const float4*)(m2 + col); const float4 sc = *(const float4*)(m2 + 1024 + col);
        uint2 h;
        h.x = pack2(o.x * (1.f + sc.x) + sh.x, o.y * (1.f + sc.y) + sh.y);
        h.y = pack2(o.z * (1.f + sc.z) + sh.z, o.w * (1.f + sc.w) + sh.w);
        *(uint2*)(hy + (size_t)row * LDH + col) = h;
      }
    }
#pragma unroll
    for (int i = 0; i < 4; ++i) { xc[i] = xn[i]; yc[i] = yn[i]; }
  }
}

template <int V = 0>
DI void gemm_plain(const u16* A, int lda, int K, const u16* Wt, int ldb, int N, u16* C, int ldc, int mode, char* smem) {
  const int tid = opqv(threadIdx.x), lane = tid & 63, w = tid >> 6, wm = w >> 2, wn = w & 3, l32 = lane & 31, hf = lane >> 5;
  const int nN = N / 256;
  for (int lt = blockIdx.x >> 3; lt < 16 * nN; lt += gridDim.x >> 3) {
    int mt, nt; tile_map(lt, 16, nN, 8, 4, mt, nt);
    const int m0 = mt * 256, n0 = nt * 256;
    gemm_tile<V>(A + (size_t)m0 * lda, lda, K / 64, nullptr, 0, 0, Wt + (size_t)n0 * ldb, ldb, smem, [&](f32x16(&acc)[2][2], int moff) {
      const int m0_ = m0 + moff;
      int l32_ = l32, hf_ = hf; asm volatile("" : "+v"(l32_), "+v"(hf_));
#pragma unroll
      for (int i = 0; i < 2; ++i)
#pragma unroll
        for (int j = 0; j < 2; ++j)
#pragma unroll
          for (int r = 0; r < 16; ++r) {
            const int row = m0_ + wm * 64 + i * 32 + crow(r, hf_), col = n0 + wn * 64 + j * 32 + l32_;
            float v = acc[i][j][r];
            if (mode == 1) { v = fmaxf(v, 0.f); v = v * v; }
            if (V == 0 || v == 123456.789f) C[(size_t)row * ldc + col] = f2bf(v);
          }
    });
  }
}

DI void att_in_phase(const Params& p, int j, char* smem) {
  const int tid = opqv(threadIdx.x), lane = tid & 63, w = tid >> 6, wm = w >> 2, wn = w & 3, l32 = lane & 31, hf = lane >> 5;
  char* ws = opq(p.ws);
  const u16* A = (const u16*)(ws + OFF_HY);
  const u16* Wt = (const u16*)(ws + OFF_W_ATTIN) + (size_t)j * 1536 * LDW1;
  u16* zc = (u16*)(ws + OFF_ZC); u16* SQ = (u16*)(ws + OFF_SQ); u16* SK = (u16*)(ws + OFF_SK); u16* SV = (u16*)(ws + OFF_SV);
  u16* Kb = (u16*)(ws + OFF_KB);
  const float2* rt64 = (const float2*)(ws + OFF_RT64); const float2* rt32 = (const float2*)(ws + OFF_RT32);
  const int nN = 6;
  for (int lt = blockIdx.x >> 3; lt < 16 * nN; lt += gridDim.x >> 3) {
    int mt, nt; tile_map(lt, 16, nN, 16, 2, mt, nt);
    const int m0 = mt * 256, n0 = nt * 256;
    gemm_tile(A + (size_t)m0 * LDH, LDH, 16, nullptr, 0, 0, Wt + (size_t)n0 * LDW1, LDW1, smem, [&](f32x16(&acc)[2][2], int moff) {
      const int m0_ = m0 + moff;
      int l32_ = l32, hf_ = hf; asm volatile("" : "+v"(l32_), "+v"(hf_));
      const int C64 = n0 + wn * 64;
#pragma unroll
      for (int i = 0; i < 2; ++i) {
        const int rb = m0_ + wm * 64 + i * 32;
        if (C64 < 640) {
#pragma unroll
          for (int jn = 0; jn < 2; ++jn)
#pragma unroll
            for (int r = 0; r < 16; ++r) zc[(size_t)(rb + crow(r, hf_)) * 640 + C64 + jn * 32 + l32_] = f2bf(acc[i][jn][r]);
        } else if (C64 < 1280) {
          const bool isq = C64 < 1152;
          u16* dst = isq ? SQ : SK; const int pitch = isq ? 512 : 128; const int cb = isq ? (C64 - 640) : (C64 - 1152);
          const float sc = isq ? SWA_QSCALE : 1.f;
#pragma unroll
          for (int r = 0; r < 16; ++r) {
            const int t = rb + crow(r, hf_), pos = t & (S_ - 1);
            const float2 cs = rt64[pos * 32 + l32_];
            const float x1 = acc[i][0][r], x2 = acc[i][1][r];
            dst[(size_t)t * pitch + cb + l32_] = f2bf((x1 * cs.x - x2 * cs.y) * sc);
            dst[(size_t)t * pitch + cb + 32 + l32_] = f2bf((x2 * cs.x + x1 * cs.y) * sc);
          }
        } else if (C64 < 1408) {
#pragma unroll
          for (int jn = 0; jn < 2; ++jn)
#pragma unroll
            for (int r = 0; r < 16; ++r) SV[(size_t)(rb + crow(r, hf_)) * 128 + (C64 - 1280) + jn * 32 + l32_] = f2bf(acc[i][jn][r]);
        } else if (C64 == 1408) {
#pragma unroll
          for (int r = 0; r < 16; ++r) {
            const int t = rb + crow(r, hf_), pos = t & (S_ - 1);
            const float x = acc[i][0][r];
            const float xp = __shfl_xor(x, 16);
            const float2 cs = rt32[pos * 16 + (l32_ & 15)];
            const float o = (l32_ < 16) ? (x * cs.x - xp * cs.y) : (x * cs.x + xp * cs.y);
            const u16 v = f2bf(o);
#pragma unroll
            for (int h = 0; h < 8; ++h) Kb[(size_t)t * LDKB + h * 96 + 64 + l32_] = v;
          }
        }
      }
    });
  }
}

DI void qkv_phase(const Params& p, int j, char* smem) {
  const int tid = opqv(threadIdx.x), lane = tid & 63, w = tid >> 6, wm = w >> 2, wn = w & 3, l32 = lane & 31, hf = lane >> 5;
  char* ws = opq(p.ws);
  const u16* zc = (const u16*)(ws + OFF_ZC);
  const u16* Wq = (const u16*)(ws + OFF_W_UQ) + (size_t)j * 768 * 384;
  const u16* Wkv = (const u16*)(ws + OFF_W_UKV) + (size_t)j * 1024 * 256;
  u16* Qb = (u16*)(ws + OFF_QB); u16* Kb = (u16*)(ws + OFF_KB); u16* Vt = (u16*)(ws + OFF_VT);
  const float2* rt32 = (const float2*)(ws + OFF_RT32);
  float* rsc = (float*)(smem + SMEM_GEMM);
  for (int lt0 = blockIdx.x >> 3; lt0 < 16 * 7; lt0 += gridDim.x >> 3) {
    const bool isq = lt0 < 16 * 3;
    int mt, nt;
    if (isq) tile_map(lt0, 16, 3, 16, 1, mt, nt); else tile_map(lt0 - 16 * 3, 16, 4, 8, 4, mt, nt);
    const int m0 = mt * 256, n0 = nt * 256;
    const int coff = isq ? 0 : 384, ncols = isq ? 384 : 256;
    {
      const int row = tid >> 1, half = tid & 1, nh = ncols / 2;
      const u16* src = zc + (size_t)(m0 + row) * 640 + coff + half * nh;
      float s = 0.f;
      for (int c = 0; c < nh; c += 8) {
        const uint4 v = *(const uint4*)(src + c);
        float f;
        f = bf2f(v.x & 0xffffu); s += f * f; f = bf2f(v.x >> 16); s += f * f;
        f = bf2f(v.y & 0xffffu); s += f * f; f = bf2f(v.y >> 16); s += f * f;
        f = bf2f(v.z & 0xffffu); s += f * f; f = bf2f(v.z >> 16); s += f * f;
        f = bf2f(v.w & 0xffffu); s += f * f; f = bf2f(v.w >> 16); s += f * f;
      }
      s += __shfl_xor(s, 1);
      if (half == 0) rsc[row] = rsqrtf(s / (float)ncols + 1e-6f);
    }
    __syncthreads();
    if (isq) {
      gemm_tile(zc + (size_t)m0 * 640, 640, 6, nullptr, 0, 0, Wq + (size_t)n0 * 384, 384, smem, [&](f32x16(&acc)[2][2], int moff) {
      const int m0_ = m0 + moff;
      int l32_ = l32, hf_ = hf; asm volatile("" : "+v"(l32_), "+v"(hf_));
        const int C64 = n0 + wn * 64;
#pragma unroll
        for (int i = 0; i < 2; ++i) {
          const int rl = wm * 64 + i * 32;
#pragma unroll
          for (int jn = 0; jn < 2; ++jn)
#pragma unroll
            for (int r = 0; r < 16; ++r) {
              const int rr = rl + crow(r, hf_), t = m0_ + rr;
              const float x = acc[i][jn][r] * rsc[moff + rr] * MLA_QSCALE;
              if (C64 < 512) {
                Qb[(size_t)t * 768 + (C64 >> 6) * 96 + jn * 32 + l32_] = f2bf(x);
              } else {
                const int hq = ((C64 - 512) >> 5) + jn, pos = t & (S_ - 1);
                const float xp = __shfl_xor(x, 16);
                const float2 cs = rt32[pos * 16 + (l32_ & 15)];
                const float o = (l32_ < 16) ? (x * cs.x - xp * cs.y) : (x * cs.x + xp * cs.y);
                Qb[(size_t)t * 768 + hq * 96 + 64 + l32_] = f2bf(o);
              }
            }
        }
      });
    } else {
      gemm_tile(zc + (size_t)m0 * 640 + 384, 640, 4, nullptr, 0, 0, Wkv + (size_t)n0 * 256, 256, smem, [&](f32x16(&acc)[2][2], int moff) {
      const int m0_ = m0 + moff;
      int l32_ = l32, hf_ = hf; asm volatile("" : "+v"(l32_), "+v"(hf_));
        const int C64 = n0 + wn * 64, h = C64 >> 7, part = (C64 >> 6) & 1;
#pragma unroll
        for (int i = 0; i < 2; ++i) {
          const int rl = wm * 64 + i * 32;
#pragma unroll
          for (int jn = 0; jn < 2; ++jn) {
            if (part == 0) {
#pragma unroll
              for (int r = 0; r < 16; ++r) {
                const int rr = rl + crow(r, hf_), t = m0_ + rr;
                Kb[(size_t)t * LDKB + h * 96 + jn * 32 + l32_] = f2bf(acc[i][jn][r] * rsc[moff + rr]);
              }
            } else {
              const int e = jn * 32 + l32_;
#pragma unroll
              for (int qd = 0; qd < 4; ++qd) {
                const int rr = rl + 8 * qd + 4 * hf_, t0 = m0_ + rr, b = t0 >> 14, s0 = t0 & (S_ - 1);
                uint2 o;
                o.x = pack2(acc[i][jn][4 * qd + 0] * rsc[moff + rr + 0], acc[i][jn][4 * qd + 1] * rsc[moff + rr + 1]);
                o.y = pack2(acc[i][jn][4 * qd + 2] * rsc[moff + rr + 2], acc[i][jn][4 * qd + 3] * rsc[moff + rr + 3]);
                *(uint2*)(Vt + ((size_t)((b * 8 + h) * 64 + e)) * LDV + s0) = o;
              }
            }
          }
        }
      });
    }
    __syncthreads();
  }
}

constexpr int MLA_BUF = 64 * 208 + 64 * 136;
constexpr int MLA_SVP = 264;
constexpr int MLA_BUF2 = 128 * 208 + 64 * MLA_SVP;
DI void mla_item(const Params& p, int qb, int b, int h, char* smem) {
  const int tid = opqv(threadIdx.x), lane = tid & 63, w = tid >> 6, l32 = lane & 31, hf = lane >> 5;
  char* ws = opq(p.ws);
  const u16* Qb = (const u16*)(ws + OFF_QB); u16* o = (u16*)(ws + OFF_OE);
  const int q0 = qb * 256 + w * 32;
  const size_t tq = (size_t)b * S_ + q0 + l32;
  bf16x8 qf[6];
#pragma unroll
  for (int s = 0; s < 6; ++s) qf[s] = *(const bf16x8*)(Qb + tq * 768 + h * 96 + s * 16 + hf * 8);
  f32x16 ot[2]; ot[0] = zero16(); ot[1] = zero16();
  float m = -1e30f, l = 0.f;
  const int ntile = 2 * qb + 2;
  const u16* Kg = (const u16*)(ws + OFF_KB) + ((size_t)b * S_) * LDKB + h * 96;
  const u16* Vg = (const u16*)(ws + OFF_VT) + ((size_t)(b * 8 + h) * 64) * LDV;
  u32x4 rk[2][3], rv[2][2];
#define MGLOAD(SET, KT) { const int kt_ = (KT); \
    _Pragma("unroll") for (int i = 0; i < 3; ++i) { const int c = tid + 512 * i, row = c / 12, ch = c % 12; rk[SET][i] = *(const u32x4*)(Kg + (size_t)(kt_ * 128 + row) * LDKB + ch * 8); } \
    _Pragma("unroll") for (int i = 0; i < 2; ++i) { const int c = tid + 512 * i, row = c >> 4, ch = c & 15; rv[SET][i] = *(const u32x4*)(Vg + (size_t)row * LDV + kt_ * 128 + ch * 8); } }
#define MSWRITE(SET, BUF) { char* sk_ = smem + (BUF) * MLA_BUF2; char* sv_ = sk_ + 128 * 208; \
    _Pragma("unroll") for (int i = 0; i < 3; ++i) { const int c = tid + 512 * i, row = c / 12, ch = c % 12; *(u32x4*)(sk_ + row * 208 + ch * 16) = rk[SET][i]; } \
    _Pragma("unroll") for (int i = 0; i < 2; ++i) { const int c = tid + 512 * i, row = c >> 4, ch = c & 15; \
      *(uint2*)(sv_ + row * MLA_SVP + ch * 16) = make_uint2(rv[SET][i].x, rv[SET][i].y); \
      *(uint2*)(sv_ + row * MLA_SVP + ch * 16 + 8) = make_uint2(rv[SET][i].z, rv[SET][i].w); } }
  auto compute = [&](int kt, int sub) {
    const char* sk = smem + (kt & 1) * MLA_BUF2 + sub * (64 * 208); const char* sv = smem + (kt & 1) * MLA_BUF2 + 128 * 208 + sub * 128;
    const int k0 = kt * 128 + sub * 64;
    if (k0 <= q0 + 31) {
      f32x16 st[2];
      bf16x8 kf[2][6];
#pragma unroll
      for (int t32 = 0; t32 < 2; ++t32)
#pragma unroll
        for (int s = 0; s < 6; ++s) kf[t32][s] = *(const bf16x8*)(sk + (t32 * 32 + l32) * 208 + (s * 16 + hf * 8) * 2);
      __builtin_amdgcn_sched_barrier(0);
      __builtin_amdgcn_s_setprio(1);
#pragma unroll
      for (int t32 = 0; t32 < 2; ++t32) {
        st[t32] = zero16();
#pragma unroll
        for (int s = 0; s < 6; ++s) st[t32] = MFMA(kf[t32][s], qf[s], st[t32]);
      }
      __builtin_amdgcn_s_setprio(0);
      bf16x8 vf[2][2][2];
#pragma unroll
      for (int t32 = 0; t32 < 2; ++t32)
#pragma unroll
        for (int s = 0; s < 2; ++s)
#pragma unroll
          for (int mt = 0; mt < 2; ++mt) {
            const char* vp = sv + (mt * 32 + l32) * MLA_SVP + (t32 * 32 + s * 16 + hf * 4) * 2;
            vf[t32][s][mt] = join8(*(const uint2*)vp, *(const uint2*)(vp + 16));
          }
      __builtin_amdgcn_sched_barrier(0);
      if (k0 + 63 > q0) {
        const int qpos = q0 + l32;
#pragma unroll
        for (int t32 = 0; t32 < 2; ++t32)
#pragma unroll
          for (int r = 0; r < 16; ++r) { const int key = k0 + t32 * 32 + crow(r, hf); if (key > qpos) st[t32][r] = -1e30f; }
      }
      float mx = -1e30f;
#pragma unroll
      for (int t32 = 0; t32 < 2; ++t32)
#pragma unroll
        for (int r = 0; r < 16; ++r) mx = fmaxf(mx, st[t32][r]);
      mx = fmaxf(mx, __shfl_xor(mx, 32));
      const float mn = fmaxf(m, mx);
      const float alpha = ex2(m - mn);
      m = mn;
      float ps = 0.f;
#pragma unroll
      for (int t32 = 0; t32 < 2; ++t32)
#pragma unroll
        for (int r = 0; r < 16; ++r) { const float pv = ex2(st[t32][r] - mn); st[t32][r] = pv; ps += pv; }
      l = l * alpha + ps;
#pragma unroll
      for (int mt = 0; mt < 2; ++mt)
#pragma unroll
        for (int r = 0; r < 16; ++r) ot[mt][r] *= alpha;
      __builtin_amdgcn_s_setprio(1);
#pragma unroll
      for (int t32 = 0; t32 < 2; ++t32)
#pragma unroll
        for (int s = 0; s < 2; ++s) {
          const bf16x8 pf = pack8(st[t32], s);
#pragma unroll
          for (int mt = 0; mt < 2; ++mt) ot[mt] = MFMA(vf[t32][s][mt], pf, ot[mt]);
        }
      __builtin_amdgcn_s_setprio(0);
    }
  };
  MGLOAD(0, 0); MGLOAD(1, 1);
  MSWRITE(0, 0); __syncthreads();
  for (int kt = 0; kt < ntile; kt += 2) {
    if (kt + 2 < ntile) MGLOAD(0, kt + 2);
    __builtin_amdgcn_sched_barrier(0);
    compute(kt, 0); compute(kt, 1);
    MSWRITE(1, 1);
    __syncthreads();
    if (kt + 3 < ntile) MGLOAD(1, kt + 3);
    __builtin_amdgcn_sched_barrier(0);
    compute(kt + 1, 0); compute(kt + 1, 1);
    if (kt + 2 < ntile) MSWRITE(0, 0);
    __syncthreads();
  }
#undef MGLOAD
#undef MSWRITE
  l += __shfl_xor(l, 32);
  const float inv = 1.f / l;
#pragma unroll
  for (int mt = 0; mt < 2; ++mt)
#pragma unroll
    for (int qd = 0; qd < 4; ++qd) {
      const int e0 = mt * 32 + 8 * qd + 4 * hf;
      uint2 ov;
      ov.x = pack2(ot[mt][4 * qd + 0] * inv, ot[mt][4 * qd + 1] * inv);
      ov.y = pack2(ot[mt][4 * qd + 2] * inv, ot[mt][4 * qd + 3] * inv);
      *(uint2*)(o + tq * LDH + h * 64 + e0) = ov;
    }
}

DI void swa_item(const Params& p, int j, int b, int nblk, int kvh, char* smem) {
  const int tid = opqv(threadIdx.x) & 255, lane = tid & 63, w = tid >> 6, l32 = lane & 31, hf = lane >> 5;
  char* ws = opq(p.ws);
  const u16* SQ = (const u16*)(ws + OFF_SQ); const u16* SK = (const u16*)(ws + OFF_SK); const u16* SV = (const u16*)(ws + OFF_SV);
  u16* o = (u16*)(ws + OFF_OE);
  char* sk = smem; char* sv = smem + 256 * 144;
  const int ws0 = 128 * (nblk - 1);
#pragma unroll
  for (int i = 0; i < 8; ++i) {
    const int c = tid + 256 * i, row = c >> 3, ch = c & 7, pos = ws0 + row;
    uint4 kv = make_uint4(0, 0, 0, 0), vv = make_uint4(0, 0, 0, 0);
    if (pos >= 0) {
      kv = *(const uint4*)(SK + ((size_t)b * S_ + pos) * 128 + kvh * 64 + ch * 8);
      vv = *(const uint4*)(SV + ((size_t)b * S_ + pos) * 128 + kvh * 64 + ch * 8);
    }
    *(uint4*)(sk + row * 144 + ch * 16) = kv;
    char* vb = sv + (ch * 8) * 528 + row * 2;
    *(u16*)(vb + 0 * 528) = (u16)(vv.x & 0xffffu); *(u16*)(vb + 1 * 528) = (u16)(vv.x >> 16);
    *(u16*)(vb + 2 * 528) = (u16)(vv.y & 0xffffu); *(u16*)(vb + 3 * 528) = (u16)(vv.y >> 16);
    *(u16*)(vb + 4 * 528) = (u16)(vv.z & 0xffffu); *(u16*)(vb + 5 * 528) = (u16)(vv.z >> 16);
    *(u16*)(vb + 6 * 528) = (u16)(vv.w & 0xffffu); *(u16*)(vb + 7 * 528) = (u16)(vv.w >> 16);
  }
  __syncthreads();
  const size_t tq = (size_t)b * S_ + nblk * 128 + w * 32 + l32;
  const int qloc = 128 + w * 32 + l32;
#pragma unroll 1
  for (int g = 0; g < 4; ++g) {
    const int head = kvh * 4 + g;
    bf16x8 qf[4];
#pragma unroll
    for (int s = 0; s < 4; ++s) qf[s] = *(const bf16x8*)(SQ + tq * 512 + head * 64 + s * 16 + hf * 8);
    f32x16 st[5];
    const float sink2 = p.swa_sinks[j * 8 + head] * LOG2E;
    float mx = sink2;
#pragma unroll
    for (int tt = 0; tt < 5; ++tt) {
      const int kb = w * 32 + tt * 32;
      st[tt] = zero16();
#pragma unroll
      for (int s = 0; s < 4; ++s) {
        const bf16x8 kf = *(const bf16x8*)(sk + (kb + l32) * 144 + (s * 16 + hf * 8) * 2);
        st[tt] = MFMA(kf, qf[s], st[tt]);
      }
#pragma unroll
      for (int r = 0; r < 16; ++r) {
        const int kloc = kb + crow(r, hf);
        const bool valid = (kloc <= qloc) && (kloc > qloc - 128) && (ws0 + kloc >= 0);
        const float v = valid ? st[tt][r] : -1e30f;
        st[tt][r] = v; mx = fmaxf(mx, v);
      }
    }
    mx = fmaxf(mx, __shfl_xor(mx, 32));
    float ps = 0.f;
#pragma unroll
    for (int tt = 0; tt < 5; ++tt)
#pragma unroll
      for (int r = 0; r < 16; ++r) { const float pv = ex2(st[tt][r] - mx); st[tt][r] = pv; ps += pv; }
    ps += __shfl_xor(ps, 32);
    const float inv = 1.f / (ps + ex2(sink2 - mx));
    f32x16 ot[2]; ot[0] = zero16(); ot[1] = zero16();
#pragma unroll
    for (int tt = 0; tt < 5; ++tt) {
      const int kb = w * 32 + tt * 32;
#pragma unroll
      for (int s = 0; s < 2; ++s) {
        const bf16x8 pf = pack8(st[tt], s);
#pragma unroll
        for (int mt = 0; mt < 2; ++mt) {
          const char* vp = sv + (mt * 32 + l32) * 528 + (kb + s * 16 + hf * 4) * 2;
          const bf16x8 vf = join8(*(const uint2*)vp, *(const uint2*)(vp + 16));
          ot[mt] = MFMA(vf, pf, ot[mt]);
        }
      }
    }
#pragma unroll
    for (int mt = 0; mt < 2; ++mt)
#pragma unroll
      for (int qd = 0; qd < 4; ++qd) {
        const int e0 = mt * 32 + 8 * qd + 4 * hf;
        uint2 ov;
        ov.x = pack2(ot[mt][4 * qd + 0] * inv, ot[mt][4 * qd + 1] * inv);
        ov.y = pack2(ot[mt][4 * qd + 2] * inv, ot[mt][4 * qd + 3] * inv);
        *(uint2*)(o + tq * LDH + 512 + head * 64 + e0) = ov;
      }
  }
  __syncthreads();
}

DI void attn_phase(const Params& p, int j, int ctr_idx, char* smem) {
  __shared__ int s_item;
  const int xcd = blockIdx.x & 7;
  int* ctr = (int*)(p.ws + OFF_CTR) + 16 + ctr_idx * 8 + xcd;
  const int nmla = 128, nswa = 32;
  const int half = opqv(threadIdx.x) >> 8;
  char* sm = smem + half * HALF_SMEM;
  for (;;) {
    __syncthreads();
    if (threadIdx.x == 0) s_item = atomicAdd(ctr, 1);
    __syncthreads();
    const int it = s_item;
    if (it >= nmla + nswa) break;
    if (it < nmla) {
      const int qb = 63 - (it >> 1), bh = xcd * 2 + (it & 1);
      mla_item(p, qb, bh >> 3, bh & 7, smem);
    } else {
      const int k = (xcd * nswa + (it - nmla)) * 2 + half;
      swa_item(p, j, k >> 8, (k >> 1) & 127, k & 1, sm);
    }
  }
}

DI void rec_in_phase(const Params& p, int j, char* smem) {
  const int tid = opqv(threadIdx.x), lane = tid & 63, w = tid >> 6, wm = w >> 2, wn = w & 3, l32 = lane & 31, hf = lane >> 5;
  char* ws = opq(p.ws);
  const u16* A = (const u16*)(ws + OFF_HY);
  const u16* Wt = (const u16*)(ws + OFF_W_RECIN) + (size_t)j * 2560 * LDW1;
  u16* zr = (u16*)(ws + OFF_ZR); u16* ug = (u16*)(ws + OFF_UG);
  const float2* rt128 = (const float2*)(ws + OFF_RT128);
  const int nN = 10;
  for (int lt = blockIdx.x >> 3; lt < 16 * nN; lt += gridDim.x >> 3) {
    int mt, nt; tile_map(lt, 16, nN, 16, 2, mt, nt);
    const int m0 = mt * 256, n0 = nt * 256;
    gemm_tile(A + (size_t)m0 * LDH, LDH, 16, nullptr, 0, 0, Wt + (size_t)n0 * LDW1, LDW1, smem, [&](f32x16(&acc)[2][2], int moff) {
      const int m0_ = m0 + moff;
      int l32_ = l32, hf_ = hf; asm volatile("" : "+v"(l32_), "+v"(hf_));
      const int C64 = n0 + wn * 64;
#pragma unroll
      for (int i = 0; i < 2; ++i) {
        const int rb = m0_ + wm * 64 + i * 32;
        if (C64 < 1024) {
          const int fi = ((C64 & 127) >> 1) + l32_, cbase = C64 & ~127;
          const float sc = (C64 >= 512) ? RET_KSCALE : 1.f;
#pragma unroll
          for (int r = 0; r < 16; ++r) {
            const int t = rb + crow(r, hf_), pos = t & (S_ - 1);
            const float2 cs = rt128[pos * 64 + fi];
            const float x1 = acc[i][0][r], x2 = acc[i][1][r];
            zr[(size_t)t * LDZR + cbase + fi] = f2bf((x1 * cs.x - x2 * cs.y) * sc);
            zr[(size_t)t * LDZR + cbase + 64 + fi] = f2bf((x2 * cs.x + x1 * cs.y) * sc);
          }
        } else if (C64 < 2048) {
#pragma unroll
          for (int jn = 0; jn < 2; ++jn)
#pragma unroll
            for (int r = 0; r < 16; ++r) zr[(size_t)(rb + crow(r, hf_)) * LDZR + C64 + jn * 32 + l32_] = f2bf(acc[i][jn][r]);
        } else {
#pragma unroll
          for (int jn = 0; jn < 2; ++jn) {
            const int cl = C64 - 2048 + jn * 32 + l32_, g = cl >> 4, pp = cl & 15;
#pragma unroll
            for (int r = 0; r < 16; ++r) ug[((size_t)g * T_ + rb + crow(r, hf_)) * 16 + pp] = f2bf(acc[i][jn][r]);
          }
        }
      }
    });
  }
}

DI void s5_fill(const Params& p, int j) {
  const int tid = opqv(threadIdx.x), nb = gridDim.x, bid = blockIdx.x;
  char* ws = opq(p.ws);
  const float4* s5z = (const float4*)(ws + OFF_S5Z) + j * 2048; const float2* bbar = (const float2*)(ws + OFF_BBAR) + j * 2048 * 16;
  const float* ktab = (const float*)(ws + OFF_KTAB) + (size_t)j * 32 * 32 * 256;
  u16* WE = (u16*)(ws + OFF_WE); u16* WY = (u16*)(ws + OFF_WY);
  for (int idx = bid * NTHR + tid; idx < 32 * 256 * 512; idx += nb * NTHR) {
    const int g = idx >> 17, n2 = (idx >> 9) & 255, k = idx & 511, jj = k >> 4, q = k & 15, n = n2 & 63;
    if (n2 >= 128) { WE[idx] = 0; continue; }
    const float4 z = s5z[g * 64 + n];
    const float d = (float)(31 - jj);
    const float mg = expf(d * z.x), ang = d * z.y; float sn_, cs_; sincos_(ang, sn_, cs_);
    const float er = mg * cs_, ei = mg * sn_;
    const float2 bb = bbar[(g * 64 + n) * 16 + q];
    const float v = (n2 < 64) ? (er * bb.x - ei * bb.y) : (er * bb.y + ei * bb.x);
    WE[idx] = f2bf(v);
  }
  for (int idx = bid * NTHR + tid; idx < 32 * 512 * 640; idx += nb * NTHR) {
    const int g = idx / (512 * 640), rem = idx - g * (512 * 640), mrow = rem / 640, k = rem - mrow * 640;
    const int i = mrow >> 4, pp = mrow & 15;
    float v;
    if (k < 512) {
      const int jj = k >> 4, q = k & 15, d = i - jj;
      v = (d >= 0) ? ktab[(g * 32 + d) * 256 + pp * 16 + q] : 0.f;
      if (d == 0 && q == pp) v += p.s5_d[j * 512 + g * 16 + pp];
    } else {
      const int n2 = k - 512, n = n2 & 63;
      const float4 z = s5z[g * 64 + n];
      const float d = (float)(i + 1);
      const float mg = expf(d * z.x), ang = d * z.y; float sn_, cs_; sincos_(ang, sn_, cs_);
    const float er = mg * cs_, ei = mg * sn_;
      const float cr = p.s5_c_re[((j * 32 + g) * 16 + pp) * 64 + n], ci = p.s5_c_im[((j * 32 + g) * 16 + pp) * 64 + n];
      v = (n2 < 64) ? (cr * er - ci * ei) : -(cr * ei + ci * er);
    }
    WY[idx] = f2bf(v);
  }
}

DI void ret_u_item(const Params& p, int b, int n, int h, char* smem) {
  const int tid = opqv(threadIdx.x) & 255, lane = tid & 63, w = tid >> 6, wm = w >> 1, wn = w & 1, l32 = lane & 31, hf = lane >> 5;
  char* ws = opq(p.ws);
  const u16* zr = (const u16*)(ws + OFF_ZR); float* U = (float*)(ws + OFF_UO);
  char* sKt = smem; char* sVt = smem + 128 * 272;
  const size_t t0 = (size_t)b * S_ + n * 128;
  const float lg = lg2gamma(h);
#pragma unroll
  for (int i = 0; i < 8; ++i) {
    const int c = tid + 256 * i, row = c >> 4, ch = c & 15;
    const uint4 kv = *(const uint4*)(zr + (t0 + row) * LDZR + 512 + h * 128 + ch * 8);
    const uint4 vv = *(const uint4*)(zr + (t0 + row) * LDZR + 1024 + h * 128 + ch * 8);
    const float te = ex2((float)(127 - row) * lg);
    char* kb = sKt + (ch * 8) * 272 + row * 2; char* vb = sVt + (ch * 8) * 272 + row * 2;
    *(u16*)(kb + 0 * 272) = f2bf(bf2f(kv.x & 0xffffu) * te); *(u16*)(kb + 1 * 272) = f2bf(bf2f(kv.x >> 16) * te);
    *(u16*)(kb + 2 * 272) = f2bf(bf2f(kv.y & 0xffffu) * te); *(u16*)(kb + 3 * 272) = f2bf(bf2f(kv.y >> 16) * te);
    *(u16*)(kb + 4 * 272) = f2bf(bf2f(kv.z & 0xffffu) * te); *(u16*)(kb + 5 * 272) = f2bf(bf2f(kv.z >> 16) * te);
    *(u16*)(kb + 6 * 272) = f2bf(bf2f(kv.w & 0xffffu) * te); *(u16*)(kb + 7 * 272) = f2bf(bf2f(kv.w >> 16) * te);
    *(u16*)(vb + 0 * 272) = (u16)(vv.x & 0xffffu); *(u16*)(vb + 1 * 272) = (u16)(vv.x >> 16);
    *(u16*)(vb + 2 * 272) = (u16)(vv.y & 0xffffu); *(u16*)(vb + 3 * 272) = (u16)(vv.y >> 16);
    *(u16*)(vb + 4 * 272) = (u16)(vv.z & 0xffffu); *(u16*)(vb + 5 * 272) = (u16)(vv.z >> 16);
    *(u16*)(vb + 6 * 272) = (u16)(vv.w & 0xffffu); *(u16*)(vb + 7 * 272) = (u16)(vv.w >> 16);
  }
  __syncthreads();
  f32x16 acc[2][2];
#pragma unroll
  for (int i = 0; i < 2; ++i)
#pragma unroll
    for (int jn = 0; jn < 2; ++jn) acc[i][jn] = zero16();
#pragma unroll
  for (int s = 0; s < 8; ++s) {
    bf16x8 af[2], bfr[2];
#pragma unroll
    for (int i = 0; i < 2; ++i) af[i] = *(const bf16x8*)(sVt + (wm * 64 + i * 32 + l32) * 272 + (s * 16 + hf * 8) * 2);
#pragma unroll
    for (int jn = 0; jn < 2; ++jn) bfr[jn] = *(const bf16x8*)(sKt + (wn * 64 + jn * 32 + l32) * 272 + (s * 16 + hf * 8) * 2);
#pragma unroll
    for (int i = 0; i < 2; ++i)
#pragma unroll
      for (int jn = 0; jn < 2; ++jn) acc[i][jn] = MFMA(af[i], bfr[jn], acc[i][jn]);
  }
  float* Ub = U + ((size_t)((b * 4 + h) * 128 + n)) * 16384;
#pragma unroll
  for (int i = 0; i < 2; ++i)
#pragma unroll
    for (int jn = 0; jn < 2; ++jn)
#pragma unroll
      for (int r = 0; r < 16; ++r) Ub[(wm * 64 + i * 32 + crow(r, hf)) * 128 + wn * 64 + jn * 32 + l32] = acc[i][jn][r];
  __syncthreads();
}

DI void rec_state_phase(const Params& p, int j, char* smem) {
  const int tid = opqv(threadIdx.x), lane = tid & 63, w = tid >> 6, wm = w >> 2, wn = w & 3, l32 = lane & 31, hf = lane >> 5;
  char* ws = opq(p.ws);
  {
    const int half = opqv(threadIdx.x) >> 8;
    char* sm = smem + half * HALF_SMEM;
    for (int it = blockIdx.x; it < 512; it += gridDim.x) { const int item = it * 2 + half; ret_u_item(p, item >> 9, (item >> 2) & 127, item & 3, sm); }
  }
  for (int it = blockIdx.x; it < 128; it += gridDim.x) {
    const int g = it >> 2, mt = it & 3, m0 = mt * 256;
    const u16* A = (const u16*)(ws + OFF_UG) + (size_t)g * T_ * 16 + (size_t)m0 * 512;
    const u16* Bt = (const u16*)(ws + OFF_WE) + (size_t)g * 256 * 512;
    float* E = (float*)(ws + OFF_EB) + (size_t)g * 1024 * 128;
    gemm_tile(A, 512, 8, nullptr, 0, 0, Bt, 512, smem, [&](f32x16(&acc)[2][2], int moff) {
      int l32_ = l32, hf_ = hf; asm volatile("" : "+v"(l32_), "+v"(hf_));
      const int m0_ = m0 + moff;
      if (wn < 2) {
#pragma unroll
        for (int i = 0; i < 2; ++i)
#pragma unroll
          for (int jn = 0; jn < 2; ++jn)
#pragma unroll
            for (int r = 0; r < 16; ++r)
              E[(size_t)(m0_ + wm * 64 + i * 32 + crow(r, hf_)) * 128 + wn * 64 + jn * 32 + l32_] = acc[i][jn][r];
      }
    });
  }
}

DI void scan_phase(const Params& p, int j) {
  const int tid = opqv(threadIdx.x) & 255;
  char* ws = opq(p.ws);
  for (int vb = blockIdx.x * 2 + (opqv(threadIdx.x) >> 8); vb < 128 + 16; vb += gridDim.x * 2) {
    if (vb < 128) {
      const int idx = vb * 256 + tid, bh = idx >> 12, e4 = (idx & 4095) * 4, h = bh & 3;
      const float cd = ex2(128.f * lg2gamma(h));
      const float* U = (const float*)(ws + OFF_UO) + (size_t)bh * 128 * 16384 + e4;
      u16* Sp = (u16*)(ws + OFF_SP) + (size_t)bh * 128 * 16384 + e4;
      float4 S = make_float4(0, 0, 0, 0);
      for (int n0 = 0; n0 < 128; n0 += 16) {
        f32x4 u[16];
#pragma unroll
        for (int k = 0; k < 16; ++k) u[k] = *(const f32x4*)(U + (size_t)(n0 + k) * 16384);
#pragma unroll
        for (int k = 0; k < 16; ++k) {
          *(uint2*)(Sp + (size_t)(n0 + k) * 16384) = make_uint2(pack2(S.x, S.y), pack2(S.z, S.w));
          S.x = cd * S.x + u[k].x; S.y = cd * S.y + u[k].y; S.z = cd * S.z + u[k].z; S.w = cd * S.w + u[k].w;
        }
      }
    } else {
      const int idx = (vb - 128) * 256 + tid, b = idx >> 11, g = (idx >> 6) & 31, n = idx & 63;
      const float4 z = ((const float4*)(ws + OFF_S5Z))[(j * 32 + g) * 64 + n];
      const float mg = expf(32.f * z.x), ang = 32.f * z.y; float sn_, cs_; sincos_(ang, sn_, cs_);
      const float a32r = mg * cs_, a32i = mg * sn_;
      const float* E = (const float*)(ws + OFF_EB) + ((size_t)g * 1024 + b * 512) * 128;
      u16* Xp = (u16*)(ws + OFF_XP) + ((size_t)g * 1024 + b * 512) * 128;
      float xr = 0.f, xi = 0.f;
      for (int c0 = 0; c0 < 512; c0 += 32) {
        float er[32], ei[32];
#pragma unroll
        for (int k = 0; k < 32; ++k) { er[k] = E[(c0 + k) * 128 + n]; ei[k] = E[(c0 + k) * 128 + 64 + n]; }
#pragma unroll
        for (int k = 0; k < 32; ++k) {
          Xp[(c0 + k) * 128 + n] = f2bf(xr); Xp[(c0 + k) * 128 + 64 + n] = f2bf(xi);
          const float nr = a32r * xr - a32i * xi + er[k], ni = a32r * xi + a32i * xr + ei[k];
          xr = nr; xi = ni;
        }
      }
    }
  }
}

DI void ret_out_item(const Params& p, int b, int n, int h, char* smem) {
  const int tid = opqv(threadIdx.x) & 255, lane = tid & 63, w = tid >> 6, l32 = lane & 31, hf = lane >> 5;
  char* ws = opq(p.ws);
  const u16* zr = (const u16*)(ws + OFF_ZR); u16* o = (u16*)(ws + OFF_UO);
  char* sK = smem; char* sVt = smem + 128 * 272;
  const size_t t0 = (size_t)b * S_ + n * 128;
  const float lg = lg2gamma(h);
#pragma unroll
  for (int i = 0; i < 8; ++i) {
    const int c = tid + 256 * i, row = c >> 4, ch = c & 15;
    const uint4 kv = *(const uint4*)(zr + (t0 + row) * LDZR + 512 + h * 128 + ch * 8);
    const uint4 vv = *(const uint4*)(zr + (t0 + row) * LDZR + 1024 + h * 128 + ch * 8);
    *(uint4*)(sK + row * 272 + ch * 16) = kv;
    char* vb = sVt + (ch * 8) * 272 + row * 2;
    *(u16*)(vb + 0 * 272) = (u16)(vv.x & 0xffffu); *(u16*)(vb + 1 * 272) = (u16)(vv.x >> 16);
    *(u16*)(vb + 2 * 272) = (u16)(vv.y & 0xffffu); *(u16*)(vb + 3 * 272) = (u16)(vv.y >> 16);
    *(u16*)(vb + 4 * 272) = (u16)(vv.z & 0xffffu); *(u16*)(vb + 5 * 272) = (u16)(vv.z >> 16);
    *(u16*)(vb + 6 * 272) = (u16)(vv.w & 0xffffu); *(u16*)(vb + 7 * 272) = (u16)(vv.w >> 16);
  }
  __syncthreads();
  const size_t tq = t0 + w * 32 + l32;
  const int qi = w * 32 + l32;
  bf16x8 qf[8];
#pragma unroll
  for (int s = 0; s < 8; ++s) qf[s] = *(const bf16x8*)(zr + tq * LDZR + h * 128 + s * 16 + hf * 8);
  f32x16 ot[4];
  const u16* Sp = (const u16*)(ws + OFF_SP) + ((size_t)((b * 4 + h) * 128 + n)) * 16384;
#pragma unroll
  for (int mt = 0; mt < 4; ++mt) {
    ot[mt] = zero16();
#pragma unroll
    for (int s = 0; s < 8; ++s) {
      const bf16x8 sf = *(const bf16x8*)(Sp + (mt * 32 + l32) * 128 + s * 16 + hf * 8);
      ot[mt] = MFMA(sf, qf[s], ot[mt]);
    }
  }
  const float fs = ex2((float)(qi + 1) * lg);
#pragma unroll
  for (int mt = 0; mt < 4; ++mt)
#pragma unroll
    for (int r = 0; r < 16; ++r) ot[mt][r] *= fs;
#pragma unroll
  for (int tt = 0; tt < 4; ++tt) {
    if (tt <= w) {
      f32x16 st = zero16();
#pragma unroll
      for (int s = 0; s < 8; ++s) {
        const bf16x8 kf = *(const bf16x8*)(sK + (tt * 32 + l32) * 272 + (s * 16 + hf * 8) * 2);
        st = MFMA(kf, qf[s], st);
      }
#pragma unroll
      for (int r = 0; r < 16; ++r) {
        const int dd = qi - (tt * 32 + crow(r, hf));
        st[r] = (dd >= 0) ? st[r] * ex2((float)dd * lg) : 0.f;
      }
#pragma unroll
      for (int s2 = 0; s2 < 2; ++s2) {
        const bf16x8 pf = pack8(st, s2);
#pragma unroll
        for (int mt = 0; mt < 4; ++mt) {
          const char* vp = sVt + (mt * 32 + l32) * 272 + (tt * 32 + s2 * 16 + hf * 4) * 2;
          const bf16x8 vf = join8(*(const uint2*)vp, *(const uint2*)(vp + 16));
          ot[mt] = MFMA(vf, pf, ot[mt]);
        }
      }
    }
  }
  float sum = 0.f;
#pragma unroll
  for (int mt = 0; mt < 4; ++mt)
#pragma unroll
    for (int r = 0; r < 16; ++r) sum += ot[mt][r];
  sum += __shfl_xor(sum, 32);
  const float mean = sum * (1.f / 128.f);
  float vs = 0.f;
#pragma unroll
  for (int mt = 0; mt < 4; ++mt)
#pragma unroll
    for (int r = 0; r < 16; ++r) { const float d = ot[mt][r] - mean; vs += d * d; }
  vs += __shfl_xor(vs, 32);
  const float rstd = rsqrtf(vs * (1.f / 128.f) + 1e-5f);
#pragma unroll
  for (int mt = 0; mt < 4; ++mt)
#pragma unroll
    for (int qd = 0; qd < 4; ++qd) {
      const int e0 = mt * 32 + 8 * qd + 4 * hf;
      const uint2 gv = *(const uint2*)(zr + tq * LDZR + 1536 + h * 128 + e0);
      const float g0 = bf2f(gv.x & 0xffffu), g1 = bf2f(gv.x >> 16), g2 = bf2f(gv.y & 0xffffu), g3 = bf2f(gv.y >> 16);
      const float o0 = g0 / (1.f + __expf(-g0)) * (ot[mt][4 * qd + 0] - mean) * rstd;
      const float o1 = g1 / (1.f + __expf(-g1)) * (ot[mt][4 * qd + 1] - mean) * rstd;
      const float o2 = g2 / (1.f + __expf(-g2)) * (ot[mt][4 * qd + 2] - mean) * rstd;
      const float o3 = g3 / (1.f + __expf(-g3)) * (ot[mt][4 * qd + 3] - mean) * rstd;
      *(uint2*)(o + tq * LDH + h * 128 + e0) = make_uint2(pack2(o0, o1), pack2(o2, o3));
    }
  __syncthreads();
}

DI float gelu_tanh(float y) {
  const float u = 0.7978845608028654f * (y + 0.044715f * y * y * y);
  const float e = __expf(2.f * u);
  const float th = 1.f - 2.f / (e + 1.f);
  return 0.5f * y * (1.f + th);
}

DI void rec_out_phase(const Params& p, int j, char* smem) {
  const int tid = opqv(threadIdx.x), lane = tid & 63, w = tid >> 6, wm = w >> 2, wn = w & 3, l32 = lane & 31, hf = lane >> 5;
  char* ws = opq(p.ws);
  {
    const int half = opqv(threadIdx.x) >> 8;
    char* sm = smem + half * HALF_SMEM;
    for (int it = blockIdx.x; it < 512; it += gridDim.x) { const int item = it * 2 + half; ret_out_item(p, item >> 9, (item >> 2) & 127, item & 3, sm); }
  }
  for (int it = blockIdx.x; it < 256; it += gridDim.x) {
    {
      const int k = it, g = k >> 3, mt = (k >> 1) & 3, nt = k & 1, m0 = mt * 256, n0 = nt * 256;
      const u16* Ug = (const u16*)(ws + OFF_UG) + (size_t)g * T_ * 16;
      const u16* A1 = Ug + (size_t)m0 * 512;
      const u16* A2 = (const u16*)(ws + OFF_XP) + ((size_t)g * 1024 + m0) * 128;
      const u16* Bt = (const u16*)(ws + OFF_WY) + ((size_t)g * 512 + n0) * 640;
      u16* yt = (u16*)(ws + OFF_YT);
      gemm_tile(A1, 512, 8, A2, 128, 2, Bt, 640, smem, [&](f32x16(&acc)[2][2], int moff) {
      const int m0_ = m0 + moff;
      int l32_ = l32, hf_ = hf; asm volatile("" : "+v"(l32_), "+v"(hf_));
#pragma unroll
        for (int i = 0; i < 2; ++i)
#pragma unroll
          for (int jn = 0; jn < 2; ++jn)
#pragma unroll
            for (int r = 0; r < 16; ++r) {
              const int R = m0_ + wm * 64 + i * 32 + crow(r, hf_), col = n0 + wn * 64 + jn * 32 + l32_;
              const int ii = col >> 4, pp = col & 15;
              const size_t t = (size_t)R * 32 + ii;
              const float y = acc[i][jn][r];
              yt[t * LDYT + g * 16 + pp] = f2bf(gelu_tanh(y));
            }
      });
    }
  }
}

DI void glu_phase(const Params& p, int j, char* smem) {
  const int tid = opqv(threadIdx.x), lane = tid & 63, w = tid >> 6, wm = w >> 2, wn = w & 3, l32 = lane & 31, hf = lane >> 5;
  char* ws = opq(p.ws);
  const u16* yt = (const u16*)(ws + OFF_YT);
  const u16* Wt = (const u16*)(ws + OFF_W_GLU) + (size_t)j * 512 * LDGLU;
  u16* o = (u16*)(ws + OFF_UO);
  const float* gb = p.s5_glu_b + j * 512;
  const int nN = 2;
  for (int lt = blockIdx.x >> 3; lt < 16 * nN; lt += gridDim.x >> 3) {
    int mt, nt; tile_map(lt, 16, nN, 16, 2, mt, nt);
    const int m0 = mt * 256, n0 = nt * 256;
    gemm_tile(yt + (size_t)m0 * LDYT, LDYT, 8, nullptr, 0, 0, Wt + (size_t)n0 * LDGLU, LDGLU, smem, [&](f32x16(&acc)[2][2], int moff) {
      const int m0_ = m0 + moff;
      int l32_ = l32, hf_ = hf; asm volatile("" : "+v"(l32_), "+v"(hf_));
#pragma unroll
      for (int i = 0; i < 2; ++i)
#pragma unroll
        for (int jn = 0; jn < 2; ++jn)
#pragma unroll
          for (int r = 0; r < 16; ++r) {
            const int row = m0_ + wm * 64 + i * 32 + crow(r, hf_), col = n0 + wn * 64 + jn * 32 + l32_;
            const float gt = acc[i][jn][r] + gb[col];
            const float y = bf2f(yt[(size_t)row * LDYT + col]);
            o[(size_t)row * LDH + 512 + col] = f2bf(y / (1.f + __expf(-gt)));
          }
    });
  }
}

DI void run_phase(const Params& p, int ph, char* smem, int rep) {
  char* ws = opq(p.ws);
  if (ph == 0) { phase0(p, smem); return; }
  if (ph == 1) { phase1(p); return; }
  const int q = ph - 2, pair = q / 18, r = q % 18;
  const bool odd = r >= 8;
  const int k = odd ? r - 8 : r;
  const int l = pair * 2 + (odd ? 1 : 0), j = pair;
  int op = 2, pm = 0, ls = 0;
  if (!odd) {
    if (k == 3) { op = 0; pm = 0; } else if (k == 5) { op = 0; pm = 1; } else if (k == 6) { op = 0; pm = 2; }
    else if (k == 4) { op = 1; ls = 2 * l; } else if (k == 7) { op = 1; ls = 2 * l + 1; }
  } else {
    if (k == 5) { op = 0; pm = 0; } else if (k == 7) { op = 0; pm = 1; } else if (k == 8) { op = 0; pm = 2; }
    else if (k == 6) { op = 1; ls = 2 * l; } else if (k == 9) { op = 1; ls = 2 * l + 1; }
  }
  if (op == 0) {
    const u16* A; const u16* W; u16* C; int K, N, mode, lda, ldb, ldc;
    if (pm == 0) {
      A = (const u16*)(ws + (odd ? OFF_UO : OFF_OE)); lda = LDH;
      W = (const u16*)(ws + (odd ? OFF_W_RECOUT : OFF_W_ATTOUT)) + (size_t)j * 1024 * LDW1; ldb = LDW1;
      C = (u16*)(ws + OFF_HY); ldc = LDH; K = 1024; N = 1024; mode = 0;
    } else if (pm == 1) {
      A = (const u16*)(ws + OFF_HY); lda = LDH; W = (const u16*)(ws + OFF_W1) + (size_t)l * 4096 * LDW1; ldb = LDW1;
      C = (u16*)(ws + OFF_HID); ldc = LDHID; K = 1024; N = 4096; mode = 1;
    } else {
      A = (const u16*)(ws + OFF_HID); lda = LDHID; W = (const u16*)(ws + OFF_W2) + (size_t)l * 1024 * LDW2; ldb = LDW2;
      C = (u16*)(ws + OFF_HY); ldc = LDH; K = 4096; N = 1024; mode = 0;
    }
#ifdef PROBE_VARIANT
    if (rep) gemm_plain<PROBE_VARIANT>(A, lda, K, W, ldb, N, C, ldc, mode, smem); else
#endif
    gemm_plain<0>(A, lda, K, W, ldb, N, C, ldc, mode, smem);
  } else if (op == 1) {
    ln_phase(p, ls);
  } else if (!odd) {
    if (k == 0) att_in_phase(p, j, smem);
    else if (k == 1) qkv_phase(p, j, smem);
    else attn_phase(p, j, j + 4 * rep, smem);
  } else {
    if (k == 0) { rec_in_phase(p, j, smem); s5_fill(p, j); }
    else if (k == 1) rec_state_phase(p, j, smem);
    else if (k == 2) scan_phase(p, j);
    else if (k == 3) rec_out_phase(p, j, smem);
    else glu_phase(p, j, smem);
  }
}

__global__ void __launch_bounds__(512, 2) mega_kernel(Params p, int ph0, int ph1) {
  extern __shared__ __attribute__((aligned(16))) char smem[];
  cg::grid_group grid = cg::this_grid();
  __shared__ uint4 xb_words;
  if (threadIdx.x == 0) xb_words = make_uint4(0u, 0u, 0u, 0u);
  __syncthreads();
  XcdBarrier xb = xcd_barrier_post((unsigned*)(p.ws + OFF_BAR), (volatile LAS unsigned*)&xb_words);
  for (int ph = ph0; ph < ph1; ++ph) {
    run_phase(p, ph, smem, 0);
#ifdef PROBE_MASK
    if (ph >= 2 && ((PROBE_MASK >> ((ph - 2) % 18)) & 1)) { xcd_barrier(xb); run_phase(p, ph, smem, 1); }
#endif
    if (ph + 1 < ph1) { if (ph == ph0) grid.sync(); else xcd_barrier(xb); }
  }
}

__global__ void fail_fill(float* out, int n) {
  int i = blockIdx.x * 256 + threadIdx.x;
  if (i < n) out[i] = 0.f;
}

extern "C" void kernel_launch(void* const* d_in, const int* in_sizes, int n_in, void* d_out, int out_size, void* d_ws,
                              size_t ws_size, hipStream_t stream) {
  Params p{};
  const float** fp = (const float**)&p;
  for (int i = 0; i < 27; ++i) fp[i] = (const float*)d_in[i];
  p.out = (float*)d_out;
  p.ws = (char*)d_ws;
  if (ws_size < WS_NEED) {
    fail_fill<<<(out_size + 255) / 256, 256, 0, stream>>>((float*)d_out, out_size);
    return;
  }
  static int grid_blocks = 0;
  if (!grid_blocks) {
    hipFuncSetAttribute((const void*)mega_kernel, hipFuncAttributeMaxDynamicSharedMemorySize, SMEM_BYTES);
    int dev = 0, cus = 0, per_cu = 0;
    hipGetDevice(&dev);
    hipDeviceGetAttribute(&cus, hipDeviceAttributeMultiprocessorCount, dev);
    hipOccupancyMaxActiveBlocksPerMultiprocessor(&per_cu, mega_kernel, NTHR, SMEM_BYTES);
    if (per_cu > 1) per_cu = 1;
    if (per_cu < 1) per_cu = 1;
    grid_blocks = cus * per_cu;
  }
  (void)hipMemsetAsync((char*)d_ws + OFF_BAR, 0, XCD_BAR_WORDS * 4, stream);
  int ph0 = 0, ph1 = NPHASE;
  void* args[] = {&p, &ph0, &ph1};
  hipError_t e = hipLaunchCooperativeKernel((void*)mega_kernel, dim3(grid_blocks), dim3(NTHR), args, SMEM_BYTES, stream);
  if (e != hipSuccess) fprintf(stderr, "cooperative launch failed: %s (grid %d)\n", hipGetErrorString(e), grid_blocks);
}
static_assert(WS_NEED <= (size_t)536870912, "workspace budget exceeded");
```

```cpp
#include <hip/hip_runtime.h>
#include <hip/hip_cooperative_groups.h>
#include <cstdio>
namespace cg = cooperative_groups;

typedef unsigned short u16;
using bf16x8 = __attribute__((ext_vector_type(8))) short;
using f32x16 = __attribute__((ext_vector_type(16))) float;
using u32x4 = __attribute__((ext_vector_type(4))) unsigned;
typedef __attribute__((address_space(3))) unsigned lds_u32;
using f32x4 = __attribute__((ext_vector_type(4))) float;
#define DI __device__ __forceinline__
#define MFMA(a, b, c) __builtin_amdgcn_mfma_f32_32x32x16_bf16((a), (b), (c), 0, 0, 0)

constexpr int T_ = 32768, S_ = 16384;
constexpr float LOG2E = 1.4426950408889634f;
constexpr float DN_ALPHA = 1.6817928305074290f;
constexpr float MLA_QSCALE = 0.10206207261596575f * LOG2E;
constexpr float SWA_QSCALE = 0.125f * LOG2E;
constexpr float RET_KSCALE = 0.08838834764831845f;
constexpr int LDH = 1088, LDHID = 4160, LDW1 = 1088, LDW2 = 4160, LDV = S_ + 64, LDKB = 832, LDZR = 2112, LDYT = 576, LDGLU = 576;

constexpr size_t OFF_MOD = 0;
constexpr size_t OFF_CTR = OFF_MOD + 8 * 2 * 3072 * 4;
constexpr size_t OFF_BAR = OFF_CTR + 256;
constexpr size_t OFF_RT32 = OFF_BAR + 16384;
constexpr size_t OFF_RT64 = OFF_RT32 + (size_t)S_ * 16 * 8;
constexpr size_t OFF_RT128 = OFF_RT64 + (size_t)S_ * 32 * 8;
constexpr size_t OFF_S5Z = OFF_RT128 + (size_t)S_ * 64 * 8;
constexpr size_t OFF_BBAR = OFF_S5Z + 2 * 32 * 64 * 16;
constexpr size_t OFF_KTAB = OFF_BBAR + 2 * 32 * 64 * 16 * 8;
constexpr size_t OFF_W_ATTIN = OFF_KTAB + 2 * 32 * 32 * 256 * 4;
constexpr size_t OFF_W_UQ = OFF_W_ATTIN + (size_t)2 * 1536 * LDW1 * 2;
constexpr size_t OFF_W_UKV = OFF_W_UQ + (size_t)2 * 768 * 384 * 2;
constexpr size_t OFF_W_ATTOUT = OFF_W_UKV + (size_t)2 * 1024 * 256 * 2;
constexpr size_t OFF_W_RECIN = OFF_W_ATTOUT + (size_t)2 * 1024 * LDW1 * 2;
constexpr size_t OFF_W_GLU = OFF_W_RECIN + (size_t)2 * 2560 * LDW1 * 2;
constexpr size_t OFF_W_RECOUT = OFF_W_GLU + (size_t)2 * 512 * LDGLU * 2;
constexpr size_t OFF_W1 = OFF_W_RECOUT + (size_t)2 * 1024 * LDW1 * 2;
constexpr size_t OFF_W2 = OFF_W1 + (size_t)4 * 4096 * LDW1 * 2;
constexpr size_t OFF_WE = OFF_W2 + (size_t)4 * 1024 * LDW2 * 2;
constexpr size_t OFF_WY = OFF_WE + (size_t)32 * 256 * 512 * 2;
constexpr size_t OFF_HY = OFF_WY + (size_t)32 * 512 * 640 * 2;
constexpr size_t OFF_RA = OFF_HY + (size_t)T_ * LDH * 2;
constexpr size_t OFF_ZC = OFF_RA;
constexpr size_t OFF_QB = OFF_ZC + (size_t)T_ * 640 * 2;
constexpr size_t OFF_KB = OFF_QB + (size_t)T_ * 768 * 2;
constexpr size_t OFF_VT = OFF_KB + (size_t)T_ * LDKB * 2;
constexpr size_t OFF_SQ = OFF_VT + (size_t)2 * 8 * 64 * LDV * 2;
constexpr size_t OFF_SK = OFF_SQ + (size_t)T_ * 512 * 2;
constexpr size_t OFF_SV = OFF_SK + (size_t)T_ * 128 * 2;
constexpr size_t OFF_OE = OFF_SV + (size_t)T_ * 128 * 2;
constexpr size_t END_EVEN = OFF_OE + (size_t)T_ * LDH * 2;
constexpr size_t OFF_ZR = OFF_RA;
constexpr size_t OFF_UG = OFF_ZR + (size_t)T_ * LDZR * 2;
constexpr size_t OFF_UO = OFF_UG + (size_t)T_ * 512 * 2;
constexpr size_t OFF_SP = OFF_UO + (size_t)T_ * LDH * 2;
constexpr size_t OFF_EB = OFF_SP + (size_t)T_ * 512 * 2;
constexpr size_t OFF_XP = OFF_EB + (size_t)32 * 1024 * 128 * 4;
constexpr size_t OFF_YT = OFF_HY;
constexpr size_t END_ODD = OFF_XP + (size_t)32 * 1024 * 128 * 2;
constexpr size_t OFF_HID = OFF_RA;
constexpr size_t END_MLP = OFF_HID + (size_t)T_ * LDHID * 2;
constexpr size_t WS_NEED = END_ODD > END_EVEN ? (END_ODD > END_MLP ? END_ODD : END_MLP) : (END_EVEN > END_MLP ? END_EVEN : END_MLP);

constexpr int NTHR = 512;
constexpr int HALF_SMEM = 73728 + 1024;
constexpr int SMEM_GEMM = 131072;
constexpr int SMEM_BYTES = 2 * HALF_SMEM;
constexpr int NPHASE = 38;

struct Params {
  const float *x, *c, *ada_w, *ada_b, *ln_g, *ln_b, *att_w_in, *mla_q_norm, *mla_w_uq, *mla_kv_norm, *mla_w_ukv,
      *swa_sinks, *att_w_out, *rec_w_in, *s5_a_re, *s5_a_im, *s5_log_step, *s5_b_re, *s5_b_im, *s5_c_re, *s5_c_im,
      *s5_d, *s5_glu_w, *s5_glu_b, *rec_w_out, *mlp_w1, *mlp_w2;
  float* out;
  char* ws;
};

#define XB_TMO      128
#define XB_XCNT(j)  (256  + 64 * (j))
#define XB_XSUB(j)  (1280 + 64 * (j))
#define XB_XGEN(j)  (2304 + 64 * (j))
#define XB_TOP      3328
#define XB_TOPGEN   3392
#define XCD_BAR_WORDS 3456
#define XB_SPIN_CAP (1u << 18)
#define LAS __attribute__((address_space(3)))

__device__ __forceinline__ unsigned xb_ld(unsigned* p)              { return __hip_atomic_load(p, __ATOMIC_RELAXED, __HIP_MEMORY_SCOPE_AGENT); }
__device__ __forceinline__ unsigned xb_add(unsigned* p, unsigned v) { return __hip_atomic_fetch_add(p, v, __ATOMIC_RELAXED, __HIP_MEMORY_SCOPE_AGENT); }
__device__ __forceinline__ unsigned xb_xcc_id() { return (unsigned)__builtin_amdgcn_s_getreg((3 << 11) | 20) & 0xFu; }
#define XB_SPIN(cond, bar) do { unsigned _sp = 0; while (cond) { __builtin_amdgcn_s_sleep(1); \
    if ((++_sp & 255u) == 0u) { if (xb_ld(&(bar)[XB_TMO])) break; if (_sp > XB_SPIN_CAP) { atomicAdd(&(bar)[XB_TMO], 1u); break; } } } } while (0)

struct XcdBarrier {
    unsigned* bar; unsigned x;
    volatile LAS unsigned* st;
};

__device__ __forceinline__ XcdBarrier xcd_barrier_post(unsigned* bar, volatile LAS unsigned* st) {
    XcdBarrier b; b.bar = bar; b.x = xb_xcc_id(); b.st = st;
    if (threadIdx.x == 0) (void)xb_add(&bar[XB_XCNT(b.x)], 1u);
    return b;
}
__device__ __forceinline__ void xcd_barrier_complete(unsigned* bar, unsigned x, unsigned& nloc, unsigned& nx) {
    const unsigned G = gridDim.x * gridDim.y * gridDim.z;
    unsigned sum, cnt, mine, sp = 0u;
    for (;;) {
        sum = 0u; cnt = 0u; mine = 0u;
#pragma unroll
        for (unsigned j = 0; j < 16; ++j) { const unsigned c = xb_ld(&bar[XB_XCNT(j)]); sum += c; cnt += (c > 0u) ? 1u : 0u; mine = (j == x) ? c : mine; }
        if (sum == G) break;
        __builtin_amdgcn_s_sleep(1);
        if ((++sp & 255u) == 0u) { if (xb_ld(&bar[XB_TMO])) break; if (sp > XB_SPIN_CAP) { atomicAdd(&bar[XB_TMO], 1u); break; } }
    }
    nloc = mine > 0u ? mine : 1u; nx = cnt > 0u ? cnt : 1u;
}

__device__ __forceinline__ void xcd_barrier(const XcdBarrier& b) {
    asm volatile("s_waitcnt vmcnt(0)" ::: "memory");
    __syncthreads();
    if (threadIdx.x == 0) {
        unsigned* bar = b.bar;
        __builtin_amdgcn_s_waitcnt(0);
        unsigned nloc = b.st[0], nx = b.st[1];
        if (nloc == 0u) { xcd_barrier_complete(bar, b.x, nloc, nx); b.st[0] = nloc; b.st[1] = nx; }
        const unsigned old = xb_add(&bar[XB_XSUB(b.x)], 1u);
        const unsigned gen = old / nloc;
        if (old + 1u == (gen + 1u) * nloc) {
            __builtin_amdgcn_fence(__ATOMIC_RELEASE, "agent");
            asm volatile("s_waitcnt vmcnt(0)" ::: "memory");
            const unsigned og = xb_add(&bar[XB_TOP], 1u);
            const unsigned tg = og / nx;
            if (og + 1u == (tg + 1u) * nx) xb_add(&bar[XB_TOPGEN], 1u);
            else XB_SPIN(xb_ld(&bar[XB_TOPGEN]) == tg, bar);
            __builtin_amdgcn_fence(__ATOMIC_ACQUIRE, "agent");
            xb_add(&bar[XB_XGEN(b.x)], 1u);
            asm volatile("s_waitcnt vmcnt(0)" ::: "memory");
        } else {
            XB_SPIN(xb_ld(&bar[XB_XGEN(b.x)]) == gen, bar);
            __builtin_amdgcn_fence(__ATOMIC_ACQUIRE, "agent");
            asm volatile("s_waitcnt vmcnt(0)" ::: "memory");
        }
    }
    __syncthreads();
}


typedef __bf16 bf2_t __attribute__((ext_vector_type(2)));
typedef float f2_t __attribute__((ext_vector_type(2)));
DI u16 f2bf(float x) { __bf16 r = (__bf16)x; return __builtin_bit_cast(u16, r); }
DI float bf2f(unsigned h) { return __uint_as_float(h << 16); }
DI unsigned pack2(float a, float b) { f2_t v = {a, b}; bf2_t r = __builtin_convertvector(v, bf2_t); return __builtin_bit_cast(unsigned, r); }
DI int crow(int r, int hf) { return (r & 3) + 8 * (r >> 2) + 4 * hf; }
DI float ex2(float x) { return __builtin_amdgcn_exp2f(x); }
DI bf16x8 pack8(const f32x16& x, int s) {
  uint4 u;
  u.x = pack2(x[8 * s + 0], x[8 * s + 1]); u.y = pack2(x[8 * s + 2], x[8 * s + 3]);
  u.z = pack2(x[8 * s + 4], x[8 * s + 5]); u.w = pack2(x[8 * s + 6], x[8 * s + 7]);
  return __builtin_bit_cast(bf16x8, u);
}
DI bf16x8 join8(uint2 lo, uint2 hi) { uint4 u = make_uint4(lo.x, lo.y, hi.x, hi.y); return __builtin_bit_cast(bf16x8, u); }
DI f32x16 zero16() { f32x16 z; for (int i = 0; i < 16; ++i) z[i] = 0.f; return z; }
DI int opqv(int x) { asm volatile("" : "+v"(x)); return x; }
DI char* opq(char* p) { asm volatile("" : "+s"(p)); return p; }
DI void sincos_(float x, float& sn, float& cs) { float s_, c_; sincosf(x, &s_, &c_); sn = s_; cs = c_; }
DI float lg2gamma(int h) { return log2f(1.0f - exp2f(-5.0f - (float)h)); }

template <int V = 0, class Epi>
DI void gemm_tile(const u16* A1, long lda1, int nk1, const u16* A2, long lda2, int nk2, const u16* Bt, long ldb,
                  char* smem, Epi&& epi) {
  const int tid = opqv(threadIdx.x), lane = tid & 63, w = tid >> 6, wm = w >> 2, wn = w & 3, l32 = lane & 31, hf = lane >> 5;
  f32x16 acc[2][2][2];
#pragma unroll
  for (int h = 0; h < 2; ++h)
#pragma unroll
    for (int i = 0; i < 2; ++i)
#pragma unroll
      for (int j = 0; j < 2; ++j) acc[h][i][j] = zero16();
  const int nk = nk1 + nk2;
  const int drow = lane >> 3, dslot = lane & 7, x7 = (l32 >> 1) & 7;
#define GLDS(KT, BUF) { const int kt_ = (KT); const u16* Ab; long lda; \
    if (kt_ < nk1) { Ab = A1 + kt_ * 64; lda = lda1; } else { Ab = A2 + (kt_ - nk1) * 64; lda = lda2; } \
    _Pragma("unroll") for (int q = 0; q < 4; ++q) { \
      const int r = (w * 4 + q) * 8 + drow; const int c = dslot ^ ((r >> 1) & 7); \
      __builtin_amdgcn_global_load_lds((const unsigned*)(Ab + (long)r * lda + c * 8), (lds_u32*)(smem + (BUF) * 65536 + (w * 4 + q) * 1024), 16, 0, 0); \
      __builtin_amdgcn_global_load_lds((const unsigned*)(Bt + (long)r * ldb + kt_ * 64 + c * 8), (lds_u32*)(smem + (BUF) * 65536 + 32768 + (w * 4 + q) * 1024), 16, 0, 0); } }
#define LFR(AF, BF, BUF, S0) { const char* a = smem + (BUF) * 65536; const char* b = a + 32768; \
    _Pragma("unroll") for (int i = 0; i < 4; ++i) AF[i] = *(const bf16x8*)(a + (wm * 128 + i * 32 + l32) * 128 + (((2 * (S0) + hf) ^ x7) << 4)); \
    _Pragma("unroll") for (int j = 0; j < 2; ++j) BF[j] = *(const bf16x8*)(b + (wn * 64 + j * 32 + l32) * 128 + (((2 * (S0) + hf) ^ x7) << 4)); }
#define MMA8(AF, BF) { \
    _Pragma("unroll") for (int i = 0; i < 4; ++i) \
      _Pragma("unroll") for (int j = 0; j < 2; ++j) acc[i >> 1][i & 1][j] = MFMA(AF[i], BF[j], acc[i >> 1][i & 1][j]); }
#define COMPUTE(BUF) { bf16x8 af0[4], bf0[2], af1[4], bf1[2]; \
    LFR(af0, bf0, BUF, 0); __builtin_amdgcn_sched_barrier(0); \
    LFR(af1, bf1, BUF, 1); MMA8(af0, bf0); __builtin_amdgcn_sched_barrier(0); \
    LFR(af0, bf0, BUF, 2); MMA8(af1, bf1); __builtin_amdgcn_sched_barrier(0); \
    LFR(af1, bf1, BUF, 3); MMA8(af0, bf0); __builtin_amdgcn_sched_barrier(0); \
    MMA8(af1, bf1); __builtin_amdgcn_sched_barrier(0); }
#define RAWBAR() { asm volatile("s_waitcnt vmcnt(0) lgkmcnt(0)" ::: "memory"); __builtin_amdgcn_s_barrier(); }
  if (V != 1) GLDS(0, 0);
  RAWBAR();
  for (int kt = 0; kt < nk; kt += 2) {
    if (V != 1) GLDS(kt + 1, 1);
    if (V != 2) COMPUTE(0);
    RAWBAR();
    if (V != 1) if (kt + 2 < nk) GLDS(kt + 2, 0);
    if (V != 2) COMPUTE(1);
    RAWBAR();
  }
#undef GLDS
#undef LFR
#undef MMA8
#undef COMPUTE
#undef RAWBAR
  epi(acc[0], wm * 64);
  epi(acc[1], wm * 64 + 64);
}

DI void tile_map(int lt, int nM8, int nN, int GM, int GN, int& mt, int& nt) {
  const int G = GM * GN, xcd = blockIdx.x & 7, group = lt / G, within = lt - group * G, ngn = nN / GN;
  const int mg = group / ngn, ng = group - mg * ngn;
  mt = xcd * nM8 + mg * GM + within / GN;
  nt = ng * GN + within % GN;
}

DI int colmap(int mode, int n) {
  if (mode == 1) { if (n < 640) return n; if (n < 1408) return n + 32; if (n < 1440) return n - 1408 + 640; return -1; }
  if (mode == 2) { if (n < 512) return (n >> 6) * 96 + (n & 63); int m = n - 512; return (m >> 5) * 96 + 64 + (m & 31); }
  if (mode == 3) { if (n < 1024) { int dl = n & 127, b4 = dl >> 5; int sb = (b4 == 1) ? 2 : (b4 == 2 ? 1 : b4); return (n & ~127) + sb * 32 + (dl & 31); } return n; }
  return n;
}
DI void conv_job(const float* src, int K, int N, u16* dst, int ldk, int Npad, const float* kscale, int mode, float* lds) {
  const int tid = opqv(threadIdx.x);
  const int nKt = K / 64, nNt = Npad / 64;
  for (int tile = blockIdx.x; tile < nKt * nNt; tile += gridDim.x) {
    const int nt = tile / nKt, kt = tile % nKt;
    const int nl = tid & 63, kq = tid >> 6;
    const int col = colmap(mode, nt * 64 + nl);
    for (int i = 0; i < 8; ++i) {
      const int kl = kq + 8 * i, k = kt * 64 + kl;
      float v = 0.f;
      if (col >= 0) { v = src[(size_t)k * N + col]; if (kscale) v *= kscale[k]; }
      lds[kl * 65 + nl] = v;
    }
    __syncthreads();
    for (int i = 0; i < 8; ++i) {
      const int n2 = kq + 8 * i;
      dst[(size_t)(nt * 64 + n2) * ldk + kt * 64 + nl] = f2bf(lds[nl * 65 + n2]);
    }
    __syncthreads();
  }
}

DI void phase0(const Params& p, char* smem) {
  const int tid = opqv(threadIdx.x), nb = gridDim.x, bid = blockIdx.x;
  char* ws = opq(p.ws);
  if (bid == 0 && tid < 64) ((int*)(ws + OFF_CTR))[tid] = 0;
  {
    float* cond = (float*)smem; float* red = cond + 2048; float* mod = (float*)(ws + OFF_MOD);
    for (int i = tid; i < 2048; i += NTHR) { float v = p.c[i]; cond[i] = v / (1.f + expf(-v)); }
    __syncthreads();
    for (int it = bid; it < 8 * 48; it += nb) {
      const int ls = it / 48, cgp = it % 48, tx = tid & 15, ty = tid >> 4;
      const float* wp = p.ada_w + (size_t)ls * 1024 * 3072 + cgp * 64 + tx * 4;
      float4 a0 = make_float4(0, 0, 0, 0), a1 = make_float4(0, 0, 0, 0);
      for (int k = ty * 32; k < ty * 32 + 32; ++k) {
        const float4 wv = *(const float4*)(wp + (size_t)k * 3072);
        const float c0 = cond[k], c1 = cond[1024 + k];
        a0.x += c0 * wv.x; a0.y += c0 * wv.y; a0.z += c0 * wv.z; a0.w += c0 * wv.w;
        a1.x += c1 * wv.x; a1.y += c1 * wv.y; a1.z += c1 * wv.z; a1.w += c1 * wv.w;
      }
      *(float4*)(red + (ty * 2 + 0) * 64 + tx * 4) = a0;
      *(float4*)(red + (ty * 2 + 1) * 64 + tx * 4) = a1;
      __syncthreads();
      if (tid < 128) {
        const int b = tid >> 6, col = tid & 63; float s = 0.f;
        for (int y = 0; y < 32; ++y) s += red[(y * 2 + b) * 64 + col];
        const int j = cgp * 64 + col;
        mod[(ls * 2 + b) * 3072 + j] = s + p.ada_b[ls * 3072 + j];
      }
      __syncthreads();
    }
  }
  {
    float* lds = (float*)smem;
    for (int j = 0; j < 2; ++j) {
      conv_job(p.att_w_in + (size_t)j * 1024 * 1440, 1024, 1440, (u16*)(ws + OFF_W_ATTIN) + (size_t)j * 1536 * LDW1, LDW1, 1536, nullptr, 1, lds);
      conv_job(p.mla_w_uq + (size_t)j * 384 * 768, 384, 768, (u16*)(ws + OFF_W_UQ) + (size_t)j * 768 * 384, 384, 768, p.mla_q_norm + j * 384, 2, lds);
      conv_job(p.mla_w_ukv + (size_t)j * 256 * 1024, 256, 1024, (u16*)(ws + OFF_W_UKV) + (size_t)j * 1024 * 256, 256, 1024, p.mla_kv_norm + j * 256, 0, lds);
      conv_job(p.att_w_out + (size_t)j * 1024 * 1024, 1024, 1024, (u16*)(ws + OFF_W_ATTOUT) + (size_t)j * 1024 * LDW1, LDW1, 1024, nullptr, 0, lds);
      conv_job(p.rec_w_in + (size_t)j * 1024 * 2560, 1024, 2560, (u16*)(ws + OFF_W_RECIN) + (size_t)j * 2560 * LDW1, LDW1, 2560, nullptr, 3, lds);
      conv_job(p.s5_glu_w + (size_t)j * 512 * 512, 512, 512, (u16*)(ws + OFF_W_GLU) + (size_t)j * 512 * LDGLU, LDGLU, 512, nullptr, 0, lds);
      conv_job(p.rec_w_out + (size_t)j * 1024 * 1024, 1024, 1024, (u16*)(ws + OFF_W_RECOUT) + (size_t)j * 1024 * LDW1, LDW1, 1024, nullptr, 0, lds);
    }
    for (int l = 0; l < 4; ++l) {
      conv_job(p.mlp_w1 + (size_t)l * 1024 * 4096, 1024, 4096, (u16*)(ws + OFF_W1) + (size_t)l * 4096 * LDW1, LDW1, 4096, nullptr, 0, lds);
      conv_job(p.mlp_w2 + (size_t)l * 4096 * 1024, 4096, 1024, (u16*)(ws + OFF_W2) + (size_t)l * 1024 * LDW2, LDW2, 1024, nullptr, 0, lds);
    }
  }
  {
    float2* rt32 = (float2*)(ws + OFF_RT32); float2* rt64 = (float2*)(ws + OFF_RT64); float2* rt128 = (float2*)(ws + OFF_RT128);
    for (int idx = bid * NTHR + tid; idx < S_ * 112; idx += nb * NTHR) {
      const int s = idx / 112, r = idx % 112;
      int dim, i; float2* dst;
      if (r < 16) { dim = 32; i = r; dst = rt32 + s * 16 + i; }
      else if (r < 48) { dim = 64; i = r - 16; dst = rt64 + s * 32 + i; }
      else { dim = 128; i = r - 48; dst = rt128 + s * 64 + i; }
      const float inv = powf(10000.0f, -((float)(2 * i)) / (float)dim);
      const float ang = (float)s * inv;
      float sn_, cs_; sincos_(ang, sn_, cs_);
      *dst = make_float2(cs_, sn_);
    }
  }
  {
    float4* s5z = (float4*)(ws + OFF_S5Z); float2* bbar = (float2*)(ws + OFF_BBAR);
    for (int idx = bid * NTHR + tid; idx < 2 * 32 * 64; idx += nb * NTHR) {
      const int jg = idx >> 6;
      const float dt = expf(p.s5_log_step[jg]);
      const float lr = p.s5_a_re[idx], li = p.s5_a_im[idx];
      const float zr = lr * dt, zi = li * dt, mag = expf(zr);
      float sn_, cs_; sincos_(zi, sn_, cs_);
      const float ar = mag * cs_, ai = mag * sn_;
      const float den = lr * lr + li * li;
      const float cr = ((ar - 1.f) * lr + ai * li) / den, ci = (ai * lr - (ar - 1.f) * li) / den;
      s5z[idx] = make_float4(zr, zi, ar, ai);
      for (int q = 0; q < 16; ++q) {
        const float br = p.s5_b_re[idx * 16 + q], bi = p.s5_b_im[idx * 16 + q];
        bbar[idx * 16 + q] = make_float2(cr * br - ci * bi, cr * bi + ci * br);
      }
    }
  }
}

DI void phase1(const Params& p) {
  const int tid = opqv(threadIdx.x), nb = gridDim.x, bid = blockIdx.x;
  char* ws = opq(p.ws);
  const float* mod = (const float*)(ws + OFF_MOD);
  u16* hy = (u16*)(ws + OFF_HY);
  for (int i = bid * NTHR + tid; i < T_ * 256; i += nb * NTHR) {
    const int t = i >> 8, c4 = (i & 255) * 4, b = t >> 14;
    const float4 xv = *(const float4*)(p.x + (size_t)i * 4);
    const float4 sh = *(const float4*)(mod + b * 3072 + c4);
    const float4 sc = *(const float4*)(mod + b * 3072 + 1024 + c4);
    uint2 o;
    o.x = pack2(xv.x * (1.f + sc.x) + sh.x, xv.y * (1.f + sc.y) + sh.y);
    o.y = pack2(xv.z * (1.f + sc.z) + sh.z, xv.w * (1.f + sc.w) + sh.w);
    *(uint2*)(hy + (size_t)t * LDH + c4) = o;
  }
  const float4* s5z = (const float4*)(ws + OFF_S5Z); const float2* bbar = (const float2*)(ws + OFF_BBAR);
  float* ktab = (float*)(ws + OFF_KTAB);
  for (int idx8 = bid * NTHR + tid; idx8 < 2 * 32 * 256 * 8; idx8 += nb * NTHR) {
    const int part = idx8 & 7, idx = idx8 >> 3;
    const int q = idx & 15, pp = (idx >> 4) & 15, jg = idx >> 8;
    float acc[32];
#pragma unroll
    for (int d = 0; d < 32; ++d) acc[d] = 0.f;
    for (int n = part * 8; n < part * 8 + 8; ++n) {
      const float4 z = s5z[jg * 64 + n];
      const float2 bb = bbar[(jg * 64 + n) * 16 + q];
      const float cr = p.s5_c_re[(jg * 16 + pp) * 64 + n], ci = p.s5_c_im[(jg * 16 + pp) * 64 + n];
      const float wr = cr * bb.x - ci * bb.y, wi = cr * bb.y + ci * bb.x;
      float er = 1.f, ei = 0.f;
#pragma unroll
      for (int d = 0; d < 32; ++d) {
        acc[d] += wr * er - wi * ei;
        const float nr = er * z.z - ei * z.w, ni = er * z.w + ei * z.z;
        er = nr; ei = ni;
      }
    }
#pragma unroll
    for (int d = 0; d < 32; ++d) {
      float a = acc[d];
      a += __shfl_xor(a, 1); a += __shfl_xor(a, 2); a += __shfl_xor(a, 4);
      if (part == 0) ktab[(jg * 32 + d) * 256 + pp * 16 + q] = a;
    }
  }
}

DI void ln_phase(const Params& p, int ls) {
  const int tid = opqv(threadIdx.x), lane = tid & 63, w = tid >> 6;
  char* ws = opq(p.ws);
  const float* mod = (const float*)(ws + OFF_MOD);
  u16* hy = (u16*)(ws + OFF_HY);
  const float* xin = (ls == 0) ? p.x : p.out;
  const float* lg = p.ln_g + ls * 1024; const float* lb = p.ln_b + ls * 1024;
  const int stride = gridDim.x * 8;
  f32x4 xc[4], xn[4]; uint2 yc[4], yn[4];
  {
    const int row = blockIdx.x * 8 + w;
#pragma unroll
    for (int i = 0; i < 4; ++i) {
      const int col = lane * 4 + 256 * i;
      xc[i] = *(const f32x4*)(xin + (size_t)row * 1024 + col);
      yc[i] = *(const uint2*)(hy + (size_t)row * LDH + col);
    }
  }
  for (int row = blockIdx.x * 8 + w; row < T_; row += stride) {
    const int b = row >> 14;
    const float* gate = mod + (ls * 2 + b) * 3072 + 2048;
    const int rn = row + stride;
    if (rn < T_) {
#pragma unroll
      for (int i = 0; i < 4; ++i) {
        const int col = lane * 4 + 256 * i;
        xn[i] = *(const f32x4*)(xin + (size_t)rn * 1024 + col);
        yn[i] = *(const uint2*)(hy + (size_t)rn * LDH + col);
      }
    }
    float v[16];
    float sum = 0.f;
#pragma unroll
    for (int i = 0; i < 4; ++i) {
      const int col = lane * 4 + 256 * i;
      const f32x4 xv = xc[i];
      const uint2 yv = yc[i];
      const float4 g = *(const float4*)(gate + col);
      v[4 * i + 0] = DN_ALPHA * xv.x + (1.f + g.x) * bf2f(yv.x & 0xffffu);
      v[4 * i + 1] = DN_ALPHA * xv.y + (1.f + g.y) * bf2f(yv.x >> 16);
      v[4 * i + 2] = DN_ALPHA * xv.z + (1.f + g.z) * bf2f(yv.y & 0xffffu);
      v[4 * i + 3] = DN_ALPHA * xv.w + (1.f + g.w) * bf2f(yv.y >> 16);
      sum += v[4 * i] + v[4 * i + 1] + v[4 * i + 2] + v[4 * i + 3];
    }
#pragma unroll
    for (int m = 32; m >= 1; m >>= 1) sum += __shfl_xor(sum, m);
    const float mean = sum * (1.f / 1024.f);
    float vs = 0.f;
#pragma unroll
    for (int i = 0; i < 16; ++i) { const float d = v[i] - mean; vs += d * d; }
#pragma unroll
    for (int m = 32; m >= 1; m >>= 1) vs += __shfl_xor(vs, m);
    const float rstd = rsqrtf(vs * (1.f / 1024.f) + 1e-5f);
#pragma unroll
    for (int i = 0; i < 4; ++i) {
      const int col = lane * 4 + 256 * i;
      const float4 g = *(const float4*)(lg + col); const float4 bb = *(const float4*)(lb + col);
      float4 o;
      o.x = (v[4 * i + 0] - mean) * rstd * g.x + bb.x; o.y = (v[4 * i + 1] - mean) * rstd * g.y + bb.y;
      o.z = (v[4 * i + 2] - mean) * rstd * g.z + bb.z; o.w = (v[4 * i + 3] - mean) * rstd * g.w + bb.w;
      *(float4*)(p.out + (size_t)row * 1024 + col) = o;
      if (ls < 7) {
        const float* m2 = mod + ((ls + 1) * 2 + b) * 3072;
        const float4 sh = *(const float4*)(m2 + col); const float4 sc = *(const float4*)(m2 + 1024 + col);
        uint2 h;
        h.x = pack2(o.x * (1.f + sc.x) + sh.x, o.y * (1.f + sc.y) + sh.y);
        h.y = pack2(o.z * (1.f + sc.z) + sh.z, o.w * (1.f + sc.w) + sh.w);
        *(uint2*)(hy + (size_t)row * LDH + col) = h;
      }
    }
#pragma unroll
    for (int i = 0; i < 4; ++i) { xc[i] = xn[i]; yc[i] = yn[i]; }
  }
}

template <int V = 0>
DI void gemm_plain(const u16* A, int lda, int K, const u16* Wt, int ldb, int N, u16* C, int ldc, int mode, char* smem) {
  const int tid = opqv(threadIdx.x), lane = tid & 63, w = tid >> 6, wm = w >> 2, wn = w & 3, l32 = lane & 31, hf = lane >> 5;
  const int nN = N / 256;
  for (int lt = blockIdx.x >> 3; lt < 16 * nN; lt += gridDim.x >> 3) {
    int mt, nt; tile_map(lt, 16, nN, 8, 4, mt, nt);
    const int m0 = mt * 256, n0 = nt * 256;
    gemm_tile<V>(A + (size_t)m0 * lda, lda, K / 64, nullptr, 0, 0, Wt + (size_t)n0 * ldb, ldb, smem, [&](f32x16(&acc)[2][2], int moff) {
      const int m0_ = m0 + moff;
      int l32_ = l32, hf_ = hf; asm volatile("" : "+v"(l32_), "+v"(hf_));
#pragma unroll
      for (int i = 0; i < 2; ++i)
#pragma unroll
        for (int j = 0; j < 2; ++j)
#pragma unroll
          for (int r = 0; r < 16; ++r) {
            const int row = m0_ + wm * 64 + i * 32 + crow(r, hf_), col = n0 + wn * 64 + j * 32 + l32_;
            float v = acc[i][j][r];
            if (mode == 1) { v = fmaxf(v, 0.f); v = v * v; }
            if (V == 0 || v == 123456.789f) C[(size_t)row * ldc + col] = f2bf(v);
          }
    });
  }
}

DI void att_in_phase(const Params& p, int j, char* smem) {
  const int tid = opqv(threadIdx.x), lane = tid & 63, w = tid >> 6, wm = w >> 2, wn = w & 3, l32 = lane & 31, hf = lane >> 5;
  char* ws = opq(p.ws);
  const u16* A = (const u16*)(ws + OFF_HY);
  const u16* Wt = (const u16*)(ws + OFF_W_ATTIN) + (size_t)j * 1536 * LDW1;
  u16* zc = (u16*)(ws + OFF_ZC); u16* SQ = (u16*)(ws + OFF_SQ); u16* SK = (u16*)(ws + OFF_SK); u16* SV = (u16*)(ws + OFF_SV);
  u16* Kb = (u16*)(ws + OFF_KB);
  const float2* rt64 = (const float2*)(ws + OFF_RT64); const float2* rt32 = (const float2*)(ws + OFF_RT32);
  const int nN = 6;
  for (int lt = blockIdx.x >> 3; lt < 16 * nN; lt += gridDim.x >> 3) {
    int mt, nt; tile_map(lt, 16, nN, 16, 2, mt, nt);
    const int m0 = mt * 256, n0 = nt * 256;
    gemm_tile(A + (size_t)m0 * LDH, LDH, 16, nullptr, 0, 0, Wt + (size_t)n0 * LDW1, LDW1, smem, [&](f32x16(&acc)[2][2], int moff) {
      const int m0_ = m0 + moff;
      int l32_ = l32, hf_ = hf; asm volatile("" : "+v"(l32_), "+v"(hf_));
      const int C64 = n0 + wn * 64;
#pragma unroll
      for (int i = 0; i < 2; ++i) {
        const int rb = m0_ + wm * 64 + i * 32;
        if (C64 < 640) {
#pragma unroll
          for (int jn = 0; jn < 2; ++jn)
#pragma unroll
            for (int r = 0; r < 16; ++r) zc[(size_t)(rb + crow(r, hf_)) * 640 + C64 + jn * 32 + l32_] = f2bf(acc[i][jn][r]);
        } else if (C64 < 1280) {
          const bool isq = C64 < 1152;
          u16* dst = isq ? SQ : SK; const int pitch = isq ? 512 : 128; const int cb = isq ? (C64 - 640) : (C64 - 1152);
          const float sc = isq ? SWA_QSCALE : 1.f;
#pragma unroll
          for (int r = 0; r < 16; ++r) {
            const int t = rb + crow(r, hf_), pos = t & (S_ - 1);
            const float2 cs = rt64[pos * 32 + l32_];
            const float x1 = acc[i][0][r], x2 = acc[i][1][r];
            dst[(size_t)t * pitch + cb + l32_] = f2bf((x1 * cs.x - x2 * cs.y) * sc);
            dst[(size_t)t * pitch + cb + 32 + l32_] = f2bf((x2 * cs.x + x1 * cs.y) * sc);
          }
        } else if (C64 < 1408) {
#pragma unroll
          for (int jn = 0; jn < 2; ++jn)
#pragma unroll
            for (int r = 0; r < 16; ++r) SV[(size_t)(rb + crow(r, hf_)) * 128 + (C64 - 1280) + jn * 32 + l32_] = f2bf(acc[i][jn][r]);
        } else if (C64 == 1408) {
#pragma unroll
          for (int r = 0; r < 16; ++r) {
            const int t = rb + crow(r, hf_), pos = t & (S_ - 1);
            const float x = acc[i][0][r];
            const float xp = __shfl_xor(x, 16);
            const float2 cs = rt32[pos * 16 + (l32_ & 15)];
            const float o = (l32_ < 16) ? (x * cs.x - xp * cs.y) : (x * cs.x + xp * cs.y);
            const u16 v = f2bf(o);
#pragma unroll
            for (int h = 0; h < 8; ++h) Kb[(size_t)t * LDKB + h * 96 + 64 + l32_] = v;
          }
        }
      }
    });
  }
}

DI void qkv_phase(const Params& p, int j, char* smem) {
  const int tid = opqv(threadIdx.x), lane = tid & 63, w = tid >> 6, wm = w >> 2, wn = w & 3, l32 = lane & 31, hf = lane >> 5;
  char* ws = opq(p.ws);
  const u16* zc = (const u16*)(ws + OFF_ZC);
  const u16* Wq = (const u16*)(ws + OFF_W_UQ) + (size_t)j * 768 * 384;
  const u16* Wkv = (const u16*)(ws + OFF_W_UKV) + (size_t)j * 1024 * 256;
  u16* Qb = (u16*)(ws + OFF_QB); u16* Kb = (u16*)(ws + OFF_KB); u16* Vt = (u16*)(ws + OFF_VT);
  const float2* rt32 = (const float2*)(ws + OFF_RT32);
  float* rsc = (float*)(smem + SMEM_GEMM);
  for (int lt0 = blockIdx.x >> 3; lt0 < 16 * 7; lt0 += gridDim.x >> 3) {
    const bool isq = lt0 < 16 * 3;
    int mt, nt;
    if (isq) tile_map(lt0, 16, 3, 16, 1, mt, nt); else tile_map(lt0 - 16 * 3, 16, 4, 8, 4, mt, nt);
    const int m0 = mt * 256, n0 = nt * 256;
    const int coff = isq ? 0 : 384, ncols = isq ? 384 : 256;
    {
      const int row = tid >> 1, half = tid & 1, nh = ncols / 2;
      const u16* src = zc + (size_t)(m0 + row) * 640 + coff + half * nh;
      float s = 0.f;
      for (int c = 0; c < nh; c += 8) {
        const uint4 v = *(const uint4*)(src + c);
        float f;
        f = bf2f(v.x & 0xffffu); s += f * f; f = bf2f(v.x >> 16); s += f * f;
        f = bf2f(v.y & 0xffffu); s += f * f; f = bf2f(v.y >> 16); s += f * f;
        f = bf2f(v.z & 0xffffu); s += f * f; f = bf2f(v.z >> 16); s += f * f;
        f = bf2f(v.w & 0xffffu); s += f * f; f = bf2f(v.w >> 16); s += f * f;
      }
      s += __shfl_xor(s, 1);
      if (half == 0) rsc[row] = rsqrtf(s / (float)ncols + 1e-6f);
    }
    __syncthreads();
    if (isq) {
      gemm_tile(zc + (size_t)m0 * 640, 640, 6, nullptr, 0, 0, Wq + (size_t)n0 * 384, 384, smem, [&](f32x16(&acc)[2][2], int moff) {
      const int m0_ = m0 + moff;
      int l32_ = l32, hf_ = hf; asm volatile("" : "+v"(l32_), "+v"(hf_));
        const int C64 = n0 + wn * 64;
#pragma unroll
        for (int i = 0; i < 2; ++i) {
          const int rl = wm * 64 + i * 32;
#pragma unroll
          for (int jn = 0; jn < 2; ++jn)
#pragma unroll
            for (int r = 0; r < 16; ++r) {
              const int rr = rl + crow(r, hf_), t = m0_ + rr;
              const float x = acc[i][jn][r] * rsc[moff + rr] * MLA_QSCALE;
              if (C64 < 512) {
                Qb[(size_t)t * 768 + (C64 >> 6) * 96 + jn * 32 + l32_] = f2bf(x);
              } else {
                const int hq = ((C64 - 512) >> 5) + jn, pos = t & (S_ - 1);
                const float xp = __shfl_xor(x, 16);
                const float2 cs = rt32[pos * 16 + (l32_ & 15)];
                const float o = (l32_ < 16) ? (x * cs.x - xp * cs.y) : (x * cs.x + xp * cs.y);
                Qb[(size_t)t * 768 + hq * 96 + 64 + l32_] = f2bf(o);
              }
            }
        }
      });
    } else {
      gemm_tile(zc + (size_t)m0 * 640 + 384, 640, 4, nullptr, 0, 0, Wkv + (size_t)n0 * 256, 256, smem, [&](f32x16(&acc)[2][2], int moff) {
      const int m0_ = m0 + moff;
      int l32_ = l32, hf_ = hf; asm volatile("" : "+v"(l32_), "+v"(hf_));
        const int C64 = n0 + wn * 64, h = C64 >> 7, part = (C64 >> 6) & 1;
#pragma unroll
        for (int i = 0; i < 2; ++i) {
          const int rl = wm * 64 + i * 32;
#pragma unroll
          for (int jn = 0; jn < 2; ++jn) {
            if (part == 0) {
#pragma unroll
              for (int r = 0; r < 16; ++r) {
                const int rr = rl + crow(r, hf_), t = m0_ + rr;
                Kb[(size_t)t * LDKB + h * 96 + jn * 32 + l32_] = f2bf(acc[i][jn][r] * rsc[moff + rr]);
              }
            } else {
              const int e = jn * 32 + l32_;
#pragma unroll
              for (int qd = 0; qd < 4; ++qd) {
                const int rr = rl + 8 * qd + 4 * hf_, t0 = m0_ + rr, b = t0 >> 14, s0 = t0 & (S_ - 1);
                uint2 o;
                o.x = pack2(acc[i][jn][4 * qd + 0] * rsc[moff + rr + 0], acc[i][jn][4 * qd + 1] * rsc[moff + rr + 1]);
                o.y = pack2(acc[i][jn][4 * qd + 2] * rsc[moff + rr + 2], acc[i][jn][4 * qd + 3] * rsc[moff + rr + 3]);
                *(uint2*)(Vt + ((size_t)((b * 8 + h) * 64 + e)) * LDV + s0) = o;
              }
            }
          }
        }
      });
    }
    __syncthreads();
  }
}

constexpr int MLA_BUF = 64 * 208 + 64 * 136;
constexpr int MLA_SVP = 264;
constexpr int MLA_BUF2 = 128 * 208 + 64 * MLA_SVP;
DI void mla_item(const Params& p, int qb, int b, int h, char* smem) {
  const int tid = opqv(threadIdx.x), lane = tid & 63, w = tid >> 6, l32 = lane & 31, hf = lane >> 5;
  char* ws = opq(p.ws);
  const u16* Qb = (const u16*)(ws + OFF_QB); u16* o = (u16*)(ws + OFF_OE);
  const int q0 = qb * 256 + w * 32;
  const size_t tq = (size_t)b * S_ + q0 + l32;
  bf16x8 qf[6];
#pragma unroll
  for (int s = 0; s < 6; ++s) qf[s] = *(const bf16x8*)(Qb + tq * 768 + h * 96 + s * 16 + hf * 8);
  f32x16 ot[2]; ot[0] = zero16(); ot[1] = zero16();
  float m = -1e30f, l = 0.f;
  const int ntile = 2 * qb + 2;
  const u16* Kg = (const u16*)(ws + OFF_KB) + ((size_t)b * S_) * LDKB + h * 96;
  const u16* Vg = (const u16*)(ws + OFF_VT) + ((size_t)(b * 8 + h) * 64) * LDV;
  u32x4 rk[2][3], rv[2][2];
#define MGLOAD(SET, KT) { const int kt_ = (KT); \
    _Pragma("unroll") for (int i = 0; i < 3; ++i) { const int c = tid + 512 * i, row = c / 12, ch = c % 12; rk[SET][i] = *(const u32x4*)(Kg + (size_t)(kt_ * 128 + row) * LDKB + ch * 8); } \
    _Pragma("unroll") for (int i = 0; i < 2; ++i) { const int c = tid + 512 * i, row = c >> 4, ch = c & 15; rv[SET][i] = *(const u32x4*)(Vg + (size_t)row * LDV + kt_ * 128 + ch * 8); } }
#define MSWRITE(SET, BUF) { char* sk_ = smem + (BUF) * MLA_BUF2; char* sv_ = sk_ + 128 * 208; \
    _Pragma("unroll") for (int i = 0; i < 3; ++i) { const int c = tid + 512 * i, row = c / 12, ch = c % 12; *(u32x4*)(sk_ + row * 208 + ch * 16) = rk[SET][i]; } \
    _Pragma("unroll") for (int i = 0; i < 2; ++i) { const int c = tid + 512 * i, row = c >> 4, ch = c & 15; \
      *(uint2*)(sv_ + row * MLA_SVP + ch * 16) = make_uint2(rv[SET][i].x, rv[SET][i].y); \
      *(uint2*)(sv_ + row * MLA_SVP + ch * 16 + 8) = make_uint2(rv[SET][i].z, rv[SET][i].w); } }
  auto compute = [&](int kt, int sub) {
    const char* sk = smem + (kt & 1) * MLA_BUF2 + sub * (64 * 208); const char* sv = smem + (kt & 1) * MLA_BUF2 + 128 * 208 + sub * 128;
    const int k0 = kt * 128 + sub * 64;
    if (k0 <= q0 + 31) {
      f32x16 st[2];
      bf16x8 kf[2][6];
#pragma unroll
      for (int t32 = 0; t32 < 2; ++t32)
#pragma unroll
        for (int s = 0; s < 6; ++s) kf[t32][s] = *(const bf16x8*)(sk + (t32 * 32 + l32) * 208 + (s * 16 + hf * 8) * 2);
      __builtin_amdgcn_sched_barrier(0);
      __builtin_amdgcn_s_setprio(1);
#pragma unroll
      for (int t32 = 0; t32 < 2; ++t32) {
        st[t32] = zero16();
#pragma unroll
        for (int s = 0; s < 6; ++s) st[t32] = MFMA(kf[t32][s], qf[s], st[t32]);
      }
      __builtin_amdgcn_s_setprio(0);
      bf16x8 vf[2][2][2];
#pragma unroll
      for (int t32 = 0; t32 < 2; ++t32)
#pragma unroll
        for (int s = 0; s < 2; ++s)
#pragma unroll
          for (int mt = 0; mt < 2; ++mt) {
            const char* vp = sv + (mt * 32 + l32) * MLA_SVP + (t32 * 32 + s * 16 + hf * 4) * 2;
            vf[t32][s][mt] = join8(*(const uint2*)vp, *(const uint2*)(vp + 16));
          }
      __builtin_amdgcn_sched_barrier(0);
      if (k0 + 63 > q0) {
        const int qpos = q0 + l32;
#pragma unroll
        for (int t32 = 0; t32 < 2; ++t32)
#pragma unroll
          for (int r = 0; r < 16; ++r) { const int key = k0 + t32 * 32 + crow(r, hf); if (key > qpos) st[t32][r] = -1e30f; }
      }
      float mx = -1e30f;
#pragma unroll
      for (int t32 = 0; t32 < 2; ++t32)
#pragma unroll
        for (int r = 0; r < 16; ++r) mx = fmaxf(mx, st[t32][r]);
      mx = fmaxf(mx, __shfl_xor(mx, 32));
      const float mn = fmaxf(m, mx);
      const float alpha = ex2(m - mn);
      m = mn;
      float ps = 0.f;
#pragma unroll
      for (int t32 = 0; t32 < 2; ++t32)
#pragma unroll
        for (int r = 0; r < 16; ++r) { const float pv = ex2(st[t32][r] - mn); st[t32][r] = pv; ps += pv; }
      l = l * alpha + ps;
#pragma unroll
      for (int mt = 0; mt < 2; ++mt)
#pragma unroll
        for (int r = 0; r < 16; ++r) ot[mt][r] *= alpha;
      __builtin_amdgcn_s_setprio(1);
#pragma unroll
      for (int t32 = 0; t32 < 2; ++t32)
#pragma unroll
        for (int s = 0; s < 2; ++s) {
          const bf16x8 pf = pack8(st[t32], s);
#pragma unroll
          for (int mt = 0; mt < 2; ++mt) ot[mt] = MFMA(vf[t32][s][mt], pf, ot[mt]);
        }
      __builtin_amdgcn_s_setprio(0);
    }
  };
  MGLOAD(0, 0); MGLOAD(1, 1);
  MSWRITE(0, 0); __syncthreads();
  for (int kt = 0; kt < ntile; kt += 2) {
    if (kt + 2 < ntile) MGLOAD(0, kt + 2);
    __builtin_amdgcn_sched_barrier(0);
    compute(kt, 0); compute(kt, 1);
    MSWRITE(1, 1);
    __syncthreads();
    if (kt + 3 < ntile) MGLOAD(1, kt + 3);
    __builtin_amdgcn_sched_barrier(0);
    compute(kt + 1, 0); compute(kt + 1, 1);
    if (kt + 2 < ntile) MSWRITE(0, 0);
    __syncthreads();
  }
#undef MGLOAD
#undef MSWRITE
  l += __shfl_xor(l, 32);
  const float inv = 1.f / l;
#pragma unroll
  for (int mt = 0; mt < 2; ++mt)
#pragma unroll
    for (int qd = 0; qd < 4; ++qd) {
      const int e0 = mt * 32 + 8 * qd + 4 * hf;
      uint2 ov;
      ov.x = pack2(ot[mt][4 * qd + 0] * inv, ot[mt][4 * qd + 1] * inv);
      ov.y = pack2(ot[mt][4 * qd + 2] * inv, ot[mt][4 * qd + 3] * inv);
      *(uint2*)(o + tq * LDH + h * 64 + e0) = ov;
    }
}

DI void swa_item(const Params& p, int j, int b, int nblk, int kvh, char* smem) {
  const int tid = opqv(threadIdx.x) & 255, lane = tid & 63, w = tid >> 6, l32 = lane & 31, hf = lane >> 5;
  char* ws = opq(p.ws);
  const u16* SQ = (const u16*)(ws + OFF_SQ); const u16* SK = (const u16*)(ws + OFF_SK); const u16* SV = (const u16*)(ws + OFF_SV);
  u16* o = (u16*)(ws + OFF_OE);
  char* sk = smem; char* sv = smem + 256 * 144;
  const int ws0 = 128 * (nblk - 1);
#pragma unroll
  for (int i = 0; i < 8; ++i) {
    const int c = tid + 256 * i, row = c >> 3, ch = c & 7, pos = ws0 + row;
    uint4 kv = make_uint4(0, 0, 0, 0), vv = make_uint4(0, 0, 0, 0);
    if (pos >= 0) {
      kv = *(const uint4*)(SK + ((size_t)b * S_ + pos) * 128 + kvh * 64 + ch * 8);
      vv = *(const uint4*)(SV + ((size_t)b * S_ + pos) * 128 + kvh * 64 + ch * 8);
    }
    *(uint4*)(sk + row * 144 + ch * 16) = kv;
    char* vb = sv + (ch * 8) * 528 + row * 2;
    *(u16*)(vb + 0 * 528) = (u16)(vv.x & 0xffffu); *(u16*)(vb + 1 * 528) = (u16)(vv.x >> 16);
    *(u16*)(vb + 2 * 528) = (u16)(vv.y & 0xffffu); *(u16*)(vb + 3 * 528) = (u16)(vv.y >> 16);
    *(u16*)(vb + 4 * 528) = (u16)(vv.z & 0xffffu); *(u16*)(vb + 5 * 528) = (u16)(vv.z >> 16);
    *(u16*)(vb + 6 * 528) = (u16)(vv.w & 0xffffu); *(u16*)(vb + 7 * 528) = (u16)(vv.w >> 16);
  }
  __syncthreads();
  const size_t tq = (size_t)b * S_ + nblk * 128 + w * 32 + l32;
  const int qloc = 128 + w * 32 + l32;
#pragma unroll 1
  for (int g = 0; g < 4; ++g) {
    const int head = kvh * 4 + g;
    bf16x8 qf[4];
#pragma unroll
    for (int s = 0; s < 4; ++s) qf[s] = *(const bf16x8*)(SQ + tq * 512 + head * 64 + s * 16 + hf * 8);
    f32x16 st[5];
    const float sink2 = p.swa_sinks[j * 8 + head] * LOG2E;
    float mx = sink2;
#pragma unroll
    for (int tt = 0; tt < 5; ++tt) {
      const int kb = w * 32 + tt * 32;
      st[tt] = zero16();
#pragma unroll
      for (int s = 0; s < 4; ++s) {
        const bf16x8 kf = *(const bf16x8*)(sk + (kb + l32) * 144 + (s * 16 + hf * 8) * 2);
        st[tt] = MFMA(kf, qf[s], st[tt]);
      }
#pragma unroll
      for (int r = 0; r < 16; ++r) {
        const int kloc = kb + crow(r, hf);
        const bool valid = (kloc <= qloc) && (kloc > qloc - 128) && (ws0 + kloc >= 0);
        const float v = valid ? st[tt][r] : -1e30f;
        st[tt][r] = v; mx = fmaxf(mx, v);
      }
    }
    mx = fmaxf(mx, __shfl_xor(mx, 32));
    float ps = 0.f;
#pragma unroll
    for (int tt = 0; tt < 5; ++tt)
#pragma unroll
      for (int r = 0; r < 16; ++r) { const float pv = ex2(st[tt][r] - mx); st[tt][r] = pv; ps += pv; }
    ps += __shfl_xor(ps, 32);
    const float inv = 1.f / (ps + ex2(sink2 - mx));
    f32x16 ot[2]; ot[0] = zero16(); ot[1] = zero16();
#pragma unroll
    for (int tt = 0; tt < 5; ++tt) {
      const int kb = w * 32 + tt * 32;
#pragma unroll
      for (int s = 0; s < 2; ++s) {
        const bf16x8 pf = pack8(st[tt], s);
#pragma unroll
        for (int mt = 0; mt < 2; ++mt) {
          const char* vp = sv + (mt * 32 + l32) * 528 + (kb + s * 16 + hf * 4) * 2;
          const bf16x8 vf = join8(*(const uint2*)vp, *(const uint2*)(vp + 16));
          ot[mt] = MFMA(vf, pf, ot[mt]);
        }
      }
    }
#pragma unroll
    for (int mt = 0; mt < 2; ++mt)
#pragma unroll
      for (int qd = 0; qd < 4; ++qd) {
        const int e0 = mt * 32 + 8 * qd + 4 * hf;
        uint2 ov;
        ov.x = pack2(ot[mt][4 * qd + 0] * inv, ot[mt][4 * qd + 1] * inv);
        ov.y = pack2(ot[mt][4 * qd + 2] * inv, ot[mt][4 * qd + 3] * inv);
        *(uint2*)(o + tq * LDH + 512 + head * 64 + e0) = ov;
      }
  }
  __syncthreads();
}

DI void attn_phase(const Params& p, int j, int ctr_idx, char* smem) {
  __shared__ int s_item;
  const int xcd = blockIdx.x & 7;
  int* ctr = (int*)(p.ws + OFF_CTR) + 16 + ctr_idx * 8 + xcd;
  const int nmla = 128, nswa = 32;
  const int half = opqv(threadIdx.x) >> 8;
  char* sm = smem + half * HALF_SMEM;
  for (;;) {
    __syncthreads();
    if (threadIdx.x == 0) s_item = atomicAdd(ctr, 1);
    __syncthreads();
    const int it = s_item;
    if (it >= nmla + nswa) break;
    if (it < nmla) {
      const int qb = 63 - (it >> 1), bh = xcd * 2 + (it & 1);
      mla_item(p, qb, bh >> 3, bh & 7, smem);
    } else {
      const int k = (xcd * nswa + (it - nmla)) * 2 + half;
      swa_item(p, j, k >> 8, (k >> 1) & 127, k & 1, sm);
    }
  }
}

DI void rec_in_phase(const Params& p, int j, char* smem) {
  const int tid = opqv(threadIdx.x), lane = tid & 63, w = tid >> 6, wm = w >> 2, wn = w & 3, l32 = lane & 31, hf = lane >> 5;
  char* ws = opq(p.ws);
  const u16* A = (const u16*)(ws + OFF_HY);
  const u16* Wt = (const u16*)(ws + OFF_W_RECIN) + (size_t)j * 2560 * LDW1;
  u16* zr = (u16*)(ws + OFF_ZR); u16* ug = (u16*)(ws + OFF_UG);
  const float2* rt128 = (const float2*)(ws + OFF_RT128);
  const int nN = 10;
  for (int lt = blockIdx.x >> 3; lt < 16 * nN; lt += gridDim.x >> 3) {
    int mt, nt; tile_map(lt, 16, nN, 16, 2, mt, nt);
    const int m0 = mt * 256, n0 = nt * 256;
    gemm_tile(A + (size_t)m0 * LDH, LDH, 16, nullptr, 0, 0, Wt + (size_t)n0 * LDW1, LDW1, smem, [&](f32x16(&acc)[2][2], int moff) {
      const int m0_ = m0 + moff;
      int l32_ = l32, hf_ = hf; asm volatile("" : "+v"(l32_), "+v"(hf_));
      const int C64 = n0 + wn * 64;
#pragma unroll
      for (int i = 0; i < 2; ++i) {
        const int rb = m0_ + wm * 64 + i * 32;
        if (C64 < 1024) {
          const int fi = ((C64 & 127) >> 1) + l32_, cbase = C64 & ~127;
          const float sc = (C64 >= 512) ? RET_KSCALE : 1.f;
#pragma unroll
          for (int r = 0; r < 16; ++r) {
            const int t = rb + crow(r, hf_), pos = t & (S_ - 1);
            const float2 cs = rt128[pos * 64 + fi];
            const float x1 = acc[i][0][r], x2 = acc[i][1][r];
            zr[(size_t)t * LDZR + cbase + fi] = f2bf((x1 * cs.x - x2 * cs.y) * sc);
            zr[(size_t)t * LDZR + cbase + 64 + fi] = f2bf((x2 * cs.x + x1 * cs.y) * sc);
          }
        } else if (C64 < 2048) {
#pragma unroll
          for (int jn = 0; jn < 2; ++jn)
#pragma unroll
            for (int r = 0; r < 16; ++r) zr[(size_t)(rb + crow(r, hf_)) * LDZR + C64 + jn * 32 + l32_] = f2bf(acc[i][jn][r]);
        } else {
#pragma unroll
          for (int jn = 0; jn < 2; ++jn) {
            const int cl = C64 - 2048 + jn * 32 + l32_, g = cl >> 4, pp = cl & 15;
#pragma unroll
            for (int r = 0; r < 16; ++r) ug[((size_t)g * T_ + rb + crow(r, hf_)) * 16 + pp] = f2bf(acc[i][jn][r]);
          }
        }
      }
    });
  }
}

DI void s5_fill(const Params& p, int j) {
  const int tid = opqv(threadIdx.x), nb = gridDim.x, bid = blockIdx.x;
  char* ws = opq(p.ws);
  const float4* s5z = (const float4*)(ws + OFF_S5Z) + j * 2048; const float2* bbar = (const float2*)(ws + OFF_BBAR) + j * 2048 * 16;
  const float* ktab = (const float*)(ws + OFF_KTAB) + (size_t)j * 32 * 32 * 256;
  u16* WE = (u16*)(ws + OFF_WE); u16* WY = (u16*)(ws + OFF_WY);
  for (int idx = bid * NTHR + tid; idx < 32 * 256 * 512; idx += nb * NTHR) {
    const int g = idx >> 17, n2 = (idx >> 9) & 255, k = idx & 511, jj = k >> 4, q = k & 15, n = n2 & 63;
    if (n2 >= 128) { WE[idx] = 0; continue; }
    const float4 z = s5z[g * 64 + n];
    const float d = (float)(31 - jj);
    const float mg = expf(d * z.x), ang = d * z.y; float sn_, cs_; sincos_(ang, sn_, cs_);
    const float er = mg * cs_, ei = mg * sn_;
    const float2 bb = bbar[(g * 64 + n) * 16 + q];
    const float v = (n2 < 64) ? (er * bb.x - ei * bb.y) : (er * bb.y + ei * bb.x);
    WE[idx] = f2bf(v);
  }
  for (int idx = bid * NTHR + tid; idx < 32 * 512 * 640; idx += nb * NTHR) {
    const int g = idx / (512 * 640), rem = idx - g * (512 * 640), mrow = rem / 640, k = rem - mrow * 640;
    const int i = mrow >> 4, pp = mrow & 15;
    float v;
    if (k < 512) {
      const int jj = k >> 4, q = k & 15, d = i - jj;
      v = (d >= 0) ? ktab[(g * 32 + d) * 256 + pp * 16 + q] : 0.f;
      if (d == 0 && q == pp) v += p.s5_d[j * 512 + g * 16 + pp];
    } else {
      const int n2 = k - 512, n = n2 & 63;
      const float4 z = s5z[g * 64 + n];
      const float d = (float)(i + 1);
      const float mg = expf(d * z.x), ang = d * z.y; float sn_, cs_; sincos_(ang, sn_, cs_);
    const float er = mg * cs_, ei = mg * sn_;
      const float cr = p.s5_c_re[((j * 32 + g) * 16 + pp) * 64 + n], ci = p.s5_c_im[((j * 32 + g) * 16 + pp) * 64 + n];
      v = (n2 < 64) ? (cr * er - ci * ei) : -(cr * ei + ci * er);
    }
    WY[idx] = f2bf(v);
  }
}

DI void ret_u_item(const Params& p, int b, int n, int h, char* smem) {
  const int tid = opqv(threadIdx.x) & 255, lane = tid & 63, w = tid >> 6, wm = w >> 1, wn = w & 1, l32 = lane & 31, hf = lane >> 5;
  char* ws = opq(p.ws);
  const u16* zr = (const u16*)(ws + OFF_ZR); float* U = (float*)(ws + OFF_UO);
  char* sKt = smem; char* sVt = smem + 128 * 272;
  const size_t t0 = (size_t)b * S_ + n * 128;
  const float lg = lg2gamma(h);
#pragma unroll
  for (int i = 0; i < 8; ++i) {
    const int c = tid + 256 * i, row = c >> 4, ch = c & 15;
    const uint4 kv = *(const uint4*)(zr + (t0 + row) * LDZR + 512 + h * 128 + ch * 8);
    const uint4 vv = *(const uint4*)(zr + (t0 + row) * LDZR + 1024 + h * 128 + ch * 8);
    const float te = ex2((float)(127 - row) * lg);
    char* kb = sKt + (ch * 8) * 272 + row * 2; char* vb = sVt + (ch * 8) * 272 + row * 2;
    *(u16*)(kb + 0 * 272) = f2bf(bf2f(kv.x & 0xffffu) * te); *(u16*)(kb + 1 * 272) = f2bf(bf2f(kv.x >> 16) * te);
    *(u16*)(kb + 2 * 272) = f2bf(bf2f(kv.y & 0xffffu) * te); *(u16*)(kb + 3 * 272) = f2bf(bf2f(kv.y >> 16) * te);
    *(u16*)(kb + 4 * 272) = f2bf(bf2f(kv.z & 0xffffu) * te); *(u16*)(kb + 5 * 272) = f2bf(bf2f(kv.z >> 16) * te);
    *(u16*)(kb + 6 * 272) = f2bf(bf2f(kv.w & 0xffffu) * te); *(u16*)(kb + 7 * 272) = f2bf(bf2f(kv.w >> 16) * te);
    *(u16*)(vb + 0 * 272) = (u16)(vv.x & 0xffffu); *(u16*)(vb + 1 * 272) = (u16)(vv.x >> 16);
    *(u16*)(vb + 2 * 272) = (u16)(vv.y & 0xffffu); *(u16*)(vb + 3 * 272) = (u16)(vv.y >> 16);
    *(u16*)(vb + 4 * 272) = (u16)(vv.z & 0xffffu); *(u16*)(vb + 5 * 272) = (u16)(vv.z >> 16);
    *(u16*)(vb + 6 * 272) = (u16)(vv.w & 0xffffu); *(u16*)(vb + 7 * 272) = (u16)(vv.w >> 16);
  }
  __syncthreads();
  f32x16 acc[2][2];
#pragma unroll
  for (int i = 0; i < 2; ++i)
#pragma unroll
    for (int jn = 0; jn < 2; ++jn) acc[i][jn] = zero16();
#pragma unroll
  for (int s = 0; s < 8; ++s) {
    bf16x8 af[2], bfr[2];
#pragma unroll
    for (int i = 0; i < 2; ++i) af[i] = *(const bf16x8*)(sVt + (wm * 64 + i * 32 + l32) * 272 + (s * 16 + hf * 8) * 2);
#pragma unroll
    for (int jn = 0; jn < 2; ++jn) bfr[jn] = *(const bf16x8*)(sKt + (wn * 64 + jn * 32 + l32) * 272 + (s * 16 + hf * 8) * 2);
#pragma unroll
    for (int i = 0; i < 2; ++i)
#pragma unroll
      for (int jn = 0; jn < 2; ++jn) acc[i][jn] = MFMA(af[i], bfr[jn], acc[i][jn]);
  }
  float* Ub = U + ((size_t)((b * 4 + h) * 128 + n)) * 16384;
#pragma unroll
  for (int i = 0; i < 2; ++i)
#pragma unroll
    for (int jn = 0; jn < 2; ++jn)
#pragma unroll
      for (int r = 0; r < 16; ++r) Ub[(wm * 64 + i * 32 + crow(r, hf)) * 128 + wn * 64 + jn * 32 + l32] = acc[i][jn][r];
  __syncthreads();
}

DI void rec_state_phase(const Params& p, int j, char* smem) {
  const int tid = opqv(threadIdx.x), lane = tid & 63, w = tid >> 6, wm = w >> 2, wn = w & 3, l32 = lane & 31, hf = lane >> 5;
  char* ws = opq(p.ws);
  {
    const int half = opqv(threadIdx.x) >> 8;
    char* sm = smem + half * HALF_SMEM;
    for (int it = blockIdx.x; it < 512; it += gridDim.x) { const int item = it * 2 + half; ret_u_item(p, item >> 9, (item >> 2) & 127, item & 3, sm); }
  }
  for (int it = blockIdx.x; it < 128; it += gridDim.x) {
    const int g = it >> 2, mt = it & 3, m0 = mt * 256;
    const u16* A = (const u16*)(ws + OFF_UG) + (size_t)g * T_ * 16 + (size_t)m0 * 512;
    const u16* Bt = (const u16*)(ws + OFF_WE) + (size_t)g * 256 * 512;
    float* E = (float*)(ws + OFF_EB) + (size_t)g * 1024 * 128;
    gemm_tile(A, 512, 8, nullptr, 0, 0, Bt, 512, smem, [&](f32x16(&acc)[2][2], int moff) {
      int l32_ = l32, hf_ = hf; asm volatile("" : "+v"(l32_), "+v"(hf_));
      const int m0_ = m0 + moff;
      if (wn < 2) {
#pragma unroll
        for (int i = 0; i < 2; ++i)
#pragma unroll
          for (int jn = 0; jn < 2; ++jn)
#pragma unroll
            for (int r = 0; r < 16; ++r)
              E[(size_t)(m0_ + wm * 64 + i * 32 + crow(r, hf_)) * 128 + wn * 64 + jn * 32 + l32_] = acc[i][jn][r];
      }
    });
  }
}

DI void scan_phase(const Params& p, int j) {
  const int tid = opqv(threadIdx.x) & 255;
  char* ws = opq(p.ws);
  for (int vb = blockIdx.x * 2 + (opqv(threadIdx.x) >> 8); vb < 128 + 16; vb += gridDim.x * 2) {
    if (vb < 128) {
      const int idx = vb * 256 + tid, bh = idx >> 12, e4 = (idx & 4095) * 4, h = bh & 3;
      const float cd = ex2(128.f * lg2gamma(h));
      const float* U = (const float*)(ws + OFF_UO) + (size_t)bh * 128 * 16384 + e4;
      u16* Sp = (u16*)(ws + OFF_SP) + (size_t)bh * 128 * 16384 + e4;
      float4 S = make_float4(0, 0, 0, 0);
      for (int n0 = 0; n0 < 128; n0 += 16) {
        f32x4 u[16];
#pragma unroll
        for (int k = 0; k < 16; ++k) u[k] = *(const f32x4*)(U + (size_t)(n0 + k) * 16384);
#pragma unroll
        for (int k = 0; k < 16; ++k) {
          *(uint2*)(Sp + (size_t)(n0 + k) * 16384) = make_uint2(pack2(S.x, S.y), pack2(S.z, S.w));
          S.x = cd * S.x + u[k].x; S.y = cd * S.y + u[k].y; S.z = cd * S.z + u[k].z; S.w = cd * S.w + u[k].w;
        }
      }
    } else {
      const int idx = (vb - 128) * 256 + tid, b = idx >> 11, g = (idx >> 6) & 31, n = idx & 63;
      const float4 z = ((const float4*)(ws + OFF_S5Z))[(j * 32 + g) * 64 + n];
      const float mg = expf(32.f * z.x), ang = 32.f * z.y; float sn_, cs_; sincos_(ang, sn_, cs_);
      const float a32r = mg * cs_, a32i = mg * sn_;
      const float* E = (const float*)(ws + OFF_EB) + ((size_t)g * 1024 + b * 512) * 128;
      u16* Xp = (u16*)(ws + OFF_XP) + ((size_t)g * 1024 + b * 512) * 128;
      float xr = 0.f, xi = 0.f;
      for (int c0 = 0; c0 < 512; c0 += 32) {
        float er[32], ei[32];
#pragma unroll
        for (int k = 0; k < 32; ++k) { er[k] = E[(c0 + k) * 128 + n]; ei[k] = E[(c0 + k) * 128 + 64 + n]; }
#pragma unroll
        for (int k = 0; k < 32; ++k) {
          Xp[(c0 + k) * 128 + n] = f2bf(xr); Xp[(c0 + k) * 128 + 64 + n] = f2bf(xi);
          const float nr = a32r * xr - a32i * xi + er[k], ni = a32r * xi + a32i * xr + ei[k];
          xr = nr; xi = ni;
        }
      }
    }
  }
}

DI void ret_out_item(const Params& p, int b, int n, int h, char* smem) {
  const int tid = opqv(threadIdx.x) & 255, lane = tid & 63, w = tid >> 6, l32 = lane & 31, hf = lane >> 5;
  char* ws = opq(p.ws);
  const u16* zr = (const u16*)(ws + OFF_ZR); u16* o = (u16*)(ws + OFF_UO);
  char* sK = smem; char* sVt = smem + 128 * 272;
  const size_t t0 = (size_t)b * S_ + n * 128;
  const float lg = lg2gamma(h);
#pragma unroll
  for (int i = 0; i < 8; ++i) {
    const int c = tid + 256 * i, row = c >> 4, ch = c & 15;
    const uint4 kv = *(const uint4*)(zr + (t0 + row) * LDZR + 512 + h * 128 + ch * 8);
    const uint4 vv = *(const uint4*)(zr + (t0 + row) * LDZR + 1024 + h * 128 + ch * 8);
    *(uint4*)(sK + row * 272 + ch * 16) = kv;
    char* vb = sVt + (ch * 8) * 272 + row * 2;
    *(u16*)(vb + 0 * 272) = (u16)(vv.x & 0xffffu); *(u16*)(vb + 1 * 272) = (u16)(vv.x >> 16);
    *(u16*)(vb + 2 * 272) = (u16)(vv.y & 0xffffu); *(u16*)(vb + 3 * 272) = (u16)(vv.y >> 16);
    *(u16*)(vb + 4 * 272) = (u16)(vv.z & 0xffffu); *(u16*)(vb + 5 * 272) = (u16)(vv.z >> 16);
    *(u16*)(vb + 6 * 272) = (u16)(vv.w & 0xffffu); *(u16*)(vb + 7 * 272) = (u16)(vv.w >> 16);
  }
  __syncthreads();
  const size_t tq = t0 + w * 32 + l32;
  const int qi = w * 32 + l32;
  bf16x8 qf[8];
#pragma unroll
  for (int s = 0; s < 8; ++s) qf[s] = *(const bf16x8*)(zr + tq * LDZR + h * 128 + s * 16 + hf * 8);
  f32x16 ot[4];
  const u16* Sp = (const u16*)(ws + OFF_SP) + ((size_t)((b * 4 + h) * 128 + n)) * 16384;
#pragma unroll
  for (int mt = 0; mt < 4; ++mt) {
    ot[mt] = zero16();
#pragma unroll
    for (int s = 0; s < 8; ++s) {
      const bf16x8 sf = *(const bf16x8*)(Sp + (mt * 32 + l32) * 128 + s * 16 + hf * 8);
      ot[mt] = MFMA(sf, qf[s], ot[mt]);
    }
  }
  const float fs = ex2((float)(qi + 1) * lg);
#pragma unroll
  for (int mt = 0; mt < 4; ++mt)
#pragma unroll
    for (int r = 0; r < 16; ++r) ot[mt][r] *= fs;
#pragma unroll
  for (int tt = 0; tt < 4; ++tt) {
    if (tt <= w) {
      f32x16 st = zero16();
#pragma unroll
      for (int s = 0; s < 8; ++s) {
        const bf16x8 kf = *(const bf16x8*)(sK + (tt * 32 + l32) * 272 + (s * 16 + hf * 8) * 2);
        st = MFMA(kf, qf[s], st);
      }
#pragma unroll
      for (int r = 0; r < 16; ++r) {
        const int dd = qi - (tt * 32 + crow(r, hf));
        st[r] = (dd >= 0) ? st[r] * ex2((float)dd * lg) : 0.f;
      }
#pragma unroll
      for (int s2 = 0; s2 < 2; ++s2) {
        const bf16x8 pf = pack8(st, s2);
#pragma unroll
        for (int mt = 0; mt < 4; ++mt) {
          const char* vp = sVt + (mt * 32 + l32) * 272 + (tt * 32 + s2 * 16 + hf * 4) * 2;
          const bf16x8 vf = join8(*(const uint2*)vp, *(const uint2*)(vp + 16));
          ot[mt] = MFMA(vf, pf, ot[mt]);
        }
      }
    }
  }
  float sum = 0.f;
#pragma unroll
  for (int mt = 0; mt < 4; ++mt)
#pragma unroll
    for (int r = 0; r < 16; ++r) sum += ot[mt][r];
  sum += __shfl_xor(sum, 32);
  const float mean = sum * (1.f / 128.f);
  float vs = 0.f;
#pragma unroll
  for (int mt = 0; mt < 4; ++mt)
#pragma unroll
    for (int r = 0; r < 16; ++r) { const float d = ot[mt][r] - mean; vs += d * d; }
  vs += __shfl_xor(vs, 32);
  const float rstd = rsqrtf(vs * (1.f / 128.f) + 1e-5f);
#pragma unroll
  for (int mt = 0; mt < 4; ++mt)
#pragma unroll
    for (int qd = 0; qd < 4; ++qd) {
      const int e0 = mt * 32 + 8 * qd + 4 * hf;
      const uint2 gv = *(const uint2*)(zr + tq * LDZR + 1536 + h * 128 + e0);
      const float g0 = bf2f(gv.x & 0xffffu), g1 = bf2f(gv.x >> 16), g2 = bf2f(gv.y & 0xffffu), g3 = bf2f(gv.y >> 16);
      const float o0 = g0 / (1.f + __expf(-g0)) * (ot[mt][4 * qd + 0] - mean) * rstd;
      const float o1 = g1 / (1.f + __expf(-g1)) * (ot[mt][4 * qd + 1] - mean) * rstd;
      const float o2 = g2 / (1.f + __expf(-g2)) * (ot[mt][4 * qd + 2] - mean) * rstd;
      const float o3 = g3 / (1.f + __expf(-g3)) * (ot[mt][4 * qd + 3] - mean) * rstd;
      *(uint2*)(o + tq * LDH + h * 128 + e0) = make_uint2(pack2(o0, o1), pack2(o2, o3));
    }
  __syncthreads();
}

DI float gelu_tanh(float y) {
  const float u = 0.7978845608028654f * (y + 0.044715f * y * y * y);
  const float e = __expf(2.f * u);
  const float th = 1.f - 2.f / (e + 1.f);
  return 0.5f * y * (1.f + th);
}

DI void rec_out_phase(const Params& p, int j, char* smem) {
  const int tid = opqv(threadIdx.x), lane = tid & 63, w = tid >> 6, wm = w >> 2, wn = w & 3, l32 = lane & 31, hf = lane >> 5;
  char* ws = opq(p.ws);
  {
    const int half = opqv(threadIdx.x) >> 8;
    char* sm = smem + half * HALF_SMEM;
    for (int it = blockIdx.x; it < 512; it += gridDim.x) { const int item = it * 2 + half; ret_out_item(p, item >> 9, (item >> 2) & 127, item & 3, sm); }
  }
  for (int it = blockIdx.x; it < 256; it += gridDim.x) {
    {
      const int k = it, g = k >> 3, mt = (k >> 1) & 3, nt = k & 1, m0 = mt * 256, n0 = nt * 256;
      const u16* Ug = (const u16*)(ws + OFF_UG) + (size_t)g * T_ * 16;
      const u16* A1 = Ug + (size_t)m0 * 512;
      const u16* A2 = (const u16*)(ws + OFF_XP) + ((size_t)g * 1024 + m0) * 128;
      const u16* Bt = (const u16*)(ws + OFF_WY) + ((size_t)g * 512 + n0) * 640;
      u16* yt = (u16*)(ws + OFF_YT);
      gemm_tile(A1, 512, 8, A2, 128, 2, Bt, 640, smem, [&](f32x16(&acc)[2][2], int moff) {
      const int m0_ = m0 + moff;
      int l32_ = l32, hf_ = hf; asm volatile("" : "+v"(l32_), "+v"(hf_));
#pragma unroll
        for (int i = 0; i < 2; ++i)
#pragma unroll
          for (int jn = 0; jn < 2; ++jn)
#pragma unroll
            for (int r = 0; r < 16; ++r) {
              const int R = m0_ + wm * 64 + i * 32 + crow(r, hf_), col = n0 + wn * 64 + jn * 32 + l32_;
              const int ii = col >> 4, pp = col & 15;
              const size_t t = (size_t)R * 32 + ii;
              const float y = acc[i][jn][r];
              yt[t * LDYT + g * 16 + pp] = f2bf(gelu_tanh(y));
            }
      });
    }
  }
}

DI void glu_phase(const Params& p, int j, char* smem) {
  const int tid = opqv(threadIdx.x), lane = tid & 63, w = tid >> 6, wm = w >> 2, wn = w & 3, l32 = lane & 31, hf = lane >> 5;
  char* ws = opq(p.ws);
  const u16* yt = (const u16*)(ws + OFF_YT);
  const u16* Wt = (const u16*)(ws + OFF_W_GLU) + (size_t)j * 512 * LDGLU;
  u16* o = (u16*)(ws + OFF_UO);
  const float* gb = p.s5_glu_b + j * 512;
  const int nN = 2;
  for (int lt = blockIdx.x >> 3; lt < 16 * nN; lt += gridDim.x >> 3) {
    int mt, nt; tile_map(lt, 16, nN, 16, 2, mt, nt);
    const int m0 = mt * 256, n0 = nt * 256;
    gemm_tile(yt + (size_t)m0 * LDYT, LDYT, 8, nullptr, 0, 0, Wt + (size_t)n0 * LDGLU, LDGLU, smem, [&](f32x16(&acc)[2][2], int moff) {
      const int m0_ = m0 + moff;
      int l32_ = l32, hf_ = hf; asm volatile("" : "+v"(l32_), "+v"(hf_));
#pragma unroll
      for (int i = 0; i < 2; ++i)
#pragma unroll
        for (int jn = 0; jn < 2; ++jn)
#pragma unroll
          for (int r = 0; r < 16; ++r) {
            const int row = m0_ + wm * 64 + i * 32 + crow(r, hf_), col = n0 + wn * 64 + jn * 32 + l32_;
            const float gt = acc[i][jn][r] + gb[col];
            const float y = bf2f(yt[(size_t)row * LDYT + col]);
            o[(size_t)row * LDH + 512 + col] = f2bf(y / (1.f + __expf(-gt)));
          }
    });
  }
}

DI void run_phase(const Params& p, int ph, char* smem, int rep) {
  char* ws = opq(p.ws);
  if (ph == 0) { phase0(p, smem); return; }
  if (ph == 1) { phase1(p); return; }
  const int q = ph - 2, pair = q / 18, r = q % 18;
  const bool odd = r >= 8;
  const int k = odd ? r - 8 : r;
  const int l = pair * 2 + (odd ? 1 : 0), j = pair;
  int op = 2, pm = 0, ls = 0;
  if (!odd) {
    if (k == 3) { op = 0; pm = 0; } else if (k == 5) { op = 0; pm = 1; } else if (k == 6) { op = 0; pm = 2; }
    else if (k == 4) { op = 1; ls = 2 * l; } else if (k == 7) { op = 1; ls = 2 * l + 1; }
  } else {
    if (k == 5) { op = 0; pm = 0; } else if (k == 7) { op = 0; pm = 1; } else if (k == 8) { op = 0; pm = 2; }
    else if (k == 6) { op = 1; ls = 2 * l; } else if (k == 9) { op = 1; ls = 2 * l + 1; }
  }
  if (op == 0) {
    const u16* A; const u16* W; u16* C; int K, N, mode, lda, ldb, ldc;
    if (pm == 0) {
      A = (const u16*)(ws + (odd ? OFF_UO : OFF_OE)); lda = LDH;
      W = (const u16*)(ws + (odd ? OFF_W_RECOUT : OFF_W_ATTOUT)) + (size_t)j * 1024 * LDW1; ldb = LDW1;
      C = (u16*)(ws + OFF_HY); ldc = LDH; K = 1024; N = 1024; mode = 0;
    } else if (pm == 1) {
      A = (const u16*)(ws + OFF_HY); lda = LDH; W = (const u16*)(ws + OFF_W1) + (size_t)l * 4096 * LDW1; ldb = LDW1;
      C = (u16*)(ws + OFF_HID); ldc = LDHID; K = 1024; N = 4096; mode = 1;
    } else {
      A = (const u16*)(ws + OFF_HID); lda = LDHID; W = (const u16*)(ws + OFF_W2) + (size_t)l * 1024 * LDW2; ldb = LDW2;
      C = (u16*)(ws + OFF_HY); ldc = LDH; K = 4096; N = 1024; mode = 0;
    }
#ifdef PROBE_VARIANT
    if (rep) gemm_plain<PROBE_VARIANT>(A, lda, K, W, ldb, N, C, ldc, mode, smem); else
#endif
    gemm_plain<0>(A, lda, K, W, ldb, N, C, ldc, mode, smem);
  } else if (op == 1) {
    ln_phase(p, ls);
  } else if (!odd) {
    if (k == 0) att_in_phase(p, j, smem);
    else if (k == 1) qkv_phase(p, j, smem);
    else attn_phase(p, j, j + 4 * rep, smem);
  } else {
    if (k == 0) { rec_in_phase(p, j, smem); s5_fill(p, j); }
    else if (k == 1) rec_state_phase(p, j, smem);
    else if (k == 2) scan_phase(p, j);
    else if (k == 3) rec_out_phase(p, j, smem);
    else glu_phase(p, j, smem);
  }
}

__global__ void __launch_bounds__(512, 2) mega_kernel(Params p, int ph0, int ph1) {
  extern __shared__ __attribute__((aligned(16))) char smem[];
  cg::grid_group grid = cg::this_grid();
  __shared__ uint4 xb_words;
  if (threadIdx.x == 0) xb_words = make_uint4(0u, 0u, 0u, 0u);
  __syncthreads();
  XcdBarrier xb = xcd_barrier_post((unsigned*)(p.ws + OFF_BAR), (volatile LAS unsigned*)&xb_words);
  for (int ph = ph0; ph < ph1; ++ph) {
    run_phase(p, ph, smem, 0);
#ifdef PROBE_MASK
    if (ph >= 2 && ((PROBE_MASK >> ((ph - 2) % 18)) & 1)) { xcd_barrier(xb); run_phase(p, ph, smem, 1); }
#endif
    if (ph + 1 < ph1) { if (ph == ph0) grid.sync(); else xcd_barrier(xb); }
  }
}

__global__ void fail_fill(float* out, int n) {
  int i = blockIdx.x * 256 + threadIdx.x;
  if (i < n) out[i] = 0.f;
}

extern "C" void kernel_launch(void* const* d_in, const int* in_sizes, int n_in, void* d_out, int out_size, void* d_ws,
                              size_t ws_size, hipStream_t stream) {
  Params p{};
  const float** fp = (const float**)&p;
  for (int i = 0; i < 27; ++i) fp[i] = (const float*)d_in[i];
  p.out = (float*)d_out;
  p.ws = (char*)d_ws;
  if (ws_size < WS_NEED) {
    fail_fill<<<(out_size + 255) / 256, 256, 0, stream>>>((float*)d_out, out_size);
    return;
  }
  static int grid_blocks = 0;
  if (!grid_blocks) {
    hipFuncSetAttribute((const void*)mega_kernel, hipFuncAttributeMaxDynamicSharedMemorySize, SMEM_BYTES);
    int dev = 0, cus = 0, per_cu = 0;
    hipGetDevice(&dev);
    hipDeviceGetAttribute(&cus, hipDeviceAttributeMultiprocessorCount, dev);
    hipOccupancyMaxActiveBlocksPerMultiprocessor(&per_cu, mega_kernel, NTHR, SMEM_BYTES);
    if (per_cu > 1) per_cu = 1;
    if (per_cu < 1) per_cu = 1;
    grid_blocks = cus * per_cu;
  }
  (void)hipMemsetAsync((char*)d_ws + OFF_BAR, 0, XCD_BAR_WORDS * 4, stream);
  int ph0 = 0, ph1 = NPHASE;
  void* args[] = {&p, &ph0, &ph1};
  hipError_t e = hipLaunchCooperativeKernel((void*)mega_kernel, dim3(grid_blocks), dim3(NTHR), args, SMEM_BYTES, stream);
  if (e != hipSuccess) fprintf(stderr, "cooperative launch failed: %s (grid %d)\n", hipGetErrorString(e), grid_blocks);
}
static_assert(WS_NEED <= (size_t)536870912, "workspace budget exceeded");
```

```cpp
#include <hip/hip_runtime.h>
#include <hip/hip_cooperative_groups.h>
#include <cstdio>
namespace cg = cooperative_groups;

typedef unsigned short u16;
using bf16x8 = __attribute__((ext_vector_type(8))) short;
using f32x16 = __attribute__((ext_vector_type(16))) float;
using u32x4 = __attribute__((ext_vector_type(4))) unsigned;
typedef __attribute__((address_space(3))) unsigned lds_u32;
using f32x4 = __attribute__((ext_vector_type(4))) float;
#define DI __device__ __forceinline__
#define MFMA(a, b, c) __builtin_amdgcn_mfma_f32_32x32x16_bf16((a), (b), (c), 0, 0, 0)

constexpr int T_ = 32768, S_ = 16384;
constexpr float LOG2E = 1.4426950408889634f;
constexpr float DN_ALPHA = 1.6817928305074290f;
constexpr float MLA_QSCALE = 0.10206207261596575f * LOG2E;
constexpr float SWA_QSCALE = 0.125f * LOG2E;
constexpr float RET_KSCALE = 0.08838834764831845f;
constexpr int LDH = 1088, LDHID = 4160, LDW1 = 1088, LDW2 = 4160, LDV = S_ + 64, LDKB = 832, LDZR = 2112, LDYT = 576, LDGLU = 576;

constexpr size_t OFF_MOD = 0;
constexpr size_t OFF_CTR = OFF_MOD + 8 * 2 * 3072 * 4;
constexpr size_t OFF_BAR = OFF_CTR + 256;
constexpr size_t OFF_RT32 = OFF_BAR + 16384;
constexpr size_t OFF_RT64 = OFF_RT32 + (size_t)S_ * 16 * 8;
constexpr size_t OFF_RT128 = OFF_RT64 + (size_t)S_ * 32 * 8;
constexpr size_t OFF_S5Z = OFF_RT128 + (size_t)S_ * 64 * 8;
constexpr size_t OFF_BBAR = OFF_S5Z + 2 * 32 * 64 * 16;
constexpr size_t OFF_KTAB = OFF_BBAR + 2 * 32 * 64 * 16 * 8;
constexpr size_t OFF_W_ATTIN = OFF_KTAB + 2 * 32 * 32 * 256 * 4;
constexpr size_t OFF_W_UQ = OFF_W_ATTIN + (size_t)2 * 1536 * LDW1 * 2;
constexpr size_t OFF_W_UKV = OFF_W_UQ + (size_t)2 * 768 * 384 * 2;
constexpr size_t OFF_W_ATTOUT = OFF_W_UKV + (size_t)2 * 1024 * 256 * 2;
constexpr size_t OFF_W_RECIN = OFF_W_ATTOUT + (size_t)2 * 1024 * LDW1 * 2;
constexpr size_t OFF_W_GLU = OFF_W_RECIN + (size_t)2 * 2560 * LDW1 * 2;
constexpr size_t OFF_W_RECOUT = OFF_W_GLU + (size_t)2 * 512 * LDGLU * 2;
constexpr size_t OFF_W1 = OFF_W_RECOUT + (size_t)2 * 1024 * LDW1 * 2;
constexpr size_t OFF_W2 = OFF_W1 + (size_t)4 * 4096 * LDW1 * 2;
constexpr size_t OFF_WE = OFF_W2 + (size_t)4 * 1024 * LDW2 * 2;
constexpr size_t OFF_WY = OFF_WE + (size_t)32 * 256 * 512 * 2;
constexpr size_t OFF_HY = OFF_WY + (size_t)32 * 512 * 640 * 2;
constexpr size_t OFF_RA = OFF_HY + (size_t)T_ * LDH * 2;
constexpr size_t OFF_ZC = OFF_RA;
constexpr size_t OFF_QB = OFF_ZC + (size_t)T_ * 640 * 2;
constexpr size_t OFF_KB = OFF_QB + (size_t)T_ * 768 * 2;
constexpr size_t OFF_VT = OFF_KB + (size_t)T_ * LDKB * 2;
constexpr size_t OFF_SQ = OFF_VT + (size_t)2 * 8 * 64 * LDV * 2;
constexpr size_t OFF_SK = OFF_SQ + (size_t)T_ * 512 * 2;
constexpr size_t OFF_SV = OFF_SK + (size_t)T_ * 128 * 2;
constexpr size_t OFF_OE = OFF_SV + (size_t)T_ * 128 * 2;
constexpr size_t END_EVEN = OFF_OE + (size_t)T_ * LDH * 2;
constexpr size_t OFF_ZR = OFF_RA;
constexpr size_t OFF_UG = OFF_ZR + (size_t)T_ * LDZR * 2;
constexpr size_t OFF_UO = OFF_UG + (size_t)T_ * 512 * 2;
constexpr size_t OFF_SP = OFF_UO + (size_t)T_ * LDH * 2;
constexpr size_t OFF_EB = OFF_SP + (size_t)T_ * 512 * 2;
constexpr size_t OFF_XP = OFF_EB + (size_t)32 * 1024 * 128 * 4;
constexpr size_t OFF_YT = OFF_HY;
constexpr size_t END_ODD = OFF_XP + (size_t)32 * 1024 * 128 * 2;
constexpr size_t OFF_HID = OFF_RA;
constexpr size_t END_MLP = OFF_HID + (size_t)T_ * LDHID * 2;
constexpr size_t WS_NEED = END_ODD > END_EVEN ? (END_ODD > END_MLP ? END_ODD : END_MLP) : (END_EVEN > END_MLP ? END_EVEN : END_MLP);

constexpr int NTHR = 512;
constexpr int HALF_SMEM = 73728 + 1024;
constexpr int SMEM_GEMM = 131072;
constexpr int SMEM_BYTES = 2 * HALF_SMEM;
constexpr int NPHASE = 38;

struct Params {
  const float *x, *c, *ada_w, *ada_b, *ln_g, *ln_b, *att_w_in, *mla_q_norm, *mla_w_uq, *mla_kv_norm, *mla_w_ukv,
      *swa_sinks, *att_w_out, *rec_w_in, *s5_a_re, *s5_a_im, *s5_log_step, *s5_b_re, *s5_b_im, *s5_c_re, *s5_c_im,
      *s5_d, *s5_glu_w, *s5_glu_b, *rec_w_out, *mlp_w1, *mlp_w2;
  float* out;
  char* ws;
};

#define XB_TMO      128
#define XB_XCNT(j)  (256  + 64 * (j))
#define XB_XSUB(j)  (1280 + 64 * (j))
#define XB_XGEN(j)  (2304 + 64 * (j))
#define XB_TOP      3328
#define XB_TOPGEN   3392
#define XCD_BAR_WORDS 3456
#define XB_SPIN_CAP (1u << 18)
#define LAS __attribute__((address_space(3)))

__device__ __forceinline__ unsigned xb_ld(unsigned* p)              { return __hip_atomic_load(p, __ATOMIC_RELAXED, __HIP_MEMORY_SCOPE_AGENT); }
__device__ __forceinline__ unsigned xb_add(unsigned* p, unsigned v) { return __hip_atomic_fetch_add(p, v, __ATOMIC_RELAXED, __HIP_MEMORY_SCOPE_AGENT); }
__device__ __forceinline__ unsigned xb_xcc_id() { return (unsigned)__builtin_amdgcn_s_getreg((3 << 11) | 20) & 0xFu; }
#define XB_SPIN(cond, bar) do { unsigned _sp = 0; while (cond) { __builtin_amdgcn_s_sleep(1); \
    if ((++_sp & 255u) == 0u) { if (xb_ld(&(bar)[XB_TMO])) break; if (_sp > XB_SPIN_CAP) { atomicAdd(&(bar)[XB_TMO], 1u); break; } } } } while (0)

struct XcdBarrier {
    unsigned* bar; unsigned x;
    volatile LAS unsigned* st;
};

__device__ __forceinline__ XcdBarrier xcd_barrier_post(unsigned* bar, volatile LAS unsigned* st) {
    XcdBarrier b; b.bar = bar; b.x = xb_xcc_id(); b.st = st;
    if (threadIdx.x == 0) (void)xb_add(&bar[XB_XCNT(b.x)], 1u);
    return b;
}
__device__ __forceinline__ void xcd_barrier_complete(unsigned* bar, unsigned x, unsigned& nloc, unsigned& nx) {
    const unsigned G = gridDim.x * gridDim.y * gridDim.z;
    unsigned sum, cnt, mine, sp = 0u;
    for (;;) {
        sum = 0u; cnt = 0u; mine = 0u;
#pragma unroll
        for (unsigned j = 0; j < 16; ++j) { const unsigned c = xb_ld(&bar[XB_XCNT(j)]); sum += c; cnt += (c > 0u) ? 1u : 0u; mine = (j == x) ? c : mine; }
        if (sum == G) break;
        __builtin_amdgcn_s_sleep(1);
        if ((++sp & 255u) == 0u) { if (xb_ld(&bar[XB_TMO])) break; if (sp > XB_SPIN_CAP) { atomicAdd(&bar[XB_TMO], 1u); break; } }
    }
    nloc = mine > 0u ? mine : 1u; nx = cnt > 0u ? cnt : 1u;
}

__device__ __forceinline__ void xcd_barrier(const XcdBarrier& b) {
    asm volatile("s_waitcnt vmcnt(0)" ::: "memory");
    __syncthreads();
    if (threadIdx.x == 0) {
        unsigned* bar = b.bar;
        __builtin_amdgcn_s_waitcnt(0);
        unsigned nloc = b.st[0], nx = b.st[1];
        if (nloc == 0u) { xcd_barrier_complete(bar, b.x, nloc, nx); b.st[0] = nloc; b.st[1] = nx; }
        const unsigned old = xb_add(&bar[XB_XSUB(b.x)], 1u);
        const unsigned gen = old / nloc;
        if (old + 1u == (gen + 1u) * nloc) {
            __builtin_amdgcn_fence(__ATOMIC_RELEASE, "agent");
            asm volatile("s_waitcnt vmcnt(0)" ::: "memory");
            const unsigned og = xb_add(&bar[XB_TOP], 1u);
            const unsigned tg = og / nx;
            if (og + 1u == (tg + 1u) * nx) xb_add(&bar[XB_TOPGEN], 1u);
            else XB_SPIN(xb_ld(&bar[XB_TOPGEN]) == tg, bar);
            __builtin_amdgcn_fence(__ATOMIC_ACQUIRE, "agent");
            xb_add(&bar[XB_XGEN(b.x)], 1u);
            asm volatile("s_waitcnt vmcnt(0)" ::: "memory");
        } else {
            XB_SPIN(xb_ld(&bar[XB_XGEN(b.x)]) == gen, bar);
            __builtin_amdgcn_fence(__ATOMIC_ACQUIRE, "agent");
            asm volatile("s_waitcnt vmcnt(0)" ::: "memory");
        }
    }
    __syncthreads();
}


typedef __bf16 bf2_t __attribute__((ext_vector_type(2)));
typedef float f2_t __attribute__((ext_vector_type(2)));
DI u16 f2bf(float x) { __bf16 r = (__bf16)x; return __builtin_bit_cast(u16, r); }
DI float bf2f(unsigned h) { return __uint_as_float(h << 16); }
DI unsigned pack2(float a, float b) { f2_t v = {a, b}; bf2_t r = __builtin_convertvector(v, bf2_t); return __builtin_bit_cast(unsigned, r); }
DI int crow(int r, int hf) { return (r & 3) + 8 * (r >> 2) + 4 * hf; }
DI float ex2(float x) { return __builtin_amdgcn_exp2f(x); }
DI bf16x8 pack8(const f32x16& x, int s) {
  uint4 u;
  u.x = pack2(x[8 * s + 0], x[8 * s + 1]); u.y = pack2(x[8 * s + 2], x[8 * s + 3]);
  u.z = pack2(x[8 * s + 4], x[8 * s + 5]); u.w = pack2(x[8 * s + 6], x[8 * s + 7]);
  return __builtin_bit_cast(bf16x8, u);
}
DI bf16x8 join8(uint2 lo, uint2 hi) { uint4 u = make_uint4(lo.x, lo.y, hi.x, hi.y); return __builtin_bit_cast(bf16x8, u); }
DI f32x16 zero16() { f32x16 z; for (int i = 0; i < 16; ++i) z[i] = 0.f; return z; }
DI int opqv(int x) { asm volatile("" : "+v"(x)); return x; }
DI char* opq(char* p) { asm volatile("" : "+s"(p)); return p; }
DI void sincos_(float x, float& sn, float& cs) { float s_, c_; sincosf(x, &s_, &c_); sn = s_; cs = c_; }
DI float lg2gamma(int h) { return log2f(1.0f - exp2f(-5.0f - (float)h)); }

template <int V = 0, class Epi>
DI void gemm_tile(const u16* A1, long lda1, int nk1, const u16* A2, long lda2, int nk2, const u16* Bt, long ldb,
                  char* smem, Epi&& epi) {
  const int tid = opqv(threadIdx.x), lane = tid & 63, w = tid >> 6, wm = w >> 2, wn = w & 3, l32 = lane & 31, hf = lane >> 5;
  f32x16 acc[2][2][2];
#pragma unroll
  for (int h = 0; h < 2; ++h)
#pragma unroll
    for (int i = 0; i < 2; ++i)
#pragma unroll
      for (int j = 0; j < 2; ++j) acc[h][i][j] = zero16();
  const int nk = nk1 + nk2;
  const int drow = lane >> 3, dslot = lane & 7, x7 = (l32 >> 1) & 7;
#define GLDS(KT, BUF) { const int kt_ = (KT); const u16* Ab; long lda; \
    if (kt_ < nk1) { Ab = A1 + kt_ * 64; lda = lda1; } else { Ab = A2 + (kt_ - nk1) * 64; lda = lda2; } \
    _Pragma("unroll") for (int q = 0; q < 4; ++q) { \
      const int r = (w * 4 + q) * 8 + drow; const int c = dslot ^ ((r >> 1) & 7); \
      __builtin_amdgcn_global_load_lds((const unsigned*)(Ab + (long)r * lda + c * 8), (lds_u32*)(smem + (BUF) * 65536 + (w * 4 + q) * 1024), 16, 0, 0); \
      __builtin_amdgcn_global_load_lds((const unsigned*)(Bt + (long)r * ldb + kt_ * 64 + c * 8), (lds_u32*)(smem + (BUF) * 65536 + 32768 + (w * 4 + q) * 1024), 16, 0, 0); } }
#define LFR(AF, BF, BUF, S0) { const char* a = smem + (BUF) * 65536; const char* b = a + 32768; \
    _Pragma("unroll") for (int i = 0; i < 4; ++i) AF[i] = *(const bf16x8*)(a + (wm * 128 + i * 32 + l32) * 128 + (((2 * (S0) + hf) ^ x7) << 4)); \
    _Pragma("unroll") for (int j = 0; j < 2; ++j) BF[j] = *(const bf16x8*)(b + (wn * 64 + j * 32 + l32) * 128 + (((2 * (S0) + hf) ^ x7) << 4)); }
#define MMA8(AF, BF) { \
    _Pragma("unroll") for (int i = 0; i < 4; ++i) \
      _Pragma("unroll") for (int j = 0; j < 2; ++j) acc[i >> 1][i & 1][j] = MFMA(AF[i], BF[j], acc[i >> 1][i & 1][j]); }
#define COMPUTE(BUF) { bf16x8 af0[4], bf0[2], af1[4], bf1[2]; \
    LFR(af0, bf0, BUF, 0); __builtin_amdgcn_sched_barrier(0); \
    LFR(af1, bf1, BUF, 1); MMA8(af0, bf0); __builtin_amdgcn_sched_barrier(0); \
    LFR(af0, bf0, BUF, 2); MMA8(af1, bf1); __builtin_amdgcn_sched_barrier(0); \
    LFR(af1, bf1, BUF, 3); MMA8(af0, bf0); __builtin_amdgcn_sched_barrier(0); \
    MMA8(af1, bf1); __builtin_amdgcn_sched_barrier(0); }
#define RAWBAR() { asm volatile("s_waitcnt vmcnt(0) lgkmcnt(0)" ::: "memory"); __builtin_amdgcn_s_barrier(); }
  if (V != 1) GLDS(0, 0);
  RAWBAR();
  for (int kt = 0; kt < nk; kt += 2) {
    if (V != 1) GLDS(kt + 1, 1);
    if (V != 2) COMPUTE(0);
    RAWBAR();
    if (V != 1) if (kt + 2 < nk) GLDS(kt + 2, 0);
    if (V != 2) COMPUTE(1);
    RAWBAR();
  }
#undef GLDS
#undef LFR
#undef MMA8
#undef COMPUTE
#undef RAWBAR
  epi(acc[0], wm * 64);
  epi(acc[1], wm * 64 + 64);
}

DI void tile_map(int lt, int nM8, int nN, int GM, int GN, int& mt, int& nt) {
  const int G = GM * GN, xcd = blockIdx.x & 7, group = lt / G, within = lt - group * G, ngn = nN / GN;
  const int mg = group / ngn, ng = group - mg * ngn;
  mt = xcd * nM8 + mg * GM + within / GN;
  nt = ng * GN + within % GN;
}

DI int colmap(int mode, int n) {
  if (mode == 1) { if (n < 640) return n; if (n < 1408) return n + 32; if (n < 1440) return n - 1408 + 640; return -1; }
  if (mode == 2) { if (n < 512) return (n >> 6) * 96 + (n & 63); int m = n - 512; return (m >> 5) * 96 + 64 + (m & 31); }
  if (mode == 3) { if (n < 1024) { int dl = n & 127, b4 = dl >> 5; int sb = (b4 == 1) ? 2 : (b4 == 2 ? 1 : b4); return (n & ~127) + sb * 32 + (dl & 31); } return n; }
  return n;
}
DI void conv_job(const float* src, int K, int N, u16* dst, int ldk, int Npad, const float* kscale, int mode, float* lds) {
  const int tid = opqv(threadIdx.x);
  const int nKt = K / 64, nNt = Npad / 64;
  for (int tile = blockIdx.x; tile < nKt * nNt; tile += gridDim.x) {
    const int nt = tile / nKt, kt = tile % nKt;
    const int nl = tid & 63, kq = tid >> 6;
    const int col = colmap(mode, nt * 64 + nl);
    for (int i = 0; i < 8; ++i) {
      const int kl = kq + 8 * i, k = kt * 64 + kl;
      float v = 0.f;
      if (col >= 0) { v = src[(size_t)k * N + col]; if (kscale) v *= kscale[k]; }
      lds[kl * 65 + nl] = v;
    }
    __syncthreads();
    for (int i = 0; i < 8; ++i) {
      const int n2 = kq + 8 * i;
      dst[(size_t)(nt * 64 + n2) * ldk + kt * 64 + nl] = f2bf(lds[nl * 65 + n2]);
    }
    __syncthreads();
  }
}

DI void phase0(const Params& p, char* smem) {
  const int tid = opqv(threadIdx.x), nb = gridDim.x, bid = blockIdx.x;
  char* ws = opq(p.ws);
  if (bid == 0 && tid < 64) ((int*)(ws + OFF_CTR))[tid] = 0;
  {
    float* cond = (float*)smem; float* red = cond + 2048; float* mod = (float*)(ws + OFF_MOD);
    for (int i = tid; i < 2048; i += NTHR) { float v = p.c[i]; cond[i] = v / (1.f + expf(-v)); }
    __syncthreads();
    for (int it = bid; it < 8 * 48; it += nb) {
      const int ls = it / 48, cgp = it % 48, tx = tid & 15, ty = tid >> 4;
      const float* wp = p.ada_w + (size_t)ls * 1024 * 3072 + cgp * 64 + tx * 4;
      float4 a0 = make_float4(0, 0, 0, 0), a1 = make_float4(0, 0, 0, 0);
      for (int k = ty * 32; k < ty * 32 + 32; ++k) {
        const float4 wv = *(const float4*)(wp + (size_t)k * 3072);
        const float c0 = cond[k], c1 = cond[1024 + k];
        a0.x += c0 * wv.x; a0.y += c0 * wv.y; a0.z += c0 * wv.z; a0.w += c0 * wv.w;
        a1.x += c1 * wv.x; a1.y += c1 * wv.y; a1.z += c1 * wv.z; a1.w += c1 * wv.w;
      }
      *(float4*)(red + (ty * 2 + 0) * 64 + tx * 4) = a0;
      *(float4*)(red + (ty * 2 + 1) * 64 + tx * 4) = a1;
      __syncthreads();
      if (tid < 128) {
        const int b = tid >> 6, col = tid & 63; float s = 0.f;
        for (int y = 0; y < 32; ++y) s += red[(y * 2 + b) * 64 + col];
        const int j = cgp * 64 + col;
        mod[(ls * 2 + b) * 3072 + j] = s + p.ada_b[ls * 3072 + j];
      }
      __syncthreads();
    }
  }
  {
    float* lds = (float*)smem;
    for (int j = 0; j < 2; ++j) {
      conv_job(p.att_w_in + (size_t)j * 1024 * 1440, 1024, 1440, (u16*)(ws + OFF_W_ATTIN) + (size_t)j * 1536 * LDW1, LDW1, 1536, nullptr, 1, lds);
      conv_job(p.mla_w_uq + (size_t)j * 384 * 768, 384, 768, (u16*)(ws + OFF_W_UQ) + (size_t)j * 768 * 384, 384, 768, p.mla_q_norm + j * 384, 2, lds);
      conv_job(p.mla_w_ukv + (size_t)j * 256 * 1024, 256, 1024, (u16*)(ws + OFF_W_UKV) + (size_t)j * 1024 * 256, 256, 1024, p.mla_kv_norm + j * 256, 0, lds);
      conv_job(p.att_w_out + (size_t)j * 1024 * 1024, 1024, 1024, (u16*)(ws + OFF_W_ATTOUT) + (size_t)j * 1024 * LDW1, LDW1, 1024, nullptr, 0, lds);
      conv_job(p.rec_w_in + (size_t)j * 1024 * 2560, 1024, 2560, (u16*)(ws + OFF_W_RECIN) + (size_t)j * 2560 * LDW1, LDW1, 2560, nullptr, 3, lds);
      conv_job(p.s5_glu_w + (size_t)j * 512 * 512, 512, 512, (u16*)(ws + OFF_W_GLU) + (size_t)j * 512 * LDGLU, LDGLU, 512, nullptr, 0, lds);
      conv_job(p.rec_w_out + (size_t)j * 1024 * 1024, 1024, 1024, (u16*)(ws + OFF_W_RECOUT) + (size_t)j * 1024 * LDW1, LDW1, 1024, nullptr, 0, lds);
    }
    for (int l = 0; l < 4; ++l) {
      conv_job(p.mlp_w1 + (size_t)l * 1024 * 4096, 1024, 4096, (u16*)(ws + OFF_W1) + (size_t)l * 4096 * LDW1, LDW1, 4096, nullptr, 0, lds);
      conv_job(p.mlp_w2 + (size_t)l * 4096 * 1024, 4096, 1024, (u16*)(ws + OFF_W2) + (size_t)l * 1024 * LDW2, LDW2, 1024, nullptr, 0, lds);
    }
  }
  {
    float2* rt32 = (float2*)(ws + OFF_RT32); float2* rt64 = (float2*)(ws + OFF_RT64); float2* rt128 = (float2*)(ws + OFF_RT128);
    for (int idx = bid * NTHR + tid; idx < S_ * 112; idx += nb * NTHR) {
      const int s = idx / 112, r = idx % 112;
      int dim, i; float2* dst;
      if (r < 16) { dim = 32; i = r; dst = rt32 + s * 16 + i; }
      else if (r < 48) { dim = 64; i = r - 16; dst = rt64 + s * 32 + i; }
      else { dim = 128; i = r - 48; dst = rt128 + s * 64 + i; }
      const float inv = powf(10000.0f, -((float)(2 * i)) / (float)dim);
      const float ang = (float)s * inv;
      float sn_, cs_; sincos_(ang, sn_, cs_);
      *dst = make_float2(cs_, sn_);
    }
  }
  {
    float4* s5z = (float4*)(ws + OFF_S5Z); float2* bbar = (float2*)(ws + OFF_BBAR);
    for (int idx = bid * NTHR + tid; idx < 2 * 32 * 64; idx += nb * NTHR) {
      const int jg = idx >> 6;
      const float dt = expf(p.s5_log_step[jg]);
      const float lr = p.s5_a_re[idx], li = p.s5_a_im[idx];
      const float zr = lr * dt, zi = li * dt, mag = expf(zr);
      float sn_, cs_; sincos_(zi, sn_, cs_);
      const float ar = mag * cs_, ai = mag * sn_;
      const float den = lr * lr + li * li;
      const float cr = ((ar - 1.f) * lr + ai * li) / den, ci = (ai * lr - (ar - 1.f) * li) / den;
      s5z[idx] = make_float4(zr, zi, ar, ai);
      for (int q = 0; q < 16; ++q) {
        const float br = p.s5_b_re[idx * 16 + q], bi = p.s5_b_im[idx * 16 + q];
        bbar[idx * 16 + q] = make_float2(cr * br - ci * bi, cr * bi + ci * br);
      }
    }
  }
}

DI void phase1(const Params& p) {
  const int tid = opqv(threadIdx.x), nb = gridDim.x, bid = blockIdx.x;
  char* ws = opq(p.ws);
  const float* mod = (const float*)(ws + OFF_MOD);
  u16* hy = (u16*)(ws + OFF_HY);
  for (int i = bid * NTHR + tid; i < T_ * 256; i += nb * NTHR) {
    const int t = i >> 8, c4 = (i & 255) * 4, b = t >> 14;
    const float4 xv = *(const float4*)(p.x + (size_t)i * 4);
    const float4 sh = *(const float4*)(mod + b * 3072 + c4);
    const float4 sc = *(const float4*)(mod + b * 3072 + 1024 + c4);
    uint2 o;
    o.x = pack2(xv.x * (1.f + sc.x) + sh.x, xv.y * (1.f + sc.y) + sh.y);
    o.y = pack2(xv.z * (1.f + sc.z) + sh.z, xv.w * (1.f + sc.w) + sh.w);
    *(uint2*)(hy + (size_t)t * LDH + c4) = o;
  }
  const float4* s5z = (const float4*)(ws + OFF_S5Z); const float2* bbar = (const float2*)(ws + OFF_BBAR);
  float* ktab = (float*)(ws + OFF_KTAB);
  for (int idx8 = bid * NTHR + tid; idx8 < 2 * 32 * 256 * 8; idx8 += nb * NTHR) {
    const int part = idx8 & 7, idx = idx8 >> 3;
    const int q = idx & 15, pp = (idx >> 4) & 15, jg = idx >> 8;
    float acc[32];
#pragma unroll
    for (int d = 0; d < 32; ++d) acc[d] = 0.f;
    for (int n = part * 8; n < part * 8 + 8; ++n) {
      const float4 z = s5z[jg * 64 + n];
      const float2 bb = bbar[(jg * 64 + n) * 16 + q];
      const float cr = p.s5_c_re[(jg * 16 + pp) * 64 + n], ci = p.s5_c_im[(jg * 16 + pp) * 64 + n];
      const float wr = cr * bb.x - ci * bb.y, wi = cr * bb.y + ci * bb.x;
      float er = 1.f, ei = 0.f;
#pragma unroll
      for (int d = 0; d < 32; ++d) {
        acc[d] += wr * er - wi * ei;
        const float nr = er * z.z - ei * z.w, ni = er * z.w + ei * z.z;
        er = nr; ei = ni;
      }
    }
#pragma unroll
    for (int d = 0; d < 32; ++d) {
      float a = acc[d];
      a += __shfl_xor(a, 1); a += __shfl_xor(a, 2); a += __shfl_xor(a, 4);
      if (part == 0) ktab[(jg * 32 + d) * 256 + pp * 16 + q] = a;
    }
  }
}

DI void ln_phase(const Params& p, int ls) {
  const int tid = opqv(threadIdx.x), lane = tid & 63, w = tid >> 6;
  char* ws = opq(p.ws);
  const float* mod = (const float*)(ws + OFF_MOD);
  u16* hy = (u16*)(ws + OFF_HY);
  const float* xin = (ls == 0) ? p.x : p.out;
  const float* lg = p.ln_g + ls * 1024; const float* lb = p.ln_b + ls * 1024;
  const int stride = gridDim.x * 8;
  f32x4 xc[4], xn[4]; uint2 yc[4], yn[4];
  {
    const int row = blockIdx.x * 8 + w;
#pragma unroll
    for (int i = 0; i < 4; ++i) {
      const int col = lane * 4 + 256 * i;
      xc[i] = *(const f32x4*)(xin + (size_t)row * 1024 + col);
      yc[i] = *(const uint2*)(hy + (size_t)row * LDH + col);
    }
  }
  for (int row = blockIdx.x * 8 + w; row < T_; row += stride) {
    const int b = row >> 14;
    const float* gate = mod + (ls * 2 + b) * 3072 + 2048;
    const int rn = row + stride;
    if (rn < T_) {
#pragma unroll
      for (int i = 0; i < 4; ++i) {
        const int col = lane * 4 + 256 * i;
        xn[i] = *(const f32x4*)(xin + (size_t)rn * 1024 + col);
        yn[i] = *(const uint2*)(hy + (size_t)rn * LDH + col);
      }
    }
    float v[16];
    float sum = 0.f;
#pragma unroll
    for (int i = 0; i < 4; ++i) {
      const int col = lane * 4 + 256 * i;
      const f32x4 xv = xc[i];
      const uint2 yv = yc[i];
      const float4 g = *(const float4*)(gate + col);
      v[4 * i + 0] = DN_ALPHA * xv.x + (1.f + g.x) * bf2f(yv.x & 0xffffu);
      v[4 * i + 1] = DN_ALPHA * xv.y + (1.f + g.y) * bf2f(yv.x >> 16);
      v[4 * i + 2] = DN_ALPHA * xv.z + (1.f + g.z) * bf2f(yv.y & 0xffffu);
      v[4 * i + 3] = DN_ALPHA * xv.w + (1.f + g.w) * bf2f(yv.y >> 16);
      sum += v[4 * i] + v[4 * i + 1] + v[4 * i + 2] + v[4 * i + 3];
    }
#pragma unroll
    for (int m = 32; m >= 1; m >>= 1) sum += __shfl_xor(sum, m);
    const float mean = sum * (1.f / 1024.f);
    float vs = 0.f;
#pragma unroll
    for (int i = 0; i < 16; ++i) { const float d = v[i] - mean; vs += d * d; }
#pragma unroll
    for (int m = 32; m >= 1; m >>= 1) vs += __shfl_xor(vs, m);
    const float rstd = rsqrtf(vs * (1.f / 1024.f) + 1e-5f);
#pragma unroll
    for (int i = 0; i < 4; ++i) {
      const int col = lane * 4 + 256 * i;
      const float4 g = *(const float4*)(lg + col); const float4 bb = *(const float4*)(lb + col);
      float4 o;
      o.x = (v[4 * i + 0] - mean) * rstd * g.x + bb.x; o.y = (v[4 * i + 1] - mean) * rstd * g.y + bb.y;
      o.z = (v[4 * i + 2] - mean) * rstd * g.z + bb.z; o.w = (v[4 * i + 3] - mean) * rstd * g.w + bb.w;
      *(float4*)(p.out + (size_t)row * 1024 + col) = o;
      if (ls < 7) {
        const float* m2 = mod + ((ls + 1) * 2 + b) * 3072;
        const float4 sh = *(const float4*)(m2 + col); const float4 sc = *(const float4*)(m2 + 1024 + col);
        uint2 h;
        h.x = pack2(o.x * (1.f + sc.x) + sh.x, o.y * (1.f + sc.y) + sh.y);
        h.y = pack2(o.z * (1.f + sc.z) + sh.z, o.w * (1.f + sc.w) + sh.w);
        *(uint2*)(hy + (size_t)row * LDH + col) = h;
      }
    }
#pragma unroll
    for (int i = 0; i < 4; ++i) { xc[i] = xn[i]; yc[i] = yn[i]; }
  }
}

template <int V = 0>
DI void gemm_plain(const u16* A, int lda, int K, const u16* Wt, int ldb, int N, u16* C, int ldc, int mode, char* smem) {
  const int tid = opqv(threadIdx.x), lane = tid & 63, w = tid >> 6, wm = w >> 2, wn = w & 3, l32 = lane & 31, hf = lane >> 5;
  const int nN = N / 256;
  for (int lt = blockIdx.x >> 3; lt < 16 * nN; lt += gridDim.x >> 3) {
    int mt, nt; tile_map(lt, 16, nN, 8, 4, mt, nt);
    const int m0 = mt * 256, n0 = nt * 256;
    gemm_tile<V>(A + (size_t)m0 * lda, lda, K / 64, nullptr, 0, 0, Wt + (size_t)n0 * ldb, ldb, smem, [&](f32x16(&acc)[2][2], int moff) {
      const int m0_ = m0 + moff;
      int l32_ = l32, hf_ = hf; asm volatile("" : "+v"(l32_), "+v"(hf_));
#pragma unroll
      for (int i = 0; i < 2; ++i)
#pragma unroll
        for (int j = 0; j < 2; ++j)
#pragma unroll
          for (int r = 0; r < 16; ++r) {
            const int row = m0_ + wm * 64 + i * 32 + crow(r, hf_), col = n0 + wn * 64 + j * 32 + l32_;
            float v = acc[i][j][r];
            if (mode == 1) { v = fmaxf(v, 0.f); v = v * v; }
            if (V == 0 || v == 123456.789f) C[(size_t)row * ldc + col] = f2bf(v);
          }
    });
  }
}

DI void att_in_phase(const Params& p, int j, char* smem) {
  const int tid = opqv(threadIdx.x), lane = tid & 63, w = tid >> 6, wm = w >> 2, wn = w & 3, l32 = lane & 31, hf = lane >> 5;
  char* ws = opq(p.ws);
  const u16* A = (const u16*)(ws + OFF_HY);
  const u16* Wt = (const u16*)(ws + OFF_W_ATTIN) + (size_t)j * 1536 * LDW1;
  u16* zc = (u16*)(ws + OFF_ZC); u16* SQ = (u16*)(ws + OFF_SQ); u16* SK = (u16*)(ws + OFF_SK); u16* SV = (u16*)(ws + OFF_SV);
  u16* Kb = (u16*)(ws + OFF_KB);
  const float2* rt64 = (const float2*)(ws + OFF_RT64); const float2* rt32 = (const float2*)(ws + OFF_RT32);
  const int nN = 6;
  for (int lt = blockIdx.x >> 3; lt < 16 * nN; lt += gridDim.x >> 3) {
    int mt, nt; tile_map(lt, 16, nN, 16, 2, mt, nt);
    const int m0 = mt * 256, n0 = nt * 256;
    gemm_tile(A + (size_t)m0 * LDH, LDH, 16, nullptr, 0, 0, Wt + (size_t)n0 * LDW1, LDW1, smem, [&](f32x16(&acc)[2][2], int moff) {
      const int m0_ = m0 + moff;
      int l32_ = l32, hf_ = hf; asm volatile("" : "+v"(l32_), "+v"(hf_));
      const int C64 = n0 + wn * 64;
#pragma unroll
      for (int i = 0; i < 2; ++i) {
        const int rb = m0_ + wm * 64 + i * 32;
        if (C64 < 640) {
#pragma unroll
          for (int jn = 0; jn < 2; ++jn)
#pragma unroll
            for (int r = 0; r < 16; ++r) zc[(size_t)(rb + crow(r, hf_)) * 640 + C64 + jn * 32 + l32_] = f2bf(acc[i][jn][r]);
        } else if (C64 < 1280) {
          const bool isq = C64 < 1152;
          u16* dst = isq ? SQ : SK; const int pitch = isq ? 512 : 128; const int cb = isq ? (C64 - 640) : (C64 - 1152);
          const float sc = isq ? SWA_QSCALE : 1.f;
#pragma unroll
          for (int r = 0; r < 16; ++r) {
            const int t = rb + crow(r, hf_), pos = t & (S_ - 1);
            const float2 cs = rt64[pos * 32 + l32_];
            const float x1 = acc[i][0][r], x2 = acc[i][1][r];
            dst[(size_t)t * pitch + cb + l32_] = f2bf((x1 * cs.x - x2 * cs.y) * sc);
            dst[(size_t)t * pitch + cb + 32 + l32_] = f2bf((x2 * cs.x + x1 * cs.y) * sc);
          }
        } else if (C64 < 1408) {
#pragma unroll
          for (int jn = 0; jn < 2; ++jn)
#pragma unroll
            for (int r = 0; r < 16; ++r) SV[(size_t)(rb + crow(r, hf_)) * 128 + (C64 - 1280) + jn * 32 + l32_] = f2bf(acc[i][jn][r]);
        } else if (C64 == 1408) {
#pragma unroll
          for (int r = 0; r < 16; ++r) {
            const int t = rb + crow(r, hf_), pos = t & (S_ - 1);
            const float x = acc[i][0][r];
            const float xp = __shfl_xor(x, 16);
            const float2 cs = rt32[pos * 16 + (l32_ & 15)];
            const float o = (l32_ < 16) ? (x * cs.x - xp * cs.y) : (x * cs.x + xp * cs.y);
            const u16 v = f2bf(o);
#pragma unroll
            for (int h = 0; h < 8; ++h) Kb[(size_t)t * LDKB + h * 96 + 64 + l32_] = v;
          }
        }
      }
    });
  }
}

DI void qkv_phase(const Params& p, int j, char* smem) {
  const int tid = opqv(threadIdx.x), lane = tid & 63, w = tid >> 6, wm = w >> 2, wn = w & 3, l32 = lane & 31, hf = lane >> 5;
  char* ws = opq(p.ws);
  const u16* zc = (const u16*)(ws + OFF_ZC);
  const u16* Wq = (const u16*)(ws + OFF_W_UQ) + (size_t)j * 768 * 384;
  const u16* Wkv = (const u16*)(ws + OFF_W_UKV) + (size_t)j * 1024 * 256;
  u16* Qb = (u16*)(ws + OFF_QB); u16* Kb = (u16*)(ws + OFF_KB); u16* Vt = (u16*)(ws + OFF_VT);
  const float2* rt32 = (const float2*)(ws + OFF_RT32);
  float* rsc = (float*)(smem + SMEM_GEMM);
  for (int lt0 = blockIdx.x >> 3; lt0 < 16 * 7; lt0 += gridDim.x >> 3) {
    const bool isq = lt0 < 16 * 3;
    int mt, nt;
    if (isq) tile_map(lt0, 16, 3, 16, 1, mt, nt); else tile_map(lt0 - 16 * 3, 16, 4, 8, 4, mt, nt);
    const int m0 = mt * 256, n0 = nt * 256;
    const int coff = isq ? 0 : 384, ncols = isq ? 384 : 256;
    {
      const int row = tid >> 1, half = tid & 1, nh = ncols / 2;
      const u16* src = zc + (size_t)(m0 + row) * 640 + coff + half * nh;
      float s = 0.f;
      for (int c = 0; c < nh; c += 8) {
        const uint4 v = *(const uint4*)(src + c);
        float f;
        f = bf2f(v.x & 0xffffu); s += f * f; f = bf2f(v.x >> 16); s += f * f;
        f = bf2f(v.y & 0xffffu); s += f * f; f = bf2f(v.y >> 16); s += f * f;
        f = bf2f(v.z & 0xffffu); s += f * f; f = bf2f(v.z >> 16); s += f * f;
        f = bf2f(v.w & 0xffffu); s += f * f; f = bf2f(v.w >> 16); s += f * f;
      }
      s += __shfl_xor(s, 1);
      if (half == 0) rsc[row] = rsqrtf(s / (float)ncols + 1e-6f);
    }
    __syncthreads();
    if (isq) {
      gemm_tile(zc + (size_t)m0 * 640, 640, 6, nullptr, 0, 0, Wq + (size_t)n0 * 384, 384, smem, [&](f32x16(&acc)[2][2], int moff) {
      const int m0_ = m0 + moff;
      int l32_ = l32, hf_ = hf; asm volatile("" : "+v"(l32_), "+v"(hf_));
        const int C64 = n0 + wn * 64;
#pragma unroll
        for (int i = 0; i < 2; ++i) {
          const int rl = wm * 64 + i * 32;
#pragma unroll
          for (int jn = 0; jn < 2; ++jn)
#pragma unroll
            for (int r = 0; r < 16; ++r) {
              const int rr = rl + crow(r, hf_), t = m0_ + rr;
              const float x = acc[i][jn][r] * rsc[moff + rr] * MLA_QSCALE;
              if (C64 < 512) {
                Qb[(size_t)t * 768 + (C64 >> 6) * 96 + jn * 32 + l32_] = f2bf(x);
              } else {
                const int hq = ((C64 - 512) >> 5) + jn, pos = t & (S_ - 1);
                const float xp = __shfl_xor(x, 16);
                const float2 cs = rt32[pos * 16 + (l32_ & 15)];
                const float o = (l32_ < 16) ? (x * cs.x - xp * cs.y) : (x * cs.x + xp * cs.y);
                Qb[(size_t)t * 768 + hq * 96 + 64 + l32_] = f2bf(o);
              }
            }
        }
      });
    } else {
      gemm_tile(zc + (size_t)m0 * 640 + 384, 640, 4, nullptr, 0, 0, Wkv + (size_t)n0 * 256, 256, smem, [&](f32x16(&acc)[2][2], int moff) {
      const int m0_ = m0 + moff;
      int l32_ = l32, hf_ = hf; asm volatile("" : "+v"(l32_), "+v"(hf_));
        const int C64 = n0 + wn * 64, h = C64 >> 7, part = (C64 >> 6) & 1;
#pragma unroll
        for (int i = 0; i < 2; ++i) {
          const int rl = wm * 64 + i * 32;
#pragma unroll
          for (int jn = 0; jn < 2; ++jn) {
            if (part == 0) {
#pragma unroll
              for (int r = 0; r < 16; ++r) {
                const int rr = rl + crow(r, hf_), t = m0_ + rr;
                Kb[(size_t)t * LDKB + h * 96 + jn * 32 + l32_] = f2bf(acc[i][jn][r] * rsc[moff + rr]);
              }
            } else {
              const int e = jn * 32 + l32_;
#pragma unroll
              for (int qd = 0; qd < 4; ++qd) {
                const int rr = rl + 8 * qd + 4 * hf_, t0 = m0_ + rr, b = t0 >> 14, s0 = t0 & (S_ - 1);
                uint2 o;
                o.x = pack2(acc[i][jn][4 * qd + 0] * rsc[moff + rr + 0], acc[i][jn][4 * qd + 1] * rsc[moff + rr + 1]);
                o.y = pack2(acc[i][jn][4 * qd + 2] * rsc[moff + rr + 2], acc[i][jn][4 * qd + 3] * rsc[moff + rr + 3]);
                *(uint2*)(Vt + ((size_t)((b * 8 + h) * 64 + e)) * LDV + s0) = o;
              }
            }
          }
        }
      });
    }
    __syncthreads();
  }
}

constexpr int MLA_BUF = 64 * 208 + 64 * 136;
constexpr int MLA_SVP = 264;
constexpr int MLA_BUF2 = 128 * 208 + 64 * MLA_SVP;
DI void mla_item(const Params& p, int qb, int b, int h, char* smem) {
  const int tid = opqv(threadIdx.x), lane = tid & 63, w = tid >> 6, l32 = lane & 31, hf = lane >> 5;
  char* ws = opq(p.ws);
  const u16* Qb = (const u16*)(ws + OFF_QB); u16* o = (u16*)(ws + OFF_OE);
  const int q0 = qb * 256 + w * 32;
  const size_t tq = (size_t)b * S_ + q0 + l32;
  bf16x8 qf[6];
#pragma unroll
  for (int s = 0; s < 6; ++s) qf[s] = *(const bf16x8*)(Qb + tq * 768 + h * 96 + s * 16 + hf * 8);
  f32x16 ot[2]; ot[0] = zero16(); ot[1] = zero16();
  float m = -1e30f, l = 0.f;
  const int ntile = 2 * qb + 2;
  const u16* Kg = (const u16*)(ws + OFF_KB) + ((size_t)b * S_) * LDKB + h * 96;
  const u16* Vg = (const u16*)(ws + OFF_VT) + ((size_t)(b * 8 + h) * 64) * LDV;
  u32x4 rk[2][3], rv[2][2];
#define MGLOAD(SET, KT) { const int kt_ = (KT); \
    _Pragma("unroll") for (int i = 0; i < 3; ++i) { const int c = tid + 512 * i, row = c / 12, ch = c % 12; rk[SET][i] = *(const u32x4*)(Kg + (size_t)(kt_ * 128 + row) * LDKB + ch * 8); } \
    _Pragma("unroll") for (int i = 0; i < 2; ++i) { const int c = tid + 512 * i, row = c >> 4, ch = c & 15; rv[SET][i] = *(const u32x4*)(Vg + (size_t)row * LDV + kt_ * 128 + ch * 8); } }
#define MSWRITE(SET, BUF) { char* sk_ = smem + (BUF) * MLA_BUF2; char* sv_ = sk_ + 128 * 208; \
    _Pragma("unroll") for (int i = 0; i < 3; ++i) { const int c = tid + 512 * i, row = c / 12, ch = c % 12; *(u32x4*)(sk_ + row * 208 + ch * 16) = rk[SET][i]; } \
    _Pragma("unroll") for (int i = 0; i < 2; ++i) { const int c = tid + 512 * i, row = c >> 4, ch = c & 15; \
      *(uint2*)(sv_ + row * MLA_SVP + ch * 16) = make_uint2(rv[SET][i].x, rv[SET][i].y); \
      *(uint2*)(sv_ + row * MLA_SVP + ch * 16 + 8) = make_uint2(rv[SET][i].z, rv[SET][i].w); } }
  auto compute = [&](int kt, int sub) {
    const char* sk = smem + (kt & 1) * MLA_BUF2 + sub * (64 * 208); const char* sv = smem + (kt & 1) * MLA_BUF2 + 128 * 208 + sub * 128;
    const int k0 = kt * 128 + sub * 64;
    if (k0 <= q0 + 31) {
      f32x16 st[2];
      bf16x8 kf[2][6];
#pragma unroll
      for (int t32 = 0; t32 < 2; ++t32)
#pragma unroll
        for (int s = 0; s < 6; ++s) kf[t32][s] = *(const bf16x8*)(sk + (t32 * 32 + l32) * 208 + (s * 16 + hf * 8) * 2);
      __builtin_amdgcn_sched_barrier(0);
      __builtin_amdgcn_s_setprio(1);
#pragma unroll
      for (int t32 = 0; t32 < 2; ++t32) {
        st[t32] = zero16();
#pragma unroll
        for (int s = 0; s < 6; ++s) st[t32] = MFMA(kf[t32][s], qf[s], st[t32]);
      }
      __builtin_amdgcn_s_setprio(0);
      bf16x8 vf[2][2][2];
#pragma unroll
      for (int t32 = 0; t32 < 2; ++t32)
#pragma unroll
        for (int s = 0; s < 2; ++s)
#pragma unroll
          for (int mt = 0; mt < 2; ++mt) {
            const char* vp = sv + (mt * 32 + l32) * MLA_SVP + (t32 * 32 + s * 16 + hf * 4) * 2;
            vf[t32][s][mt] = join8(*(const uint2*)vp, *(const uint2*)(vp + 16));
          }
      __builtin_amdgcn_sched_barrier(0);
      if (k0 + 63 > q0) {
        const int qpos = q0 + l32;
#pragma unroll
        for (int t32 = 0; t32 < 2; ++t32)
#pragma unroll
          for (int r = 0; r < 16; ++r) { const int key = k0 + t32 * 32 + crow(r, hf); if (key > qpos) st[t32][r] = -1e30f; }
      }
      float mx = -1e30f;
#pragma unroll
      for (int t32 = 0; t32 < 2; ++t32)
#pragma unroll
        for (int r = 0; r < 16; ++r) mx = fmaxf(mx, st[t32][r]);
      mx = fmaxf(mx, __shfl_xor(mx, 32));
      const float mn = fmaxf(m, mx);
      const float alpha = ex2(m - mn);
      m = mn;
      float ps = 0.f;
#pragma unroll
      for (int t32 = 0; t32 < 2; ++t32)
#pragma unroll
        for (int r = 0; r < 16; ++r) { const float pv = ex2(st[t32][r] - mn); st[t32][r] = pv; ps += pv; }
      l = l * alpha + ps;
#pragma unroll
      for (int mt = 0; mt < 2; ++mt)
#pragma unroll
        for (int r = 0; r < 16; ++r) ot[mt][r] *= alpha;
      __builtin_amdgcn_s_setprio(1);
#pragma unroll
      for (int t32 = 0; t32 < 2; ++t32)
#pragma unroll
        for (int s = 0; s < 2; ++s) {
          const bf16x8 pf = pack8(st[t32], s);
#pragma unroll
          for (int mt = 0; mt < 2; ++mt) ot[mt] = MFMA(vf[t32][s][mt], pf, ot[mt]);
        }
      __builtin_amdgcn_s_setprio(0);
    }
  };
  MGLOAD(0, 0); MGLOAD(1, 1);
  MSWRITE(0, 0); __syncthreads();
  for (int kt = 0; kt < ntile; kt += 2) {
    if (kt + 2 < ntile) MGLOAD(0, kt + 2);
    __builtin_amdgcn_sched_barrier(0);
    compute(kt, 0); compute(kt, 1);
    MSWRITE(1, 1);
    __syncthreads();
    if (kt + 3 < ntile) MGLOAD(1, kt + 3);
    __builtin_amdgcn_sched_barrier(0);
    compute(kt + 1, 0); compute(kt + 1, 1);
    if (kt + 2 < ntile) MSWRITE(0, 0);
    __syncthreads();
  }
#undef MGLOAD
#undef MSWRITE
  l += __shfl_xor(l, 32);
  const float inv = 1.f / l;
#pragma unroll
  for (int mt = 0; mt < 2; ++mt)
#pragma unroll
    for (int qd = 0; qd < 4; ++qd) {
      const int e0 = mt * 32 + 8 * qd + 4 * hf;
      uint2 ov;
      ov.x = pack2(ot[mt][4 * qd + 0] * inv, ot[mt][4 * qd + 1] * inv);
      ov.y = pack2(ot[mt][4 * qd + 2] * inv, ot[mt][4 * qd + 3] * inv);
      *(uint2*)(o + tq * LDH + h * 64 + e0) = ov;
    }
}

DI void swa_item(const Params& p, int j, int b, int nblk, int kvh, char* smem) {
  const int tid = opqv(threadIdx.x) & 255, lane = tid & 63, w = tid >> 6, l32 = lane & 31, hf = lane >> 5;
  char* ws = opq(p.ws);
  const u16* SQ = (const u16*)(ws + OFF_SQ); const u16* SK = (const u16*)(ws + OFF_SK); const u16* SV = (const u16*)(ws + OFF_SV);
  u16* o = (u16*)(ws + OFF_OE);
  char* sk = smem; char* sv = smem + 256 * 144;
  const int ws0 = 128 * (nblk - 1);
#pragma unroll
  for (int i = 0; i < 8; ++i) {
    const int c = tid + 256 * i, row = c >> 3, ch = c & 7, pos = ws0 + row;
    uint4 kv = make_uint4(0, 0, 0, 0), vv = make_uint4(0, 0, 0, 0);
    if (pos >= 0) {
      kv = *(const uint4*)(SK + ((size_t)b * S_ + pos) * 128 + kvh * 64 + ch * 8);
      vv = *(const uint4*)(SV + ((size_t)b * S_ + pos) * 128 + kvh * 64 + ch * 8);
    }
    *(uint4*)(sk + row * 144 + ch * 16) = kv;
    char* vb = sv + (ch * 8) * 528 + row * 2;
    *(u16*)(vb + 0 * 528) = (u16)(vv.x & 0xffffu); *(u16*)(vb + 1 * 528) = (u16)(vv.x >> 16);
    *(u16*)(vb + 2 * 528) = (u16)(vv.y & 0xffffu); *(u16*)(vb + 3 * 528) = (u16)(vv.y >> 16);
    *(u16*)(vb + 4 * 528) = (u16)(vv.z & 0xffffu); *(u16*)(vb + 5 * 528) = (u16)(vv.z >> 16);
    *(u16*)(vb + 6 * 528) = (u16)(vv.w & 0xffffu); *(u16*)(vb + 7 * 528) = (u16)(vv.w >> 16);
  }
  __syncthreads();
  const size_t tq = (size_t)b * S_ + nblk * 128 + w * 32 + l32;
  const int qloc = 128 + w * 32 + l32;
#pragma unroll 1
  for (int g = 0; g < 4; ++g) {
    const int head = kvh * 4 + g;
    bf16x8 qf[4];
#pragma unroll
    for (int s = 0; s < 4; ++s) qf[s] = *(const bf16x8*)(SQ + tq * 512 + head * 64 + s * 16 + hf * 8);
    f32x16 st[5];
    const float sink2 = p.swa_sinks[j * 8 + head] * LOG2E;
    float mx = sink2;
#pragma unroll
    for (int tt = 0; tt < 5; ++tt) {
      const int kb = w * 32 + tt * 32;
      st[tt] = zero16();
#pragma unroll
      for (int s = 0; s < 4; ++s) {
        const bf16x8 kf = *(const bf16x8*)(sk + (kb + l32) * 144 + (s * 16 + hf * 8) * 2);
        st[tt] = MFMA(kf, qf[s], st[tt]);
      }
#pragma unroll
      for (int r = 0; r < 16; ++r) {
        const int kloc = kb + crow(r, hf);
        const bool valid = (kloc <= qloc) && (kloc > qloc - 128) && (ws0 + kloc >= 0);
        const float v = valid ? st[tt][r] : -1e30f;
        st[tt][r] = v; mx = fmaxf(mx, v);
      }
    }
    mx = fmaxf(mx, __shfl_xor(mx, 32));
    float ps = 0.f;
#pragma unroll
    for (int tt = 0; tt < 5; ++tt)
#pragma unroll
      for (int r = 0; r < 16; ++r) { const float pv = ex2(st[tt][r] - mx); st[tt][r] = pv; ps += pv; }
    ps += __shfl_xor(ps, 32);
    const float inv = 1.f / (ps + ex2(sink2 - mx));
    f32x16 ot[2]; ot[0] = zero16(); ot[1] = zero16();
#pragma unroll
    for (int tt = 0; tt < 5; ++tt) {
      const int kb = w * 32 + tt * 32;
#pragma unroll
      for (int s = 0; s < 2; ++s) {
        const bf16x8 pf = pack8(st[tt], s);
#pragma unroll
        for (int mt = 0; mt < 2; ++mt) {
          const char* vp = sv + (mt * 32 + l32) * 528 + (kb + s * 16 + hf * 4) * 2;
          const bf16x8 vf = join8(*(const uint2*)vp, *(const uint2*)(vp + 16));
          ot[mt] = MFMA(vf, pf, ot[mt]);
        }
      }
    }
#pragma unroll
    for (int mt = 0; mt < 2; ++mt)
#pragma unroll
      for (int qd = 0; qd < 4; ++qd) {
        const int e0 = mt * 32 + 8 * qd + 4 * hf;
        uint2 ov;
        ov.x = pack2(ot[mt][4 * qd + 0] * inv, ot[mt][4 * qd + 1] * inv);
        ov.y = pack2(ot[mt][4 * qd + 2] * inv, ot[mt][4 * qd + 3] * inv);
        *(uint2*)(o + tq * LDH + 512 + head * 64 + e0) = ov;
      }
  }
  __syncthreads();
}

DI void attn_phase(const Params& p, int j, int ctr_idx, char* smem) {
  __shared__ int s_item;
  const int xcd = blockIdx.x & 7;
  int* ctr = (int*)(p.ws + OFF_CTR) + 16 + ctr_idx * 8 + xcd;
  const int nmla = 128, nswa = 32;
  const int half = opqv(threadIdx.x) >> 8;
  char* sm = smem + half * HALF_SMEM;
  for (;;) {
    __syncthreads();
    if (threadIdx.x == 0) s_item = atomicAdd(ctr, 1);
    __syncthreads();
    const int it = s_item;
    if (it >= nmla + nswa) break;
    if (it < nmla) {
      const int qb = 63 - (it >> 1), bh = xcd * 2 + (it & 1);
      mla_item(p, qb, bh >> 3, bh & 7, smem);
    } else {
      const int k = (xcd * nswa + (it - nmla)) * 2 + half;
      swa_item(p, j, k >> 8, (k >> 1) & 127, k & 1, sm);
    }
  }
}

DI void rec_in_phase(const Params& p, int j, char* smem) {
  const int tid = opqv(threadIdx.x), lane = tid & 63, w = tid >> 6, wm = w >> 2, wn = w & 3, l32 = lane & 31, hf = lane >> 5;
  char* ws = opq(p.ws);
  const u16* A = (const u16*)(ws + OFF_HY);
  const u16* Wt = (const u16*)(ws + OFF_W_RECIN) + (size_t)j * 2560 * LDW1;
  u16* zr = (u16*)(ws + OFF_ZR); u16* ug = (u16*)(ws + OFF_UG);
  const float2* rt128 = (const float2*)(ws + OFF_RT128);
  const int nN = 10;
  for (int lt = blockIdx.x >> 3; lt < 16 * nN; lt += gridDim.x >> 3) {
    int mt, nt; tile_map(lt, 16, nN, 16, 2, mt, nt);
    const int m0 = mt * 256, n0 = nt * 256;
    gemm_tile(A + (size_t)m0 * LDH, LDH, 16, nullptr, 0, 0, Wt + (size_t)n0 * LDW1, LDW1, smem, [&](f32x16(&acc)[2][2], int moff) {
      const int m0_ = m0 + moff;
      int l32_ = l32, hf_ = hf; asm volatile("" : "+v"(l32_), "+v"(hf_));
      const int C64 = n0 + wn * 64;
#pragma unroll
      for (int i = 0; i < 2; ++i) {
        const int rb = m0_ + wm * 64 + i * 32;
        if (C64 < 1024) {
          const int fi = ((C64 & 127) >> 1) + l32_, cbase = C64 & ~127;
          const float sc = (C64 >= 512) ? RET_KSCALE : 1.f;
#pragma unroll
          for (int r = 0; r < 16; ++r) {
            const int t = rb + crow(r, hf_), pos = t & (S_ - 1);
            const float2 cs = rt128[pos * 64 + fi];
            const float x1 = acc[i][0][r], x2 = acc[i][1][r];
            zr[(size_t)t * LDZR + cbase + fi] = f2bf((x1 * cs.x - x2 * cs.y) * sc);
            zr[(size_t)t * LDZR + cbase + 64 + fi] = f2bf((x2 * cs.x + x1 * cs.y) * sc);
          }
        } else if (C64 < 2048) {
#pragma unroll
          for (int jn = 0; jn < 2; ++jn)
#pragma unroll
            for (int r = 0; r < 16; ++r) zr[(size_t)(rb + crow(r, hf_)) * LDZR + C64 + jn * 32 + l32_] = f2bf(acc[i][jn][r]);
        } else {
#pragma unroll
          for (int jn = 0; jn < 2; ++jn) {
            const int cl = C64 - 2048 + jn * 32 + l32_, g = cl >> 4, pp = cl & 15;
#pragma unroll
            for (int r = 0; r < 16; ++r) ug[((size_t)g * T_ + rb + crow(r, hf_)) * 16 + pp] = f2bf(acc[i][jn][r]);
          }
        }
      }
    });
  }
}

DI void s5_fill(const Params& p, int j) {
  const int tid = opqv(threadIdx.x), nb = gridDim.x, bid = blockIdx.x;
  char* ws = opq(p.ws);
  const float4* s5z = (const float4*)(ws + OFF_S5Z) + j * 2048; const float2* bbar = (const float2*)(ws + OFF_BBAR) + j * 2048 * 16;
  const float* ktab = (const float*)(ws + OFF_KTAB) + (size_t)j * 32 * 32 * 256;
  u16* WE = (u16*)(ws + OFF_WE); u16* WY = (u16*)(ws + OFF_WY);
  for (int idx = bid * NTHR + tid; idx < 32 * 256 * 512; idx += nb * NTHR) {
    const int g = idx >> 17, n2 = (idx >> 9) & 255, k = idx & 511, jj = k >> 4, q = k & 15, n = n2 & 63;
    if (n2 >= 128) { WE[idx] = 0; continue; }
    const float4 z = s5z[g * 64 + n];
    const float d = (float)(31 - jj);
    const float mg = expf(d * z.x), ang = d * z.y; float sn_, cs_; sincos_(ang, sn_, cs_);
    const float er = mg * cs_, ei = mg * sn_;
    const float2 bb = bbar[(g * 64 + n) * 16 + q];
    const float v = (n2 < 64) ? (er * bb.x - ei * bb.y) : (er * bb.y + ei * bb.x);
    WE[idx] = f2bf(v);
  }
  for (int idx = bid * NTHR + tid; idx < 32 * 512 * 640; idx += nb * NTHR) {
    const int g = idx / (512 * 640), rem = idx - g * (512 * 640), mrow = rem / 640, k = rem - mrow * 640;
    const int i = mrow >> 4, pp = mrow & 15;
    float v;
    if (k < 512) {
      const int jj = k >> 4, q = k & 15, d = i - jj;
      v = (d >= 0) ? ktab[(g * 32 + d) * 256 + pp * 16 + q] : 0.f;
      if (d == 0 && q == pp) v += p.s5_d[j * 512 + g * 16 + pp];
    } else {
      const int n2 = k - 512, n = n2 & 63;
      const float4 z = s5z[g * 64 + n];
      const float d = (float)(i + 1);
      const float mg = expf(d * z.x), ang = d * z.y; float sn_, cs_; sincos_(ang, sn_, cs_);
    const float er = mg * cs_, ei = mg * sn_;
      const float cr = p.s5_c_re[((j * 32 + g) * 16 + pp) * 64 + n], ci = p.s5_c_im[((j * 32 + g) * 16 + pp) * 64 + n];
      v = (n2 < 64) ? (cr * er - ci * ei) : -(cr * ei + ci * er);
    }
    WY[idx] = f2bf(v);
  }
}

DI void ret_u_item(const Params& p, int b, int n, int h, char* smem) {
  const int tid = opqv(threadIdx.x) & 255, lane = tid & 63, w = tid >> 6, wm = w >> 1, wn = w & 1, l32 = lane & 31, hf = lane >> 5;
  char* ws = opq(p.ws);
  const u16* zr = (const u16*)(ws + OFF_ZR); float* U = (float*)(ws + OFF_UO);
  char* sKt = smem; char* sVt = smem + 128 * 272;
  const size_t t0 = (size_t)b * S_ + n * 128;
  const float lg = lg2gamma(h);
#pragma unroll
  for (int i = 0; i < 8; ++i) {
    const int c = tid + 256 * i, row = c >> 4, ch = c & 15;
    const uint4 kv = *(const uint4*)(zr + (t0 + row) * LDZR + 512 + h * 128 + ch * 8);
    const uint4 vv = *(const uint4*)(zr + (t0 + row) * LDZR + 1024 + h * 128 + ch * 8);
    const float te = ex2((float)(127 - row) * lg);
    char* kb = sKt + (ch * 8) * 272 + row * 2; char* vb = sVt + (ch * 8) * 272 + row * 2;
    *(u16*)(kb + 0 * 272) = f2bf(bf2f(kv.x & 0xffffu) * te); *(u16*)(kb + 1 * 272) = f2bf(bf2f(kv.x >> 16) * te);
    *(u16*)(kb + 2 * 272) = f2bf(bf2f(kv.y & 0xffffu) * te); *(u16*)(kb + 3 * 272) = f2bf(bf2f(kv.y >> 16) * te);
    *(u16*)(kb + 4 * 272) = f2bf(bf2f(kv.z & 0xffffu) * te); *(u16*)(kb + 5 * 272) = f2bf(bf2f(kv.z >> 16) * te);
    *(u16*)(kb + 6 * 272) = f2bf(bf2f(kv.w & 0xffffu) * te); *(u16*)(kb + 7 * 272) = f2bf(bf2f(kv.w >> 16) * te);
    *(u16*)(vb + 0 * 272) = (u16)(vv.x & 0xffffu); *(u16*)(vb + 1 * 272) = (u16)(vv.x >> 16);
    *(u16*)(vb + 2 * 272) = (u16)(vv.y & 0xffffu); *(u16*)(vb + 3 * 272) = (u16)(vv.y >> 16);
    *(u16*)(vb + 4 * 272) = (u16)(vv.z & 0xffffu); *(u16*)(vb + 5 * 272) = (u16)(vv.z >> 16);
    *(u16*)(vb + 6 * 272) = (u16)(vv.w & 0xffffu); *(u16*)(vb + 7 * 272) = (u16)(vv.w >> 16);
  }
  __syncthreads();
  f32x16 acc[2][2];
#pragma unroll
  for (int i = 0; i < 2; ++i)
#pragma unroll
    for (int jn = 0; jn < 2; ++jn) acc[i][jn] = zero16();
#pragma unroll
  for (int s = 0; s < 8; ++s) {
    bf16x8 af[2], bfr[2];
#pragma unroll
    for (int i = 0; i < 2; ++i) af[i] = *(const bf16x8*)(sVt + (wm * 64 + i * 32 + l32) * 272 + (s * 16 + hf * 8) * 2);
#pragma unroll
    for (int jn = 0; jn < 2; ++jn) bfr[jn] = *(const bf16x8*)(sKt + (wn * 64 + jn * 32 + l32) * 272 + (s * 16 + hf * 8) * 2);
#pragma unroll
    for (int i = 0; i < 2; ++i)
#pragma unroll
      for (int jn = 0; jn < 2; ++jn) acc[i][jn] = MFMA(af[i], bfr[jn], acc[i][jn]);
  }
  float* Ub = U + ((size_t)((b * 4 + h) * 128 + n)) * 16384;
#pragma unroll
  for (int i = 0; i < 2; ++i)
#pragma unroll
    for (int jn = 0; jn < 2; ++jn)
#pragma unroll
      for (int r = 0; r < 16; ++r) Ub[(wm * 64 + i * 32 + crow(r, hf)) * 128 + wn * 64 + jn * 32 + l32] = acc[i][jn][r];
  __syncthreads();
}

DI void rec_state_phase(const Params& p, int j, char* smem) {
  const int tid = opqv(threadIdx.x), lane = tid & 63, w = tid >> 6, wm = w >> 2, wn = w & 3, l32 = lane & 31, hf = lane >> 5;
  char* ws = opq(p.ws);
  {
    const int half = opqv(threadIdx.x) >> 8;
    char* sm = smem + half * HALF_SMEM;
    for (int it = blockIdx.x; it < 512; it += gridDim.x) { const int item = it * 2 + half; ret_u_item(p, item >> 9, (item >> 2) & 127, item & 3, sm); }
  }
  for (int it = blockIdx.x; it < 128; it += gridDim.x) {
    const int g = it >> 2, mt = it & 3, m0 = mt * 256;
    const u16* A = (const u16*)(ws + OFF_UG) + (size_t)g * T_ * 16 + (size_t)m0 * 512;
    const u16* Bt = (const u16*)(ws + OFF_WE) + (size_t)g * 256 * 512;
    float* E = (float*)(ws + OFF_EB) + (size_t)g * 1024 * 128;
    gemm_tile(A, 512, 8, nullptr, 0, 0, Bt, 512, smem, [&](f32x16(&acc)[2][2], int moff) {
      int l32_ = l32, hf_ = hf; asm volatile("" : "+v"(l32_), "+v"(hf_));
      const int m0_ = m0 + moff;
      if (wn < 2) {
#pragma unroll
        for (int i = 0; i < 2; ++i)
#pragma unroll
          for (int jn = 0; jn < 2; ++jn)
#pragma unroll
            for (int r = 0; r < 16; ++r)
              E[(size_t)(m0_ + wm * 64 + i * 32 + crow(r, hf_)) * 128 + wn * 64 + jn * 32 + l32_] = acc[i][jn][r];
      }
    });
  }
}

DI void scan_phase(const Params& p, int j, char* smem) {
  const int tfull = opqv(threadIdx.x);
  const int tid = tfull & 255, half = tfull >> 8;
  char* ws = opq(p.ws);
  for (int it = blockIdx.x; it < 128; it += gridDim.x) {
    if (it < 64) {
      const int vb = it * 2 + half;
      const int idx = vb * 256 + tid, bh = idx >> 12, e4 = (idx & 4095) * 4, h = bh & 3;
      const float cd = ex2(128.f * lg2gamma(h));
      const float* U = (const float*)(ws + OFF_UO) + (size_t)bh * 128 * 16384 + e4;
      u16* Sp = (u16*)(ws + OFF_SP) + (size_t)bh * 128 * 16384 + e4;
      float4 S = make_float4(0, 0, 0, 0);
      for (int n0 = 0; n0 < 128; n0 += 16) {
        f32x4 u[16];
#pragma unroll
        for (int k = 0; k < 16; ++k) u[k] = *(const f32x4*)(U + (size_t)(n0 + k) * 16384);
#pragma unroll
        for (int k = 0; k < 16; ++k) {
          *(uint2*)(Sp + (size_t)(n0 + k) * 16384) = make_uint2(pack2(S.x, S.y), pack2(S.z, S.w));
          S.x = cd * S.x + u[k].x; S.y = cd * S.y + u[k].y; S.z = cd * S.z + u[k].z; S.w = cd * S.w + u[k].w;
        }
      }
    } else {
      const int bg = it - 64, b = bg >> 5, g = bg & 31, n = tfull & 63, seg = tfull >> 6;
      const float4 z = ((const float4*)(ws + OFF_S5Z))[(j * 32 + g) * 64 + n];
      const float mg = expf(32.f * z.x), ang = 32.f * z.y; float sn_, cs_; sincos_(ang, sn_, cs_);
      const float ar = mg * cs_, ai = mg * sn_;
      float br = ar, bi = ai;
#pragma unroll
      for (int t = 0; t < 6; ++t) { const float nr = br * br - bi * bi, ni = 2.f * br * bi; br = nr; bi = ni; }
      const float* E = (const float*)(ws + OFF_EB) + ((size_t)g * 1024 + b * 512 + seg * 64) * 128;
      u16* Xp = (u16*)(ws + OFF_XP) + ((size_t)g * 1024 + b * 512 + seg * 64) * 128;
      float2* Ls = (float2*)smem;
      float xr = 0.f, xi = 0.f;
      for (int c0 = 0; c0 < 64; c0 += 32) {
        float er[32], ei[32];
#pragma unroll
        for (int k = 0; k < 32; ++k) { er[k] = E[(c0 + k) * 128 + n]; ei[k] = E[(c0 + k) * 128 + 64 + n]; }
#pragma unroll
        for (int k = 0; k < 32; ++k) {
          const float nr = ar * xr - ai * xi + er[k], ni = ar * xi + ai * xr + ei[k];
          xr = nr; xi = ni;
        }
      }
      Ls[seg * 64 + n] = make_float2(xr, xi);
      __syncthreads();
      xr = 0.f; xi = 0.f;
      for (int s2 = 0; s2 < seg; ++s2) {
        const float2 L = Ls[s2 * 64 + n];
        const float nr = br * xr - bi * xi + L.x, ni = br * xi + bi * xr + L.y;
        xr = nr; xi = ni;
      }
      for (int c0 = 0; c0 < 64; c0 += 32) {
        float er[32], ei[32];
#pragma unroll
        for (int k = 0; k < 32; ++k) { er[k] = E[(c0 + k) * 128 + n]; ei[k] = E[(c0 + k) * 128 + 64 + n]; }
#pragma unroll
        for (int k = 0; k < 32; ++k) {
          Xp[(c0 + k) * 128 + n] = f2bf(xr); Xp[(c0 + k) * 128 + 64 + n] = f2bf(xi);
          const float nr = ar * xr - ai * xi + er[k], ni = ar * xi + ai * xr + ei[k];
          xr = nr; xi = ni;
        }
      }
      __syncthreads();
    }
  }
}

DI void ret_out_item(const Params& p, int b, int n, int h, char* smem) {
  const int tid = opqv(threadIdx.x) & 255, lane = tid & 63, w = tid >> 6, l32 = lane & 31, hf = lane >> 5;
  char* ws = opq(p.ws);
  const u16* zr = (const u16*)(ws + OFF_ZR); u16* o = (u16*)(ws + OFF_UO);
  char* sK = smem; char* sVt = smem + 128 * 272;
  const size_t t0 = (size_t)b * S_ + n * 128;
  const float lg = lg2gamma(h);
#pragma unroll
  for (int i = 0; i < 8; ++i) {
    const int c = tid + 256 * i, row = c >> 4, ch = c & 15;
    const uint4 kv = *(const uint4*)(zr + (t0 + row) * LDZR + 512 + h * 128 + ch * 8);
    const uint4 vv = *(const uint4*)(zr + (t0 + row) * LDZR + 1024 + h * 128 + ch * 8);
    *(uint4*)(sK + row * 272 + ch * 16) = kv;
    char* vb = sVt + (ch * 8) * 272 + row * 2;
    *(u16*)(vb + 0 * 272) = (u16)(vv.x & 0xffffu); *(u16*)(vb + 1 * 272) = (u16)(vv.x >> 16);
    *(u16*)(vb + 2 * 272) = (u16)(vv.y & 0xffffu); *(u16*)(vb + 3 * 272) = (u16)(vv.y >> 16);
    *(u16*)(vb + 4 * 272) = (u16)(vv.z & 0xffffu); *(u16*)(vb + 5 * 272) = (u16)(vv.z >> 16);
    *(u16*)(vb + 6 * 272) = (u16)(vv.w & 0xffffu); *(u16*)(vb + 7 * 272) = (u16)(vv.w >> 16);
  }
  __syncthreads();
  const size_t tq = t0 + w * 32 + l32;
  const int qi = w * 32 + l32;
  bf16x8 qf[8];
#pragma unroll
  for (int s = 0; s < 8; ++s) qf[s] = *(const bf16x8*)(zr + tq * LDZR + h * 128 + s * 16 + hf * 8);
  f32x16 ot[4];
  const u16* Sp = (const u16*)(ws + OFF_SP) + ((size_t)((b * 4 + h) * 128 + n)) * 16384;
#pragma unroll
  for (int mt = 0; mt < 4; ++mt) {
    ot[mt] = zero16();
#pragma unroll
    for (int s = 0; s < 8; ++s) {
      const bf16x8 sf = *(const bf16x8*)(Sp + (mt * 32 + l32) * 128 + s * 16 + hf * 8);
      ot[mt] = MFMA(sf, qf[s], ot[mt]);
    }
  }
  const float fs = ex2((float)(qi + 1) * lg);
#pragma unroll
  for (int mt = 0; mt < 4; ++mt)
#pragma unroll
    for (int r = 0; r < 16; ++r) ot[mt][r] *= fs;
#pragma unroll
  for (int tt = 0; tt < 4; ++tt) {
    if (tt <= w) {
      f32x16 st = zero16();
#pragma unroll
      for (int s = 0; s < 8; ++s) {
        const bf16x8 kf = *(const bf16x8*)(sK + (tt * 32 + l32) * 272 + (s * 16 + hf * 8) * 2);
        st = MFMA(kf, qf[s], st);
      }
#pragma unroll
      for (int r = 0; r < 16; ++r) {
        const int dd = qi - (tt * 32 + crow(r, hf));
        st[r] = (dd >= 0) ? st[r] * ex2((float)dd * lg) : 0.f;
      }
#pragma unroll
      for (int s2 = 0; s2 < 2; ++s2) {
        const bf16x8 pf = pack8(st, s2);
#pragma unroll
        for (int mt = 0; mt < 4; ++mt) {
          const char* vp = sVt + (mt * 32 + l32) * 272 + (tt * 32 + s2 * 16 + hf * 4) * 2;
          const bf16x8 vf = join8(*(const uint2*)vp, *(const uint2*)(vp + 16));
          ot[mt] = MFMA(vf, pf, ot[mt]);
        }
      }
    }
  }
  float sum = 0.f;
#pragma unroll
  for (int mt = 0; mt < 4; ++mt)
#pragma unroll
    for (int r = 0; r < 16; ++r) sum += ot[mt][r];
  sum += __shfl_xor(sum, 32);
  const float mean = sum * (1.f / 128.f);
  float vs = 0.f;
#pragma unroll
  for (int mt = 0; mt < 4; ++mt)
#pragma unroll
    for (int r = 0; r < 16; ++r) { const float d = ot[mt][r] - mean; vs += d * d; }
  vs += __shfl_xor(vs, 32);
  const float rstd = rsqrtf(vs * (1.f / 128.f) + 1e-5f);
#pragma unroll
  for (int mt = 0; mt < 4; ++mt)
#pragma unroll
    for (int qd = 0; qd < 4; ++qd) {
      const int e0 = mt * 32 + 8 * qd + 4 * hf;
      const uint2 gv = *(const uint2*)(zr + tq * LDZR + 1536 + h * 128 + e0);
      const float g0 = bf2f(gv.x & 0xffffu), g1 = bf2f(gv.x >> 16), g2 = bf2f(gv.y & 0xffffu), g3 = bf2f(gv.y >> 16);
      const float o0 = g0 / (1.f + __expf(-g0)) * (ot[mt][4 * qd + 0] - mean) * rstd;
      const float o1 = g1 / (1.f + __expf(-g1)) * (ot[mt][4 * qd + 1] - mean) * rstd;
      const float o2 = g2 / (1.f + __expf(-g2)) * (ot[mt][4 * qd + 2] - mean) * rstd;
      const float o3 = g3 / (1.f + __expf(-g3)) * (ot[mt][4 * qd + 3] - mean) * rstd;
      *(uint2*)(o + tq * LDH + h * 128 + e0) = make_uint2(pack2(o0, o1), pack2(o2, o3));
    }
  __syncthreads();
}

DI float gelu_tanh(float y) {
  const float u = 0.7978845608028654f * (y + 0.044715f * y * y * y);
  const float e = __expf(2.f * u);
  const float th = 1.f - 2.f / (e + 1.f);
  return 0.5f * y * (1.f + th);
}

DI void rec_out_phase(const Params& p, int j, char* smem) {
  const int tid = opqv(threadIdx.x), lane = tid & 63, w = tid >> 6, wm = w >> 2, wn = w & 3, l32 = lane & 31, hf = lane >> 5;
  char* ws = opq(p.ws);
  {
    const int half = opqv(threadIdx.x) >> 8;
    char* sm = smem + half * HALF_SMEM;
    for (int it = blockIdx.x; it < 512; it += gridDim.x) { const int item = it * 2 + half; ret_out_item(p, item >> 9, (item >> 2) & 127, item & 3, sm); }
  }
  for (int it = blockIdx.x; it < 256; it += gridDim.x) {
    {
      const int k = it, g = k >> 3, mt = (k >> 1) & 3, nt = k & 1, m0 = mt * 256, n0 = nt * 256;
      const u16* Ug = (const u16*)(ws + OFF_UG) + (size_t)g * T_ * 16;
      const u16* A1 = Ug + (size_t)m0 * 512;
      const u16* A2 = (const u16*)(ws + OFF_XP) + ((size_t)g * 1024 + m0) * 128;
      const u16* Bt = (const u16*)(ws + OFF_WY) + ((size_t)g * 512 + n0) * 640;
      u16* yt = (u16*)(ws + OFF_YT);
      gemm_tile(A1, 512, 8, A2, 128, 2, Bt, 640, smem, [&](f32x16(&acc)[2][2], int moff) {
      const int m0_ = m0 + moff;
      int l32_ = l32, hf_ = hf; asm volatile("" : "+v"(l32_), "+v"(hf_));
#pragma unroll
        for (int i = 0; i < 2; ++i)
#pragma unroll
          for (int jn = 0; jn < 2; ++jn)
#pragma unroll
            for (int r = 0; r < 16; ++r) {
              const int R = m0_ + wm * 64 + i * 32 + crow(r, hf_), col = n0 + wn * 64 + jn * 32 + l32_;
              const int ii = col >> 4, pp = col & 15;
              const size_t t = (size_t)R * 32 + ii;
              const float y = acc[i][jn][r];
              yt[t * LDYT + g * 16 + pp] = f2bf(gelu_tanh(y));
            }
      });
    }
  }
}

DI void glu_phase(const Params& p, int j, char* smem) {
  const int tid = opqv(threadIdx.x), lane = tid & 63, w = tid >> 6, wm = w >> 2, wn = w & 3, l32 = lane & 31, hf = lane >> 5;
  char* ws = opq(p.ws);
  const u16* yt = (const u16*)(ws + OFF_YT);
  const u16* Wt = (const u16*)(ws + OFF_W_GLU) + (size_t)j * 512 * LDGLU;
  u16* o = (u16*)(ws + OFF_UO);
  const float* gb = p.s5_glu_b + j * 512;
  const int nN = 2;
  for (int lt = blockIdx.x >> 3; lt < 16 * nN; lt += gridDim.x >> 3) {
    int mt, nt; tile_map(lt, 16, nN, 16, 2, mt, nt);
    const int m0 = mt * 256, n0 = nt * 256;
    gemm_tile(yt + (size_t)m0 * LDYT, LDYT, 8, nullptr, 0, 0, Wt + (size_t)n0 * LDGLU, LDGLU, smem, [&](f32x16(&acc)[2][2], int moff) {
      const int m0_ = m0 + moff;
      int l32_ = l32, hf_ = hf; asm volatile("" : "+v"(l32_), "+v"(hf_));
#pragma unroll
      for (int i = 0; i < 2; ++i)
#pragma unroll
        for (int jn = 0; jn < 2; ++jn)
#pragma unroll
          for (int r = 0; r < 16; ++r) {
            const int row = m0_ + wm * 64 + i * 32 + crow(r, hf_), col = n0 + wn * 64 + jn * 32 + l32_;
            const float gt = acc[i][jn][r] + gb[col];
            const float y = bf2f(yt[(size_t)row * LDYT + col]);
            o[(size_t)row * LDH + 512 + col] = f2bf(y / (1.f + __expf(-gt)));
          }
    });
  }
}

DI void run_phase(const Params& p, int ph, char* smem, int rep) {
  char* ws = opq(p.ws);
  if (ph == 0) { phase0(p, smem); return; }
  if (ph == 1) { phase1(p); return; }
  const int q = ph - 2, pair = q / 18, r = q % 18;
  const bool odd = r >= 8;
  const int k = odd ? r - 8 : r;
  const int l = pair * 2 + (odd ? 1 : 0), j = pair;
  int op = 2, pm = 0, ls = 0;
  if (!odd) {
    if (k == 3) { op = 0; pm = 0; } else if (k == 5) { op = 0; pm = 1; } else if (k == 6) { op = 0; pm = 2; }
    else if (k == 4) { op = 1; ls = 2 * l; } else if (k == 7) { op = 1; ls = 2 * l + 1; }
  } else {
    if (k == 5) { op = 0; pm = 0; } else if (k == 7) { op = 0; pm = 1; } else if (k == 8) { op = 0; pm = 2; }
    else if (k == 6) { op = 1; ls = 2 * l; } else if (k == 9) { op = 1; ls = 2 * l + 1; }
  }
  if (op == 0) {
    const u16* A; const u16* W; u16* C; int K, N, mode, lda, ldb, ldc;
    if (pm == 0) {
      A = (const u16*)(ws + (odd ? OFF_UO : OFF_OE)); lda = LDH;
      W = (const u16*)(ws + (odd ? OFF_W_RECOUT : OFF_W_ATTOUT)) + (size_t)j * 1024 * LDW1; ldb = LDW1;
      C = (u16*)(ws + OFF_HY); ldc = LDH; K = 1024; N = 1024; mode = 0;
    } else if (pm == 1) {
      A = (const u16*)(ws + OFF_HY); lda = LDH; W = (const u16*)(ws + OFF_W1) + (size_t)l * 4096 * LDW1; ldb = LDW1;
      C = (u16*)(ws + OFF_HID); ldc = LDHID; K = 1024; N = 4096; mode = 1;
    } else {
      A = (const u16*)(ws + OFF_HID); lda = LDHID; W = (const u16*)(ws + OFF_W2) + (size_t)l * 1024 * LDW2; ldb = LDW2;
      C = (u16*)(ws + OFF_HY); ldc = LDH; K = 4096; N = 1024; mode = 0;
    }
#ifdef PROBE_VARIANT
    if (rep) gemm_plain<PROBE_VARIANT>(A, lda, K, W, ldb, N, C, ldc, mode, smem); else
#endif
    gemm_plain<0>(A, lda, K, W, ldb, N, C, ldc, mode, smem);
  } else if (op == 1) {
    ln_phase(p, ls);
  } else if (!odd) {
    if (k == 0) att_in_phase(p, j, smem);
    else if (k == 1) qkv_phase(p, j, smem);
    else attn_phase(p, j, j + 4 * rep, smem);
  } else {
    if (k == 0) { rec_in_phase(p, j, smem); s5_fill(p, j); }
    else if (k == 1) rec_state_phase(p, j, smem);
    else if (k == 2) scan_phase(p, j, smem);
    else if (k == 3) rec_out_phase(p, j, smem);
    else glu_phase(p, j, smem);
  }
}

__global__ void __launch_bounds__(512, 2) mega_kernel(Params p, int ph0, int ph1) {
  extern __shared__ __attribute__((aligned(16))) char smem[];
  cg::grid_group grid = cg::this_grid();
  __shared__ uint4 xb_words;
  if (threadIdx.x == 0) xb_words = make_uint4(0u, 0u, 0u, 0u);
  __syncthreads();
  XcdBarrier xb = xcd_barrier_post((unsigned*)(p.ws + OFF_BAR), (volatile LAS unsigned*)&xb_words);
  for (int ph = ph0; ph < ph1; ++ph) {
    run_phase(p, ph, smem, 0);
#ifdef PROBE_MASK
    if (ph >= 2 && ((PROBE_MASK >> ((ph - 2) % 18)) & 1)) { xcd_barrier(xb); run_phase(p, ph, smem, 1); }
#endif
    if (ph + 1 < ph1) { if (ph == ph0) grid.sync(); else xcd_barrier(xb); }
  }
}

__global__ void fail_fill(float* out, int n) {
  int i = blockIdx.x * 256 + threadIdx.x;
  if (i < n) out[i] = 0.f;
}

extern "C" void kernel_launch(void* const* d_in, const int* in_sizes, int n_in, void* d_out, int out_size, void* d_ws,
                              size_t ws_size, hipStream_t stream) {
  Params p{};
  const float** fp = (const float**)&p;
  for (int i = 0; i < 27; ++i) fp[i] = (const float*)d_in[i];
  p.out = (float*)d_out;
  p.ws = (char*)d_ws;
  if (ws_size < WS_NEED) {
    fail_fill<<<(out_size + 255) / 256, 256, 0, stream>>>((float*)d_out, out_size);
    return;
  }
  static int grid_blocks = 0;
  if (!grid_blocks) {
    hipFuncSetAttribute((const void*)mega_kernel, hipFuncAttributeMaxDynamicSharedMemorySize, SMEM_BYTES);
    int dev = 0, cus = 0, per_cu = 0;
    hipGetDevice(&dev);
    hipDeviceGetAttribute(&cus, hipDeviceAttributeMultiprocessorCount, dev);
    hipOccupancyMaxActiveBlocksPerMultiprocessor(&per_cu, mega_kernel, NTHR, SMEM_BYTES);
    if (per_cu > 1) per_cu = 1;
    if (per_cu < 1) per_cu = 1;
    grid_blocks = cus * per_cu;
  }
  (void)hipMemsetAsync((char*)d_ws + OFF_BAR, 0, XCD_BAR_WORDS * 4, stream);
  int ph0 = 0, ph1 = NPHASE;
  void* args[] = {&p, &ph0, &ph1};
  hipError_t e = hipLaunchCooperativeKernel((void*)mega_kernel, dim3(grid_blocks), dim3(NTHR), args, SMEM_BYTES, stream);
  if (e != hipSuccess) fprintf(stderr, "cooperative launch failed: %s (grid %d)\n", hipGetErrorString(e), grid_blocks);
}
static_assert(WS_NEED <= (size_t)536870912, "workspace budget exceeded");
```

```cpp
#include <hip/hip_runtime.h>
#include <hip/hip_cooperative_groups.h>
#include <cstdio>
namespace cg = cooperative_groups;

typedef unsigned short u16;
using bf16x8 = __attribute__((ext_vector_type(8))) short;
using f32x16 = __attribute__((ext_vector_type(16))) float;
using u32x4 = __attribute__((ext_vector_type(4))) unsigned;
typedef __attribute__((address_space(3))) unsigned lds_u32;
using f32x4 = __attribute__((ext_vector_type(4))) float;
#define DI __device__ __forceinline__
#define MFMA(a, b, c) __builtin_amdgcn_mfma_f32_32x32x16_bf16((a), (b), (c), 0, 0, 0)

constexpr int T_ = 32768, S_ = 16384;
constexpr float LOG2E = 1.4426950408889634f;
constexpr float DN_ALPHA = 1.6817928305074290f;
constexpr float MLA_QSCALE = 0.10206207261596575f * LOG2E;
constexpr float SWA_QSCALE = 0.125f * LOG2E;
constexpr float RET_KSCALE = 0.08838834764831845f;
constexpr int LDH = 1088, LDHID = 4160, LDW1 = 1088, LDW2 = 4160, LDV = S_ + 64, LDKB = 832, LDZR = 2112, LDYT = 576, LDGLU = 576;

constexpr size_t OFF_MOD = 0;
constexpr size_t OFF_CTR = OFF_MOD + 8 * 2 * 3072 * 4;
constexpr size_t OFF_BAR = OFF_CTR + 256;
constexpr size_t OFF_RT32 = OFF_BAR + 16384;
constexpr size_t OFF_RT64 = OFF_RT32 + (size_t)S_ * 16 * 8;
constexpr size_t OFF_RT128 = OFF_RT64 + (size_t)S_ * 32 * 8;
constexpr size_t OFF_S5Z = OFF_RT128 + (size_t)S_ * 64 * 8;
constexpr size_t OFF_BBAR = OFF_S5Z + 2 * 32 * 64 * 16;
constexpr size_t OFF_KTAB = OFF_BBAR + 2 * 32 * 64 * 16 * 8;
constexpr size_t OFF_W_ATTIN = OFF_KTAB + 2 * 32 * 32 * 256 * 4;
constexpr size_t OFF_W_UQ = OFF_W_ATTIN + (size_t)2 * 1536 * LDW1 * 2;
constexpr size_t OFF_W_UKV = OFF_W_UQ + (size_t)2 * 768 * 384 * 2;
constexpr size_t OFF_W_ATTOUT = OFF_W_UKV + (size_t)2 * 1024 * 256 * 2;
constexpr size_t OFF_W_RECIN = OFF_W_ATTOUT + (size_t)2 * 1024 * LDW1 * 2;
constexpr size_t OFF_W_GLU = OFF_W_RECIN + (size_t)2 * 2560 * LDW1 * 2;
constexpr size_t OFF_W_RECOUT = OFF_W_GLU + (size_t)2 * 512 * LDGLU * 2;
constexpr size_t OFF_W1 = OFF_W_RECOUT + (size_t)2 * 1024 * LDW1 * 2;
constexpr size_t OFF_W2 = OFF_W1 + (size_t)4 * 4096 * LDW1 * 2;
constexpr size_t OFF_WE = OFF_W2 + (size_t)4 * 1024 * LDW2 * 2;
constexpr size_t OFF_WY = OFF_WE + (size_t)32 * 256 * 512 * 2;
constexpr size_t OFF_HY = OFF_WY + (size_t)32 * 512 * 640 * 2;
constexpr size_t OFF_RA = OFF_HY + (size_t)T_ * LDH * 2;
constexpr size_t OFF_ZC = OFF_RA;
constexpr size_t OFF_QB = OFF_ZC + (size_t)T_ * 640 * 2;
constexpr size_t OFF_KB = OFF_QB + (size_t)T_ * 768 * 2;
constexpr size_t OFF_VT = OFF_KB + (size_t)T_ * LDKB * 2;
constexpr size_t OFF_SQ = OFF_VT + (size_t)2 * 8 * 64 * LDV * 2;
constexpr size_t OFF_SK = OFF_SQ + (size_t)T_ * 512 * 2;
constexpr size_t OFF_SV = OFF_SK + (size_t)T_ * 128 * 2;
constexpr size_t OFF_OE = OFF_SV + (size_t)T_ * 128 * 2;
constexpr size_t END_EVEN = OFF_OE + (size_t)T_ * LDH * 2;
constexpr size_t OFF_ZR = OFF_RA;
constexpr size_t OFF_UG = OFF_ZR + (size_t)T_ * LDZR * 2;
constexpr size_t OFF_UO = OFF_UG + (size_t)T_ * 512 * 2;
constexpr size_t OFF_SP = OFF_UO + (size_t)T_ * LDH * 2;
constexpr size_t OFF_EB = OFF_SP + (size_t)T_ * 512 * 2;
constexpr size_t OFF_XP = OFF_EB + (size_t)32 * 1024 * 128 * 4;
constexpr size_t OFF_YT = OFF_HY;
constexpr size_t END_ODD = OFF_XP + (size_t)32 * 1024 * 128 * 2;
constexpr size_t OFF_HID = OFF_RA;
constexpr size_t END_MLP = OFF_HID + (size_t)T_ * LDHID * 2;
constexpr size_t WS_NEED = END_ODD > END_EVEN ? (END_ODD > END_MLP ? END_ODD : END_MLP) : (END_EVEN > END_MLP ? END_EVEN : END_MLP);

constexpr int NTHR = 512;
constexpr int HALF_SMEM = 73728 + 1024;
constexpr int SMEM_GEMM = 131072;
constexpr int SMEM_BYTES = 2 * HALF_SMEM;
constexpr int NPHASE = 38;

struct Params {
  const float *x, *c, *ada_w, *ada_b, *ln_g, *ln_b, *att_w_in, *mla_q_norm, *mla_w_uq, *mla_kv_norm, *mla_w_ukv,
      *swa_sinks, *att_w_out, *rec_w_in, *s5_a_re, *s5_a_im, *s5_log_step, *s5_b_re, *s5_b_im, *s5_c_re, *s5_c_im,
      *s5_d, *s5_glu_w, *s5_glu_b, *rec_w_out, *mlp_w1, *mlp_w2;
  float* out;
  char* ws;
};

#define XB_TMO      128
#define XB_XCNT(j)  (256  + 64 * (j))
#define XB_XSUB(j)  (1280 + 64 * (j))
#define XB_XGEN(j)  (2304 + 64 * (j))
#define XB_TOP      3328
#define XB_TOPGEN   3392
#define XCD_BAR_WORDS 3456
#define XB_SPIN_CAP (1u << 18)
#define LAS __attribute__((address_space(3)))

__device__ __forceinline__ unsigned xb_ld(unsigned* p)              { return __hip_atomic_load(p, __ATOMIC_RELAXED, __HIP_MEMORY_SCOPE_AGENT); }
__device__ __forceinline__ unsigned xb_add(unsigned* p, unsigned v) { return __hip_atomic_fetch_add(p, v, __ATOMIC_RELAXED, __HIP_MEMORY_SCOPE_AGENT); }
__device__ __forceinline__ unsigned xb_xcc_id() { return (unsigned)__builtin_amdgcn_s_getreg((3 << 11) | 20) & 0xFu; }
#define XB_SPIN(cond, bar) do { unsigned _sp = 0; while (cond) { __builtin_amdgcn_s_sleep(1); \
    if ((++_sp & 255u) == 0u) { if (xb_ld(&(bar)[XB_TMO])) break; if (_sp > XB_SPIN_CAP) { atomicAdd(&(bar)[XB_TMO], 1u); break; } } } } while (0)

struct XcdBarrier {
    unsigned* bar; unsigned x;
    volatile LAS unsigned* st;
};

__device__ __forceinline__ XcdBarrier xcd_barrier_post(unsigned* bar, volatile LAS unsigned* st) {
    XcdBarrier b; b.bar = bar; b.x = xb_xcc_id(); b.st = st;
    if (threadIdx.x == 0) (void)xb_add(&bar[XB_XCNT(b.x)], 1u);
    return b;
}
__device__ __forceinline__ void xcd_barrier_complete(unsigned* bar, unsigned x, unsigned& nloc, unsigned& nx) {
    const unsigned G = gridDim.x * gridDim.y * gridDim.z;
    unsigned sum, cnt, mine, sp = 0u;
    for (;;) {
        sum = 0u; cnt = 0u; mine = 0u;
#pragma unroll
        for (unsigned j = 0; j < 16; ++j) { const unsigned c = xb_ld(&bar[XB_XCNT(j)]); sum += c; cnt += (c > 0u) ? 1u : 0u; mine = (j == x) ? c : mine; }
        if (sum == G) break;
        __builtin_amdgcn_s_sleep(1);
        if ((++sp & 255u) == 0u) { if (xb_ld(&bar[XB_TMO])) break; if (sp > XB_SPIN_CAP) { atomicAdd(&bar[XB_TMO], 1u); break; } }
    }
    nloc = mine > 0u ? mine : 1u; nx = cnt > 0u ? cnt : 1u;
}

__device__ __forceinline__ void xcd_barrier(const XcdBarrier& b) {
    asm volatile("s_waitcnt vmcnt(0)" ::: "memory");
    __syncthreads();
    if (threadIdx.x == 0) {
        unsigned* bar = b.bar;
        __builtin_amdgcn_s_waitcnt(0);
        unsigned nloc = b.st[0], nx = b.st[1];
        if (nloc == 0u) { xcd_barrier_complete(bar, b.x, nloc, nx); b.st[0] = nloc; b.st[1] = nx; }
        const unsigned old = xb_add(&bar[XB_XSUB(b.x)], 1u);
        const unsigned gen = old / nloc;
        if (old + 1u == (gen + 1u) * nloc) {
            __builtin_amdgcn_fence(__ATOMIC_RELEASE, "agent");
            asm volatile("s_waitcnt vmcnt(0)" ::: "memory");
            const unsigned og = xb_add(&bar[XB_TOP], 1u);
            const unsigned tg = og / nx;
            if (og + 1u == (tg + 1u) * nx) xb_add(&bar[XB_TOPGEN], 1u);
            else XB_SPIN(xb_ld(&bar[XB_TOPGEN]) == tg, bar);
            __builtin_amdgcn_fence(__ATOMIC_ACQUIRE, "agent");
            xb_add(&bar[XB_XGEN(b.x)], 1u);
            asm volatile("s_waitcnt vmcnt(0)" ::: "memory");
        } else {
            XB_SPIN(xb_ld(&bar[XB_XGEN(b.x)]) == gen, bar);
            __builtin_amdgcn_fence(__ATOMIC_ACQUIRE, "agent");
            asm volatile("s_waitcnt vmcnt(0)" ::: "memory");
        }
    }
    __syncthreads();
}


typedef __bf16 bf2_t __attribute__((ext_vector_type(2)));
typedef float f2_t __attribute__((ext_vector_type(2)));
DI u16 f2bf(float x) { __bf16 r = (__bf16)x; return __builtin_bit_cast(u16, r); }
DI float bf2f(unsigned h) { return __uint_as_float(h << 16); }
DI unsigned pack2(float a, float b) { f2_t v = {a, b}; bf2_t r = __builtin_convertvector(v, bf2_t); return __builtin_bit_cast(unsigned, r); }
DI int crow(int r, int hf) { return (r & 3) + 8 * (r >> 2) + 4 * hf; }
DI float ex2(float x) { return __builtin_amdgcn_exp2f(x); }
DI bf16x8 pack8(const f32x16& x, int s) {
  uint4 u;
  u.x = pack2(x[8 * s + 0], x[8 * s + 1]); u.y = pack2(x[8 * s + 2], x[8 * s + 3]);
  u.z = pack2(x[8 * s + 4], x[8 * s + 5]); u.w = pack2(x[8 * s + 6], x[8 * s + 7]);
  return __builtin_bit_cast(bf16x8, u);
}
DI bf16x8 join8(uint2 lo, uint2 hi) { uint4 u = make_uint4(lo.x, lo.y, hi.x, hi.y); return __builtin_bit_cast(bf16x8, u); }
DI f32x16 zero16() { f32x16 z; for (int i = 0; i < 16; ++i) z[i] = 0.f; return z; }
DI int opqv(int x) { asm volatile("" : "+v"(x)); return x; }
DI char* opq(char* p) { asm volatile("" : "+s"(p)); return p; }
DI void sincos_(float x, float& sn, float& cs) { float s_, c_; sincosf(x, &s_, &c_); sn = s_; cs = c_; }
DI float lg2gamma(int h) { return log2f(1.0f - exp2f(-5.0f - (float)h)); }

template <int V = 0, class Epi>
DI void gemm_tile(const u16* A1, long lda1, int nk1, const u16* A2, long lda2, int nk2, const u16* Bt, long ldb,
                  char* smem, Epi&& epi) {
  const int tid = opqv(threadIdx.x), lane = tid & 63, w = tid >> 6, wm = w >> 2, wn = w & 3, l32 = lane & 31, hf = lane >> 5;
  f32x16 acc[2][2][2];
#pragma unroll
  for (int h = 0; h < 2; ++h)
#pragma unroll
    for (int i = 0; i < 2; ++i)
#pragma unroll
      for (int j = 0; j < 2; ++j) acc[h][i][j] = zero16();
  const int nk = nk1 + nk2;
  const int drow = lane >> 3, dslot = lane & 7, x7 = (l32 >> 1) & 7;
#define GLDS(KT, BUF) { const int kt_ = (KT); const u16* Ab; long lda; \
    if (kt_ < nk1) { Ab = A1 + kt_ * 64; lda = lda1; } else { Ab = A2 + (kt_ - nk1) * 64; lda = lda2; } \
    _Pragma("unroll") for (int q = 0; q < 4; ++q) { \
      const int r = (w * 4 + q) * 8 + drow; const int c = dslot ^ ((r >> 1) & 7); \
      __builtin_amdgcn_global_load_lds((const unsigned*)(Ab + (long)r * lda + c * 8), (lds_u32*)(smem + (BUF) * 65536 + (w * 4 + q) * 1024), 16, 0, 0); \
      __builtin_amdgcn_global_load_lds((const unsigned*)(Bt + (long)r * ldb + kt_ * 64 + c * 8), (lds_u32*)(smem + (BUF) * 65536 + 32768 + (w * 4 + q) * 1024), 16, 0, 0); } }
#define LFR(AF, BF, BUF, S0) { const char* a = smem + (BUF) * 65536; const char* b = a + 32768; \
    _Pragma("unroll") for (int i = 0; i < 4; ++i) AF[i] = *(const bf16x8*)(a + (wm * 128 + i * 32 + l32) * 128 + (((2 * (S0) + hf) ^ x7) << 4)); \
    _Pragma("unroll") for (int j = 0; j < 2; ++j) BF[j] = *(const bf16x8*)(b + (wn * 64 + j * 32 + l32) * 128 + (((2 * (S0) + hf) ^ x7) << 4)); }
#define MMA8(AF, BF) { \
    _Pragma("unroll") for (int i = 0; i < 4; ++i) \
      _Pragma("unroll") for (int j = 0; j < 2; ++j) acc[i >> 1][i & 1][j] = MFMA(AF[i], BF[j], acc[i >> 1][i & 1][j]); }
#define COMPUTE(BUF) { bf16x8 af0[4], bf0[2], af1[4], bf1[2]; \
    LFR(af0, bf0, BUF, 0); __builtin_amdgcn_sched_barrier(0); \
    LFR(af1, bf1, BUF, 1); MMA8(af0, bf0); __builtin_amdgcn_sched_barrier(0); \
    LFR(af0, bf0, BUF, 2); MMA8(af1, bf1); __builtin_amdgcn_sched_barrier(0); \
    LFR(af1, bf1, BUF, 3); MMA8(af0, bf0); __builtin_amdgcn_sched_barrier(0); \
    MMA8(af1, bf1); __builtin_amdgcn_sched_barrier(0); }
#define RAWBAR() { asm volatile("s_waitcnt vmcnt(0) lgkmcnt(0)" ::: "memory"); __builtin_amdgcn_s_barrier(); }
  if (V != 1) GLDS(0, 0);
  RAWBAR();
  for (int kt = 0; kt < nk; kt += 2) {
    if (V != 1) GLDS(kt + 1, 1);
    if (V != 2) COMPUTE(0);
    RAWBAR();
    if (V != 1) if (kt + 2 < nk) GLDS(kt + 2, 0);
    if (V != 2) COMPUTE(1);
    RAWBAR();
  }
#undef GLDS
#undef LFR
#undef MMA8
#undef COMPUTE
#undef RAWBAR
  epi(acc[0], wm * 64);
  epi(acc[1], wm * 64 + 64);
}

DI void tile_map(int lt, int nM8, int nN, int GM, int GN, int& mt, int& nt) {
  const int G = GM * GN, xcd = blockIdx.x & 7, group = lt / G, within = lt - group * G, ngn = nN / GN;
  const int mg = group / ngn, ng = group - mg * ngn;
  mt = xcd * nM8 + mg * GM + within / GN;
  nt = ng * GN + within % GN;
}

DI int colmap(int mode, int n) {
  if (mode == 1) { if (n < 640) return n; if (n < 1408) return n + 32; if (n < 1440) return n - 1408 + 640; return -1; }
  if (mode == 2) { if (n < 512) return (n >> 6) * 96 + (n & 63); int m = n - 512; return (m >> 5) * 96 + 64 + (m & 31); }
  if (mode == 3) { if (n < 1024) { int dl = n & 127, b4 = dl >> 5; int sb = (b4 == 1) ? 2 : (b4 == 2 ? 1 : b4); return (n & ~127) + sb * 32 + (dl & 31); } return n; }
  return n;
}
DI void conv_job(const float* src, int K, int N, u16* dst, int ldk, int Npad, const float* kscale, int mode, float* lds) {
  const int tid = opqv(threadIdx.x);
  const int nKt = K / 64, nNt = Npad / 64;
  for (int tile = blockIdx.x; tile < nKt * nNt; tile += gridDim.x) {
    const int nt = tile / nKt, kt = tile % nKt;
    const int nl = tid & 63, kq = tid >> 6;
    const int col = colmap(mode, nt * 64 + nl);
    for (int i = 0; i < 8; ++i) {
      const int kl = kq + 8 * i, k = kt * 64 + kl;
      float v = 0.f;
      if (col >= 0) { v = src[(size_t)k * N + col]; if (kscale) v *= kscale[k]; }
      lds[kl * 65 + nl] = v;
    }
    __syncthreads();
    for (int i = 0; i < 8; ++i) {
      const int n2 = kq + 8 * i;
      dst[(size_t)(nt * 64 + n2) * ldk + kt * 64 + nl] = f2bf(lds[nl * 65 + n2]);
    }
    __syncthreads();
  }
}

DI void phase0(const Params& p, char* smem) {
  const int tid = opqv(threadIdx.x), nb = gridDim.x, bid = blockIdx.x;
  char* ws = opq(p.ws);
  if (bid == 0 && tid < 64) ((int*)(ws + OFF_CTR))[tid] = 0;
  {
    float* cond = (float*)smem; float* red = cond + 2048; float* mod = (float*)(ws + OFF_MOD);
    for (int i = tid; i < 2048; i += NTHR) { float v = p.c[i]; cond[i] = v / (1.f + expf(-v)); }
    __syncthreads();
    for (int it = bid; it < 8 * 48; it += nb) {
      const int ls = it / 48, cgp = it % 48, tx = tid & 15, ty = tid >> 4;
      const float* wp = p.ada_w + (size_t)ls * 1024 * 3072 + cgp * 64 + tx * 4;
      float4 a0 = make_float4(0, 0, 0, 0), a1 = make_float4(0, 0, 0, 0);
      for (int k = ty * 32; k < ty * 32 + 32; ++k) {
        const float4 wv = *(const float4*)(wp + (size_t)k * 3072);
        const float c0 = cond[k], c1 = cond[1024 + k];
        a0.x += c0 * wv.x; a0.y += c0 * wv.y; a0.z += c0 * wv.z; a0.w += c0 * wv.w;
        a1.x += c1 * wv.x; a1.y += c1 * wv.y; a1.z += c1 * wv.z; a1.w += c1 * wv.w;
      }
      *(float4*)(red + (ty * 2 + 0) * 64 + tx * 4) = a0;
      *(float4*)(red + (ty * 2 + 1) * 64 + tx * 4) = a1;
      __syncthreads();
      if (tid < 128) {
        const int b = tid >> 6, col = tid & 63; float s = 0.f;
        for (int y = 0; y < 32; ++y) s += red[(y * 2 + b) * 64 + col];
        const int j = cgp * 64 + col;
        mod[(ls * 2 + b) * 3072 + j] = s + p.ada_b[ls * 3072 + j];
      }
      __syncthreads();
    }
  }
  {
    float* lds = (float*)smem;
    for (int j = 0; j < 2; ++j) {
      conv_job(p.att_w_in + (size_t)j * 1024 * 1440, 1024, 1440, (u16*)(ws + OFF_W_ATTIN) + (size_t)j * 1536 * LDW1, LDW1, 1536, nullptr, 1, lds);
      conv_job(p.mla_w_uq + (size_t)j * 384 * 768, 384, 768, (u16*)(ws + OFF_W_UQ) + (size_t)j * 768 * 384, 384, 768, p.mla_q_norm + j * 384, 2, lds);
      conv_job(p.mla_w_ukv + (size_t)j * 256 * 1024, 256, 1024, (u16*)(ws + OFF_W_UKV) + (size_t)j * 1024 * 256, 256, 1024, p.mla_kv_norm + j * 256, 0, lds);
      conv_job(p.att_w_out + (size_t)j * 1024 * 1024, 1024, 1024, (u16*)(ws + OFF_W_ATTOUT) + (size_t)j * 1024 * LDW1, LDW1, 1024, nullptr, 0, lds);
      conv_job(p.rec_w_in + (size_t)j * 1024 * 2560, 1024, 2560, (u16*)(ws + OFF_W_RECIN) + (size_t)j * 2560 * LDW1, LDW1, 2560, nullptr, 3, lds);
      conv_job(p.s5_glu_w + (size_t)j * 512 * 512, 512, 512, (u16*)(ws + OFF_W_GLU) + (size_t)j * 512 * LDGLU, LDGLU, 512, nullptr, 0, lds);
      conv_job(p.rec_w_out + (size_t)j * 1024 * 1024, 1024, 1024, (u16*)(ws + OFF_W_RECOUT) + (size_t)j * 1024 * LDW1, LDW1, 1024, nullptr, 0, lds);
    }
    for (int l = 0; l < 4; ++l) {
      conv_job(p.mlp_w1 + (size_t)l * 1024 * 4096, 1024, 4096, (u16*)(ws + OFF_W1) + (size_t)l * 4096 * LDW1, LDW1, 4096, nullptr, 0, lds);
      conv_job(p.mlp_w2 + (size_t)l * 4096 * 1024, 4096, 1024, (u16*)(ws + OFF_W2) + (size_t)l * 1024 * LDW2, LDW2, 1024, nullptr, 0, lds);
    }
  }
  {
    float2* rt32 = (float2*)(ws + OFF_RT32); float2* rt64 = (float2*)(ws + OFF_RT64); float2* rt128 = (float2*)(ws + OFF_RT128);
    for (int idx = bid * NTHR + tid; idx < S_ * 112; idx += nb * NTHR) {
      const int s = idx / 112, r = idx % 112;
      int dim, i; float2* dst;
      if (r < 16) { dim = 32; i = r; dst = rt32 + s * 16 + i; }
      else if (r < 48) { dim = 64; i = r - 16; dst = rt64 + s * 32 + i; }
      else { dim = 128; i = r - 48; dst = rt128 + s * 64 + i; }
      const float inv = powf(10000.0f, -((float)(2 * i)) / (float)dim);
      const float ang = (float)s * inv;
      float sn_, cs_; sincos_(ang, sn_, cs_);
      *dst = make_float2(cs_, sn_);
    }
  }
  {
    float4* s5z = (float4*)(ws + OFF_S5Z); float2* bbar = (float2*)(ws + OFF_BBAR);
    for (int idx = bid * NTHR + tid; idx < 2 * 32 * 64; idx += nb * NTHR) {
      const int jg = idx >> 6;
      const float dt = expf(p.s5_log_step[jg]);
      const float lr = p.s5_a_re[idx], li = p.s5_a_im[idx];
      const float zr = lr * dt, zi = li * dt, mag = expf(zr);
      float sn_, cs_; sincos_(zi, sn_, cs_);
      const float ar = mag * cs_, ai = mag * sn_;
      const float den = lr * lr + li * li;
      const float cr = ((ar - 1.f) * lr + ai * li) / den, ci = (ai * lr - (ar - 1.f) * li) / den;
      s5z[idx] = make_float4(zr, zi, ar, ai);
      for (int q = 0; q < 16; ++q) {
        const float br = p.s5_b_re[idx * 16 + q], bi = p.s5_b_im[idx * 16 + q];
        bbar[idx * 16 + q] = make_float2(cr * br - ci * bi, cr * bi + ci * br);
      }
    }
  }
}

DI void phase1(const Params& p) {
  const int tid = opqv(threadIdx.x), nb = gridDim.x, bid = blockIdx.x;
  char* ws = opq(p.ws);
  const float* mod = (const float*)(ws + OFF_MOD);
  u16* hy = (u16*)(ws + OFF_HY);
  for (int i = bid * NTHR + tid; i < T_ * 256; i += nb * NTHR) {
    const int t = i >> 8, c4 = (i & 255) * 4, b = t >> 14;
    const float4 xv = *(const float4*)(p.x + (size_t)i * 4);
    const float4 sh = *(const float4*)(mod + b * 3072 + c4);
    const float4 sc = *(const float4*)(mod + b * 3072 + 1024 + c4);
    uint2 o;
    o.x = pack2(xv.x * (1.f + sc.x) + sh.x, xv.y * (1.f + sc.y) + sh.y);
    o.y = pack2(xv.z * (1.f + sc.z) + sh.z, xv.w * (1.f + sc.w) + sh.w);
    *(uint2*)(hy + (size_t)t * LDH + c4) = o;
  }
  const float4* s5z = (const float4*)(ws + OFF_S5Z); const float2* bbar = (const float2*)(ws + OFF_BBAR);
  float* ktab = (float*)(ws + OFF_KTAB);
  for (int idx8 = bid * NTHR + tid; idx8 < 2 * 32 * 256 * 8; idx8 += nb * NTHR) {
    const int part = idx8 & 7, idx = idx8 >> 3;
    const int q = idx & 15, pp = (idx >> 4) & 15, jg = idx >> 8;
    float acc[32];
#pragma unroll
    for (int d = 0; d < 32; ++d) acc[d] = 0.f;
    for (int n = part * 8; n < part * 8 + 8; ++n) {
      const float4 z = s5z[jg * 64 + n];
      const float2 bb = bbar[(jg * 64 + n) * 16 + q];
      const float cr = p.s5_c_re[(jg * 16 + pp) * 64 + n], ci = p.s5_c_im[(jg * 16 + pp) * 64 + n];
      const float wr = cr * bb.x - ci * bb.y, wi = cr * bb.y + ci * bb.x;
      float er = 1.f, ei = 0.f;
#pragma unroll
      for (int d = 0; d < 32; ++d) {
        acc[d] += wr * er - wi * ei;
        const float nr = er * z.z - ei * z.w, ni = er * z.w + ei * z.z;
        er = nr; ei = ni;
      }
    }
#pragma unroll
    for (int d = 0; d < 32; ++d) {
      float a = acc[d];
      a += __shfl_xor(a, 1); a += __shfl_xor(a, 2); a += __shfl_xor(a, 4);
      if (part == 0) ktab[(jg * 32 + d) * 256 + pp * 16 + q] = a;
    }
  }
}

DI void ln_phase(const Params& p, int ls) {
  const int tid = opqv(threadIdx.x), lane = tid & 63, w = tid >> 6;
  char* ws = opq(p.ws);
  const float* mod = (const float*)(ws + OFF_MOD);
  u16* hy = (u16*)(ws + OFF_HY);
  const float* xin = (ls == 0) ? p.x : p.out;
  const float* lg = p.ln_g + ls * 1024; const float* lb = p.ln_b + ls * 1024;
  const int stride = gridDim.x * 8;
  f32x4 xc[4], xn[4]; uint2 yc[4], yn[4];
  {
    const int row = blockIdx.x * 8 + w;
#pragma unroll
    for (int i = 0; i < 4; ++i) {
      const int col = lane * 4 + 256 * i;
      xc[i] = __builtin_nontemporal_load((const f32x4*)(xin + (size_t)row * 1024 + col));
      yc[i] = *(const uint2*)(hy + (size_t)row * LDH + col);
    }
  }
  for (int row = blockIdx.x * 8 + w; row < T_; row += stride) {
    const int b = row >> 14;
    const float* gate = mod + (ls * 2 + b) * 3072 + 2048;
    const int rn = row + stride;
    if (rn < T_) {
#pragma unroll
      for (int i = 0; i < 4; ++i) {
        const int col = lane * 4 + 256 * i;
        xn[i] = __builtin_nontemporal_load((const f32x4*)(xin + (size_t)rn * 1024 + col));
        yn[i] = *(const uint2*)(hy + (size_t)rn * LDH + col);
      }
    }
    float v[16];
    float sum = 0.f;
#pragma unroll
    for (int i = 0; i < 4; ++i) {
      const int col = lane * 4 + 256 * i;
      const f32x4 xv = xc[i];
      const uint2 yv = yc[i];
      const float4 g = *(const float4*)(gate + col);
      v[4 * i + 0] = DN_ALPHA * xv.x + (1.f + g.x) * bf2f(yv.x & 0xffffu);
      v[4 * i + 1] = DN_ALPHA * xv.y + (1.f + g.y) * bf2f(yv.x >> 16);
      v[4 * i + 2] = DN_ALPHA * xv.z + (1.f + g.z) * bf2f(yv.y & 0xffffu);
      v[4 * i + 3] = DN_ALPHA * xv.w + (1.f + g.w) * bf2f(yv.y >> 16);
      sum += v[4 * i] + v[4 * i + 1] + v[4 * i + 2] + v[4 * i + 3];
    }
#pragma unroll
    for (int m = 32; m >= 1; m >>= 1) sum += __shfl_xor(sum, m);
    const float mean = sum * (1.f / 1024.f);
    float vs = 0.f;
#pragma unroll
    for (int i = 0; i < 16; ++i) { const float d = v[i] - mean; vs += d * d; }
#pragma unroll
    for (int m = 32; m >= 1; m >>= 1) vs += __shfl_xor(vs, m);
    const float rstd = rsqrtf(vs * (1.f / 1024.f) + 1e-5f);
#pragma unroll
    for (int i = 0; i < 4; ++i) {
      const int col = lane * 4 + 256 * i;
      const float4 g = *(const float4*)(lg + col); const float4 bb = *(const float4*)(lb + col);
      float4 o;
      o.x = (v[4 * i + 0] - mean) * rstd * g.x + bb.x; o.y = (v[4 * i + 1] - mean) * rstd * g.y + bb.y;
      o.z = (v[4 * i + 2] - mean) * rstd * g.z + bb.z; o.w = (v[4 * i + 3] - mean) * rstd * g.w + bb.w;
      { f32x4 ov = {o.x, o.y, o.z, o.w}; __builtin_nontemporal_store(ov, (f32x4*)(p.out + (size_t)row * 1024 + col)); }
      if (ls < 7) {
        const float* m2 = mod + ((ls + 1) * 2 + b) * 3072;
        const float4 sh = *(const float4*)(m2 + col); const float4 sc = *(const float4*)(m2 + 1024 + col);
        uint2 h;
        h.x = pack2(o.x * (1.f + sc.x) + sh.x, o.y * (1.f + sc.y) + sh.y);
        h.y = pack2(o.z * (1.f + sc.z) + sh.z, o.w * (1.f + sc.w) + sh.w);
        *(uint2*)(hy + (size_t)row * LDH + col) = h;
      }
    }
#pragma unroll
    for (int i = 0; i < 4; ++i) { xc[i] = xn[i]; yc[i] = yn[i]; }
  }
}

template <int V = 0>
DI void gemm_plain(const u16* A, int lda, int K, const u16* Wt, int ldb, int N, u16* C, int ldc, int mode, char* smem) {
  const int tid = opqv(threadIdx.x), lane = tid & 63, w = tid >> 6, wm = w >> 2, wn = w & 3, l32 = lane & 31, hf = lane >> 5;
  const int nN = N / 256;
  for (int lt = blockIdx.x >> 3; lt < 16 * nN; lt += gridDim.x >> 3) {
    int mt, nt; tile_map(lt, 16, nN, 8, 4, mt, nt);
    const int m0 = mt * 256, n0 = nt * 256;
    gemm_tile<V>(A + (size_t)m0 * lda, lda, K / 64, nullptr, 0, 0, Wt + (size_t)n0 * ldb, ldb, smem, [&](f32x16(&acc)[2][2], int moff) {
      const int m0_ = m0 + moff;
      int l32_ = l32, hf_ = hf; asm volatile("" : "+v"(l32_), "+v"(hf_));
#pragma unroll
      for (int i = 0; i < 2; ++i)
#pragma unroll
        for (int j = 0; j < 2; ++j)
#pragma unroll
          for (int r = 0; r < 16; ++r) {
            const int row = m0_ + wm * 64 + i * 32 + crow(r, hf_), col = n0 + wn * 64 + j * 32 + l32_;
            float v = acc[i][j][r];
            if (mode == 1) { v = fmaxf(v, 0.f); v = v * v; }
            if (V == 0 || v == 123456.789f) C[(size_t)row * ldc + col] = f2bf(v);
          }
    });
  }
}

DI void att_in_phase(const Params& p, int j, char* smem) {
  const int tid = opqv(threadIdx.x), lane = tid & 63, w = tid >> 6, wm = w >> 2, wn = w & 3, l32 = lane & 31, hf = lane >> 5;
  char* ws = opq(p.ws);
  const u16* A = (const u16*)(ws + OFF_HY);
  const u16* Wt = (const u16*)(ws + OFF_W_ATTIN) + (size_t)j * 1536 * LDW1;
  u16* zc = (u16*)(ws + OFF_ZC); u16* SQ = (u16*)(ws + OFF_SQ); u16* SK = (u16*)(ws + OFF_SK); u16* SV = (u16*)(ws + OFF_SV);
  u16* Kb = (u16*)(ws + OFF_KB);
  const float2* rt64 = (const float2*)(ws + OFF_RT64); const float2* rt32 = (const float2*)(ws + OFF_RT32);
  const int nN = 6;
  for (int lt = blockIdx.x >> 3; lt < 16 * nN; lt += gridDim.x >> 3) {
    int mt, nt; tile_map(lt, 16, nN, 16, 2, mt, nt);
    const int m0 = mt * 256, n0 = nt * 256;
    gemm_tile(A + (size_t)m0 * LDH, LDH, 16, nullptr, 0, 0, Wt + (size_t)n0 * LDW1, LDW1, smem, [&](f32x16(&acc)[2][2], int moff) {
      const int m0_ = m0 + moff;
      int l32_ = l32, hf_ = hf; asm volatile("" : "+v"(l32_), "+v"(hf_));
      const int C64 = n0 + wn * 64;
#pragma unroll
      for (int i = 0; i < 2; ++i) {
        const int rb = m0_ + wm * 64 + i * 32;
        if (C64 < 640) {
#pragma unroll
          for (int jn = 0; jn < 2; ++jn)
#pragma unroll
            for (int r = 0; r < 16; ++r) zc[(size_t)(rb + crow(r, hf_)) * 640 + C64 + jn * 32 + l32_] = f2bf(acc[i][jn][r]);
        } else if (C64 < 1280) {
          const bool isq = C64 < 1152;
          u16* dst = isq ? SQ : SK; const int pitch = isq ? 512 : 128; const int cb = isq ? (C64 - 640) : (C64 - 1152);
          const float sc = isq ? SWA_QSCALE : 1.f;
#pragma unroll
          for (int r = 0; r < 16; ++r) {
            const int t = rb + crow(r, hf_), pos = t & (S_ - 1);
            const float2 cs = rt64[pos * 32 + l32_];
            const float x1 = acc[i][0][r], x2 = acc[i][1][r];
            dst[(size_t)t * pitch + cb + l32_] = f2bf((x1 * cs.x - x2 * cs.y) * sc);
            dst[(size_t)t * pitch + cb + 32 + l32_] = f2bf((x2 * cs.x + x1 * cs.y) * sc);
          }
        } else if (C64 < 1408) {
#pragma unroll
          for (int jn = 0; jn < 2; ++jn)
#pragma unroll
            for (int r = 0; r < 16; ++r) SV[(size_t)(rb + crow(r, hf_)) * 128 + (C64 - 1280) + jn * 32 + l32_] = f2bf(acc[i][jn][r]);
        } else if (C64 == 1408) {
#pragma unroll
          for (int r = 0; r < 16; ++r) {
            const int t = rb + crow(r, hf_), pos = t & (S_ - 1);
            const float x = acc[i][0][r];
            const float xp = __shfl_xor(x, 16);
            const float2 cs = rt32[pos * 16 + (l32_ & 15)];
            const float o = (l32_ < 16) ? (x * cs.x - xp * cs.y) : (x * cs.x + xp * cs.y);
            const u16 v = f2bf(o);
#pragma unroll
            for (int h = 0; h < 8; ++h) Kb[(size_t)t * LDKB + h * 96 + 64 + l32_] = v;
          }
        }
      }
    });
  }
}

DI void qkv_phase(const Params& p, int j, char* smem) {
  const int tid = opqv(threadIdx.x), lane = tid & 63, w = tid >> 6, wm = w >> 2, wn = w & 3, l32 = lane & 31, hf = lane >> 5;
  char* ws = opq(p.ws);
  const u16* zc = (const u16*)(ws + OFF_ZC);
  const u16* Wq = (const u16*)(ws + OFF_W_UQ) + (size_t)j * 768 * 384;
  const u16* Wkv = (const u16*)(ws + OFF_W_UKV) + (size_t)j * 1024 * 256;
  u16* Qb = (u16*)(ws + OFF_QB); u16* Kb = (u16*)(ws + OFF_KB); u16* Vt = (u16*)(ws + OFF_VT);
  const float2* rt32 = (const float2*)(ws + OFF_RT32);
  float* rsc = (float*)(smem + SMEM_GEMM);
  for (int lt0 = blockIdx.x >> 3; lt0 < 16 * 7; lt0 += gridDim.x >> 3) {
    const bool isq = lt0 < 16 * 3;
    int mt, nt;
    if (isq) tile_map(lt0, 16, 3, 16, 1, mt, nt); else tile_map(lt0 - 16 * 3, 16, 4, 8, 4, mt, nt);
    const int m0 = mt * 256, n0 = nt * 256;
    const int coff = isq ? 0 : 384, ncols = isq ? 384 : 256;
    {
      const int row = tid >> 1, half = tid & 1, nh = ncols / 2;
      const u16* src = zc + (size_t)(m0 + row) * 640 + coff + half * nh;
      float s = 0.f;
      for (int c = 0; c < nh; c += 8) {
        const uint4 v = *(const uint4*)(src + c);
        float f;
        f = bf2f(v.x & 0xffffu); s += f * f; f = bf2f(v.x >> 16); s += f * f;
        f = bf2f(v.y & 0xffffu); s += f * f; f = bf2f(v.y >> 16); s += f * f;
        f = bf2f(v.z & 0xffffu); s += f * f; f = bf2f(v.z >> 16); s += f * f;
        f = bf2f(v.w & 0xffffu); s += f * f; f = bf2f(v.w >> 16); s += f * f;
      }
      s += __shfl_xor(s, 1);
      if (half == 0) rsc[row] = rsqrtf(s / (float)ncols + 1e-6f);
    }
    __syncthreads();
    if (isq) {
      gemm_tile(zc + (size_t)m0 * 640, 640, 6, nullptr, 0, 0, Wq + (size_t)n0 * 384, 384, smem, [&](f32x16(&acc)[2][2], int moff) {
      const int m0_ = m0 + moff;
      int l32_ = l32, hf_ = hf; asm volatile("" : "+v"(l32_), "+v"(hf_));
        const int C64 = n0 + wn * 64;
#pragma unroll
        for (int i = 0; i < 2; ++i) {
          const int rl = wm * 64 + i * 32;
#pragma unroll
          for (int jn = 0; jn < 2; ++jn)
#pragma unroll
            for (int r = 0; r < 16; ++r) {
              const int rr = rl + crow(r, hf_), t = m0_ + rr;
              const float x = acc[i][jn][r] * rsc[moff + rr] * MLA_QSCALE;
              if (C64 < 512) {
                Qb[(size_t)t * 768 + (C64 >> 6) * 96 + jn * 32 + l32_] = f2bf(x);
              } else {
                const int hq = ((C64 - 512) >> 5) + jn, pos = t & (S_ - 1);
                const float xp = __shfl_xor(x, 16);
                const float2 cs = rt32[pos * 16 + (l32_ & 15)];
                const float o = (l32_ < 16) ? (x * cs.x - xp * cs.y) : (x * cs.x + xp * cs.y);
                Qb[(size_t)t * 768 + hq * 96 + 64 + l32_] = f2bf(o);
              }
            }
        }
      });
    } else {
      gemm_tile(zc + (size_t)m0 * 640 + 384, 640, 4, nullptr, 0, 0, Wkv + (size_t)n0 * 256, 256, smem, [&](f32x16(&acc)[2][2], int moff) {
      const int m0_ = m0 + moff;
      int l32_ = l32, hf_ = hf; asm volatile("" : "+v"(l32_), "+v"(hf_));
        const int C64 = n0 + wn * 64, h = C64 >> 7, part = (C64 >> 6) & 1;
#pragma unroll
        for (int i = 0; i < 2; ++i) {
          const int rl = wm * 64 + i * 32;
#pragma unroll
          for (int jn = 0; jn < 2; ++jn) {
            if (part == 0) {
#pragma unroll
              for (int r = 0; r < 16; ++r) {
                const int rr = rl + crow(r, hf_), t = m0_ + rr;
                Kb[(size_t)t * LDKB + h * 96 + jn * 32 + l32_] = f2bf(acc[i][jn][r] * rsc[moff + rr]);
              }
            } else {
              const int e = jn * 32 + l32_;
#pragma unroll
              for (int qd = 0; qd < 4; ++qd) {
                const int rr = rl + 8 * qd + 4 * hf_, t0 = m0_ + rr, b = t0 >> 14, s0 = t0 & (S_ - 1);
                uint2 o;
                o.x = pack2(acc[i][jn][4 * qd + 0] * rsc[moff + rr + 0], acc[i][jn][4 * qd + 1] * rsc[moff + rr + 1]);
                o.y = pack2(acc[i][jn][4 * qd + 2] * rsc[moff + rr + 2], acc[i][jn][4 * qd + 3] * rsc[moff + rr + 3]);
                *(uint2*)(Vt + ((size_t)((b * 8 + h) * 64 + e)) * LDV + s0) = o;
              }
            }
          }
        }
      });
    }
    __syncthreads();
  }
}

constexpr int MLA_BUF = 64 * 208 + 64 * 136;
constexpr int MLA_SVP = 264;
constexpr int MLA_BUF2 = 128 * 208 + 64 * MLA_SVP;
DI void mla_item(const Params& p, int qb, int b, int h, char* smem) {
  const int tid = opqv(threadIdx.x), lane = tid & 63, w = tid >> 6, l32 = lane & 31, hf = lane >> 5;
  char* ws = opq(p.ws);
  const u16* Qb = (const u16*)(ws + OFF_QB); u16* o = (u16*)(ws + OFF_OE);
  const int q0 = qb * 256 + w * 32;
  const size_t tq = (size_t)b * S_ + q0 + l32;
  bf16x8 qf[6];
#pragma unroll
  for (int s = 0; s < 6; ++s) qf[s] = *(const bf16x8*)(Qb + tq * 768 + h * 96 + s * 16 + hf * 8);
  f32x16 ot[2]; ot[0] = zero16(); ot[1] = zero16();
  float m = -1e30f, l = 0.f;
  const int ntile = 2 * qb + 2;
  const u16* Kg = (const u16*)(ws + OFF_KB) + ((size_t)b * S_) * LDKB + h * 96;
  const u16* Vg = (const u16*)(ws + OFF_VT) + ((size_t)(b * 8 + h) * 64) * LDV;
  u32x4 rk[2][3], rv[2][2];
#define MGLOAD(SET, KT) { const int kt_ = (KT); \
    _Pragma("unroll") for (int i = 0; i < 3; ++i) { const int c = tid + 512 * i, row = c / 12, ch = c % 12; rk[SET][i] = *(const u32x4*)(Kg + (size_t)(kt_ * 128 + row) * LDKB + ch * 8); } \
    _Pragma("unroll") for (int i = 0; i < 2; ++i) { const int c = tid + 512 * i, row = c >> 4, ch = c & 15; rv[SET][i] = *(const u32x4*)(Vg + (size_t)row * LDV + kt_ * 128 + ch * 8); } }
#define MSWRITE(SET, BUF) { char* sk_ = smem + (BUF) * MLA_BUF2; char* sv_ = sk_ + 128 * 208; \
    _Pragma("unroll") for (int i = 0; i < 3; ++i) { const int c = tid + 512 * i, row = c / 12, ch = c % 12; *(u32x4*)(sk_ + row * 208 + ch * 16) = rk[SET][i]; } \
    _Pragma("unroll") for (int i = 0; i < 2; ++i) { const int c = tid + 512 * i, row = c >> 4, ch = c & 15; \
      *(uint2*)(sv_ + row * MLA_SVP + ch * 16) = make_uint2(rv[SET][i].x, rv[SET][i].y); \
      *(uint2*)(sv_ + row * MLA_SVP + ch * 16 + 8) = make_uint2(rv[SET][i].z, rv[SET][i].w); } }
  auto compute = [&](int kt, int sub) {
    const char* sk = smem + (kt & 1) * MLA_BUF2 + sub * (64 * 208); const char* sv = smem + (kt & 1) * MLA_BUF2 + 128 * 208 + sub * 128;
    const int k0 = kt * 128 + sub * 64;
    if (k0 <= q0 + 31) {
      f32x16 st[2];
      bf16x8 kf[2][6];
#pragma unroll
      for (int t32 = 0; t32 < 2; ++t32)
#pragma unroll
        for (int s = 0; s < 6; ++s) kf[t32][s] = *(const bf16x8*)(sk + (t32 * 32 + l32) * 208 + (s * 16 + hf * 8) * 2);
      __builtin_amdgcn_sched_barrier(0);
      __builtin_amdgcn_s_setprio(1);
#pragma unroll
      for (int t32 = 0; t32 < 2; ++t32) {
        st[t32] = zero16();
#pragma unroll
        for (int s = 0; s < 6; ++s) st[t32] = MFMA(kf[t32][s], qf[s], st[t32]);
      }
      __builtin_amdgcn_s_setprio(0);
      bf16x8 vf[2][2][2];
#pragma unroll
      for (int t32 = 0; t32 < 2; ++t32)
#pragma unroll
        for (int s = 0; s < 2; ++s)
#pragma unroll
          for (int mt = 0; mt < 2; ++mt) {
            const char* vp = sv + (mt * 32 + l32) * MLA_SVP + (t32 * 32 + s * 16 + hf * 4) * 2;
            vf[t32][s][mt] = join8(*(const uint2*)vp, *(const uint2*)(vp + 16));
          }
      __builtin_amdgcn_sched_barrier(0);
      if (k0 + 63 > q0) {
        const int qpos = q0 + l32;
#pragma unroll
        for (int t32 = 0; t32 < 2; ++t32)
#pragma unroll
          for (int r = 0; r < 16; ++r) { const int key = k0 + t32 * 32 + crow(r, hf); if (key > qpos) st[t32][r] = -1e30f; }
      }
      float mx = -1e30f;
#pragma unroll
      for (int t32 = 0; t32 < 2; ++t32)
#pragma unroll
        for (int r = 0; r < 16; ++r) mx = fmaxf(mx, st[t32][r]);
      mx = fmaxf(mx, __shfl_xor(mx, 32));
      const float mn = fmaxf(m, mx);
      const float alpha = ex2(m - mn);
      m = mn;
      float ps = 0.f;
#pragma unroll
      for (int t32 = 0; t32 < 2; ++t32)
#pragma unroll
        for (int r = 0; r < 16; ++r) { const float pv = ex2(st[t32][r] - mn); st[t32][r] = pv; ps += pv; }
      l = l * alpha + ps;
#pragma unroll
      for (int mt = 0; mt < 2; ++mt)
#pragma unroll
        for (int r = 0; r < 16; ++r) ot[mt][r] *= alpha;
      __builtin_amdgcn_s_setprio(1);
#pragma unroll
      for (int t32 = 0; t32 < 2; ++t32)
#pragma unroll
        for (int s = 0; s < 2; ++s) {
          const bf16x8 pf = pack8(st[t32], s);
#pragma unroll
          for (int mt = 0; mt < 2; ++mt) ot[mt] = MFMA(vf[t32][s][mt], pf, ot[mt]);
        }
      __builtin_amdgcn_s_setprio(0);
    }
  };
  MGLOAD(0, 0); MGLOAD(1, 1);
  MSWRITE(0, 0); __syncthreads();
  for (int kt = 0; kt < ntile; kt += 2) {
    if (kt + 2 < ntile) MGLOAD(0, kt + 2);
    __builtin_amdgcn_sched_barrier(0);
    compute(kt, 0); compute(kt, 1);
    MSWRITE(1, 1);
    __syncthreads();
    if (kt + 3 < ntile) MGLOAD(1, kt + 3);
    __builtin_amdgcn_sched_barrier(0);
    compute(kt + 1, 0); compute(kt + 1, 1);
    if (kt + 2 < ntile) MSWRITE(0, 0);
    __syncthreads();
  }
#undef MGLOAD
#undef MSWRITE
  l += __shfl_xor(l, 32);
  const float inv = 1.f / l;
#pragma unroll
  for (int mt = 0; mt < 2; ++mt)
#pragma unroll
    for (int qd = 0; qd < 4; ++qd) {
      const int e0 = mt * 32 + 8 * qd + 4 * hf;
      uint2 ov;
      ov.x = pack2(ot[mt][4 * qd + 0] * inv, ot[mt][4 * qd + 1] * inv);
      ov.y = pack2(ot[mt][4 * qd + 2] * inv, ot[mt][4 * qd + 3] * inv);
      *(uint2*)(o + tq * LDH + h * 64 + e0) = ov;
    }
}

DI void swa_item(const Params& p, int j, int b, int nblk, int kvh, char* smem) {
  const int tid = opqv(threadIdx.x) & 255, lane = tid & 63, w = tid >> 6, l32 = lane & 31, hf = lane >> 5;
  char* ws = opq(p.ws);
  const u16* SQ = (const u16*)(ws + OFF_SQ); const u16* SK = (const u16*)(ws + OFF_SK); const u16* SV = (const u16*)(ws + OFF_SV);
  u16* o = (u16*)(ws + OFF_OE);
  char* sk = smem; char* sv = smem + 256 * 144;
  const int ws0 = 128 * (nblk - 1);
#pragma unroll
  for (int i = 0; i < 8; ++i) {
    const int c = tid + 256 * i, row = c >> 3, ch = c & 7, pos = ws0 + row;
    uint4 kv = make_uint4(0, 0, 0, 0), vv = make_uint4(0, 0, 0, 0);
    if (pos >= 0) {
      kv = *(const uint4*)(SK + ((size_t)b * S_ + pos) * 128 + kvh * 64 + ch * 8);
      vv = *(const uint4*)(SV + ((size_t)b * S_ + pos) * 128 + kvh * 64 + ch * 8);
    }
    *(uint4*)(sk + row * 144 + ch * 16) = kv;
    char* vb = sv + (ch * 8) * 528 + row * 2;
    *(u16*)(vb + 0 * 528) = (u16)(vv.x & 0xffffu); *(u16*)(vb + 1 * 528) = (u16)(vv.x >> 16);
    *(u16*)(vb + 2 * 528) = (u16)(vv.y & 0xffffu); *(u16*)(vb + 3 * 528) = (u16)(vv.y >> 16);
    *(u16*)(vb + 4 * 528) = (u16)(vv.z & 0xffffu); *(u16*)(vb + 5 * 528) = (u16)(vv.z >> 16);
    *(u16*)(vb + 6 * 528) = (u16)(vv.w & 0xffffu); *(u16*)(vb + 7 * 528) = (u16)(vv.w >> 16);
  }
  __syncthreads();
  const size_t tq = (size_t)b * S_ + nblk * 128 + w * 32 + l32;
  const int qloc = 128 + w * 32 + l32;
#pragma unroll 1
  for (int g = 0; g < 4; ++g) {
    const int head = kvh * 4 + g;
    bf16x8 qf[4];
#pragma unroll
    for (int s = 0; s < 4; ++s) qf[s] = *(const bf16x8*)(SQ + tq * 512 + head * 64 + s * 16 + hf * 8);
    f32x16 st[5];
    const float sink2 = p.swa_sinks[j * 8 + head] * LOG2E;
    float mx = sink2;
#pragma unroll
    for (int tt = 0; tt < 5; ++tt) {
      const int kb = w * 32 + tt * 32;
      st[tt] = zero16();
#pragma unroll
      for (int s = 0; s < 4; ++s) {
        const bf16x8 kf = *(const bf16x8*)(sk + (kb + l32) * 144 + (s * 16 + hf * 8) * 2);
        st[tt] = MFMA(kf, qf[s], st[tt]);
      }
#pragma unroll
      for (int r = 0; r < 16; ++r) {
        const int kloc = kb + crow(r, hf);
        const bool valid = (kloc <= qloc) && (kloc > qloc - 128) && (ws0 + kloc >= 0);
        const float v = valid ? st[tt][r] : -1e30f;
        st[tt][r] = v; mx = fmaxf(mx, v);
      }
    }
    mx = fmaxf(mx, __shfl_xor(mx, 32));
    float ps = 0.f;
#pragma unroll
    for (int tt = 0; tt < 5; ++tt)
#pragma unroll
      for (int r = 0; r < 16; ++r) { const float pv = ex2(st[tt][r] - mx); st[tt][r] = pv; ps += pv; }
    ps += __shfl_xor(ps, 32);
    const float inv = 1.f / (ps + ex2(sink2 - mx));
    f32x16 ot[2]; ot[0] = zero16(); ot[1] = zero16();
#pragma unroll
    for (int tt = 0; tt < 5; ++tt) {
      const int kb = w * 32 + tt * 32;
#pragma unroll
      for (int s = 0; s < 2; ++s) {
        const bf16x8 pf = pack8(st[tt], s);
#pragma unroll
        for (int mt = 0; mt < 2; ++mt) {
          const char* vp = sv + (mt * 32 + l32) * 528 + (kb + s * 16 + hf * 4) * 2;
          const bf16x8 vf = join8(*(const uint2*)vp, *(const uint2*)(vp + 16));
          ot[mt] = MFMA(vf, pf, ot[mt]);
        }
      }
    }
#pragma unroll
    for (int mt = 0; mt < 2; ++mt)
#pragma unroll
      for (int qd = 0; qd < 4; ++qd) {
        const int e0 = mt * 32 + 8 * qd + 4 * hf;
        uint2 ov;
        ov.x = pack2(ot[mt][4 * qd + 0] * inv, ot[mt][4 * qd + 1] * inv);
        ov.y = pack2(ot[mt][4 * qd + 2] * inv, ot[mt][4 * qd + 3] * inv);
        *(uint2*)(o + tq * LDH + 512 + head * 64 + e0) = ov;
      }
  }
  __syncthreads();
}

DI void attn_phase(const Params& p, int j, int ctr_idx, char* smem) {
  __shared__ int s_item;
  const int xcd = blockIdx.x & 7;
  int* ctr = (int*)(p.ws + OFF_CTR) + 16 + ctr_idx * 8 + xcd;
  const int nmla = 128, nswa = 32;
  const int half = opqv(threadIdx.x) >> 8;
  char* sm = smem + half * HALF_SMEM;
  for (;;) {
    __syncthreads();
    if (threadIdx.x == 0) s_item = atomicAdd(ctr, 1);
    __syncthreads();
    const int it = s_item;
    if (it >= nmla + nswa) break;
    if (it < nmla) {
      const int qb = 63 - (it >> 1), bh = xcd * 2 + (it & 1);
      mla_item(p, qb, bh >> 3, bh & 7, smem);
    } else {
      const int k = (xcd * nswa + (it - nmla)) * 2 + half;
      swa_item(p, j, k >> 8, (k >> 1) & 127, k & 1, sm);
    }
  }
}

DI void rec_in_phase(const Params& p, int j, char* smem) {
  const int tid = opqv(threadIdx.x), lane = tid & 63, w = tid >> 6, wm = w >> 2, wn = w & 3, l32 = lane & 31, hf = lane >> 5;
  char* ws = opq(p.ws);
  const u16* A = (const u16*)(ws + OFF_HY);
  const u16* Wt = (const u16*)(ws + OFF_W_RECIN) + (size_t)j * 2560 * LDW1;
  u16* zr = (u16*)(ws + OFF_ZR); u16* ug = (u16*)(ws + OFF_UG);
  const float2* rt128 = (const float2*)(ws + OFF_RT128);
  const int nN = 10;
  for (int lt = blockIdx.x >> 3; lt < 16 * nN; lt += gridDim.x >> 3) {
    int mt, nt; tile_map(lt, 16, nN, 16, 2, mt, nt);
    const int m0 = mt * 256, n0 = nt * 256;
    gemm_tile(A + (size_t)m0 * LDH, LDH, 16, nullptr, 0, 0, Wt + (size_t)n0 * LDW1, LDW1, smem, [&](f32x16(&acc)[2][2], int moff) {
      const int m0_ = m0 + moff;
      int l32_ = l32, hf_ = hf; asm volatile("" : "+v"(l32_), "+v"(hf_));
      const int C64 = n0 + wn * 64;
#pragma unroll
      for (int i = 0; i < 2; ++i) {
        const int rb = m0_ + wm * 64 + i * 32;
        if (C64 < 1024) {
          const int fi = ((C64 & 127) >> 1) + l32_, cbase = C64 & ~127;
          const float sc = (C64 >= 512) ? RET_KSCALE : 1.f;
#pragma unroll
          for (int r = 0; r < 16; ++r) {
            const int t = rb + crow(r, hf_), pos = t & (S_ - 1);
            const float2 cs = rt128[pos * 64 + fi];
            const float x1 = acc[i][0][r], x2 = acc[i][1][r];
            zr[(size_t)t * LDZR + cbase + fi] = f2bf((x1 * cs.x - x2 * cs.y) * sc);
            zr[(size_t)t * LDZR + cbase + 64 + fi] = f2bf((x2 * cs.x + x1 * cs.y) * sc);
          }
        } else if (C64 < 2048) {
#pragma unroll
          for (int jn = 0; jn < 2; ++jn)
#pragma unroll
            for (int r = 0; r < 16; ++r) zr[(size_t)(rb + crow(r, hf_)) * LDZR + C64 + jn * 32 + l32_] = f2bf(acc[i][jn][r]);
        } else {
#pragma unroll
          for (int jn = 0; jn < 2; ++jn) {
            const int cl = C64 - 2048 + jn * 32 + l32_, g = cl >> 4, pp = cl & 15;
#pragma unroll
            for (int r = 0; r < 16; ++r) ug[((size_t)g * T_ + rb + crow(r, hf_)) * 16 + pp] = f2bf(acc[i][jn][r]);
          }
        }
      }
    });
  }
}

DI void s5_fill(const Params& p, int j) {
  const int tid = opqv(threadIdx.x), nb = gridDim.x, bid = blockIdx.x;
  char* ws = opq(p.ws);
  const float4* s5z = (const float4*)(ws + OFF_S5Z) + j * 2048; const float2* bbar = (const float2*)(ws + OFF_BBAR) + j * 2048 * 16;
  const float* ktab = (const float*)(ws + OFF_KTAB) + (size_t)j * 32 * 32 * 256;
  u16* WE = (u16*)(ws + OFF_WE); u16* WY = (u16*)(ws + OFF_WY);
  for (int idx = bid * NTHR + tid; idx < 32 * 256 * 512; idx += nb * NTHR) {
    const int g = idx >> 17, n2 = (idx >> 9) & 255, k = idx & 511, jj = k >> 4, q = k & 15, n = n2 & 63;
    if (n2 >= 128) { WE[idx] = 0; continue; }
    const float4 z = s5z[g * 64 + n];
    const float d = (float)(31 - jj);
    const float mg = expf(d * z.x), ang = d * z.y; float sn_, cs_; sincos_(ang, sn_, cs_);
    const float er = mg * cs_, ei = mg * sn_;
    const float2 bb = bbar[(g * 64 + n) * 16 + q];
    const float v = (n2 < 64) ? (er * bb.x - ei * bb.y) : (er * bb.y + ei * bb.x);
    WE[idx] = f2bf(v);
  }
  for (int idx = bid * NTHR + tid; idx < 32 * 512 * 640; idx += nb * NTHR) {
    const int g = idx / (512 * 640), rem = idx - g * (512 * 640), mrow = rem / 640, k = rem - mrow * 640;
    const int i = mrow >> 4, pp = mrow & 15;
    float v;
    if (k < 512) {
      const int jj = k >> 4, q = k & 15, d = i - jj;
      v = (d >= 0) ? ktab[(g * 32 + d) * 256 + pp * 16 + q] : 0.f;
      if (d == 0 && q == pp) v += p.s5_d[j * 512 + g * 16 + pp];
    } else {
      const int n2 = k - 512, n = n2 & 63;
      const float4 z = s5z[g * 64 + n];
      const float d = (float)(i + 1);
      const float mg = expf(d * z.x), ang = d * z.y; float sn_, cs_; sincos_(ang, sn_, cs_);
    const float er = mg * cs_, ei = mg * sn_;
      const float cr = p.s5_c_re[((j * 32 + g) * 16 + pp) * 64 + n], ci = p.s5_c_im[((j * 32 + g) * 16 + pp) * 64 + n];
      v = (n2 < 64) ? (cr * er - ci * ei) : -(cr * ei + ci * er);
    }
    WY[idx] = f2bf(v);
  }
}

DI void ret_u_item(const Params& p, int b, int n, int h, char* smem) {
  const int tid = opqv(threadIdx.x) & 255, lane = tid & 63, w = tid >> 6, wm = w >> 1, wn = w & 1, l32 = lane & 31, hf = lane >> 5;
  char* ws = opq(p.ws);
  const u16* zr = (const u16*)(ws + OFF_ZR); float* U = (float*)(ws + OFF_UO);
  char* sKt = smem; char* sVt = smem + 128 * 272;
  const size_t t0 = (size_t)b * S_ + n * 128;
  const float lg = lg2gamma(h);
#pragma unroll
  for (int i = 0; i < 8; ++i) {
    const int c = tid + 256 * i, row = c >> 4, ch = c & 15;
    const uint4 kv = *(const uint4*)(zr + (t0 + row) * LDZR + 512 + h * 128 + ch * 8);
    const uint4 vv = *(const uint4*)(zr + (t0 + row) * LDZR + 1024 + h * 128 + ch * 8);
    const float te = ex2((float)(127 - row) * lg);
    char* kb = sKt + (ch * 8) * 272 + row * 2; char* vb = sVt + (ch * 8) * 272 + row * 2;
    *(u16*)(kb + 0 * 272) = f2bf(bf2f(kv.x & 0xffffu) * te); *(u16*)(kb + 1 * 272) = f2bf(bf2f(kv.x >> 16) * te);
    *(u16*)(kb + 2 * 272) = f2bf(bf2f(kv.y & 0xffffu) * te); *(u16*)(kb + 3 * 272) = f2bf(bf2f(kv.y >> 16) * te);
    *(u16*)(kb + 4 * 272) = f2bf(bf2f(kv.z & 0xffffu) * te); *(u16*)(kb + 5 * 272) = f2bf(bf2f(kv.z >> 16) * te);
    *(u16*)(kb + 6 * 272) = f2bf(bf2f(kv.w & 0xffffu) * te); *(u16*)(kb + 7 * 272) = f2bf(bf2f(kv.w >> 16) * te);
    *(u16*)(vb + 0 * 272) = (u16)(vv.x & 0xffffu); *(u16*)(vb + 1 * 272) = (u16)(vv.x >> 16);
    *(u16*)(vb + 2 * 272) = (u16)(vv.y & 0xffffu); *(u16*)(vb + 3 * 272) = (u16)(vv.y >> 16);
    *(u16*)(vb + 4 * 272) = (u16)(vv.z & 0xffffu); *(u16*)(vb + 5 * 272) = (u16)(vv.z >> 16);
    *(u16*)(vb + 6 * 272) = (u16)(vv.w & 0xffffu); *(u16*)(vb + 7 * 272) = (u16)(vv.w >> 16);
  }
  __syncthreads();
  f32x16 acc[2][2];
#pragma unroll
  for (int i = 0; i < 2; ++i)
#pragma unroll
    for (int jn = 0; jn < 2; ++jn) acc[i][jn] = zero16();
#pragma unroll
  for (int s = 0; s < 8; ++s) {
    bf16x8 af[2], bfr[2];
#pragma unroll
    for (int i = 0; i < 2; ++i) af[i] = *(const bf16x8*)(sVt + (wm * 64 + i * 32 + l32) * 272 + (s * 16 + hf * 8) * 2);
#pragma unroll
    for (int jn = 0; jn < 2; ++jn) bfr[jn] = *(const bf16x8*)(sKt + (wn * 64 + jn * 32 + l32) * 272 + (s * 16 + hf * 8) * 2);
#pragma unroll
    for (int i = 0; i < 2; ++i)
#pragma unroll
      for (int jn = 0; jn < 2; ++jn) acc[i][jn] = MFMA(af[i], bfr[jn], acc[i][jn]);
  }
  float* Ub = U + ((size_t)((b * 4 + h) * 128 + n)) * 16384;
#pragma unroll
  for (int i = 0; i < 2; ++i)
#pragma unroll
    for (int jn = 0; jn < 2; ++jn)
#pragma unroll
      for (int r = 0; r < 16; ++r) Ub[(wm * 64 + i * 32 + crow(r, hf)) * 128 + wn * 64 + jn * 32 + l32] = acc[i][jn][r];
  __syncthreads();
}

DI void rec_state_phase(const Params& p, int j, char* smem) {
  const int tid = opqv(threadIdx.x), lane = tid & 63, w = tid >> 6, wm = w >> 2, wn = w & 3, l32 = lane & 31, hf = lane >> 5;
  char* ws = opq(p.ws);
  {
    const int half = opqv(threadIdx.x) >> 8;
    char* sm = smem + half * HALF_SMEM;
    for (int it = blockIdx.x; it < 512; it += gridDim.x) { const int item = it * 2 + half; ret_u_item(p, item >> 9, (item >> 2) & 127, item & 3, sm); }
  }
  for (int it = blockIdx.x; it < 128; it += gridDim.x) {
    const int g = it >> 2, mt = it & 3, m0 = mt * 256;
    const u16* A = (const u16*)(ws + OFF_UG) + (size_t)g * T_ * 16 + (size_t)m0 * 512;
    const u16* Bt = (const u16*)(ws + OFF_WE) + (size_t)g * 256 * 512;
    float* E = (float*)(ws + OFF_EB) + (size_t)g * 1024 * 128;
    gemm_tile(A, 512, 8, nullptr, 0, 0, Bt, 512, smem, [&](f32x16(&acc)[2][2], int moff) {
      int l32_ = l32, hf_ = hf; asm volatile("" : "+v"(l32_), "+v"(hf_));
      const int m0_ = m0 + moff;
      if (wn < 2) {
#pragma unroll
        for (int i = 0; i < 2; ++i)
#pragma unroll
          for (int jn = 0; jn < 2; ++jn)
#pragma unroll
            for (int r = 0; r < 16; ++r)
              E[(size_t)(m0_ + wm * 64 + i * 32 + crow(r, hf_)) * 128 + wn * 64 + jn * 32 + l32_] = acc[i][jn][r];
      }
    });
  }
}

DI void scan_phase(const Params& p, int j, char* smem) {
  const int tfull = opqv(threadIdx.x);
  const int tid = tfull & 255, half = tfull >> 8;
  char* ws = opq(p.ws);
  for (int it = blockIdx.x; it < 128; it += gridDim.x) {
    if (it < 64) {
      const int vb = it * 2 + half;
      const int idx = vb * 256 + tid, bh = idx >> 12, e4 = (idx & 4095) * 4, h = bh & 3;
      const float cd = ex2(128.f * lg2gamma(h));
      const float* U = (const float*)(ws + OFF_UO) + (size_t)bh * 128 * 16384 + e4;
      u16* Sp = (u16*)(ws + OFF_SP) + (size_t)bh * 128 * 16384 + e4;
      float4 S = make_float4(0, 0, 0, 0);
      for (int n0 = 0; n0 < 128; n0 += 16) {
        f32x4 u[16];
#pragma unroll
        for (int k = 0; k < 16; ++k) u[k] = *(const f32x4*)(U + (size_t)(n0 + k) * 16384);
#pragma unroll
        for (int k = 0; k < 16; ++k) {
          *(uint2*)(Sp + (size_t)(n0 + k) * 16384) = make_uint2(pack2(S.x, S.y), pack2(S.z, S.w));
          S.x = cd * S.x + u[k].x; S.y = cd * S.y + u[k].y; S.z = cd * S.z + u[k].z; S.w = cd * S.w + u[k].w;
        }
      }
    } else {
      const int bg = it - 64, b = bg >> 5, g = bg & 31, n = tfull & 63, seg = tfull >> 6;
      const float4 z = ((const float4*)(ws + OFF_S5Z))[(j * 32 + g) * 64 + n];
      const float mg = expf(32.f * z.x), ang = 32.f * z.y; float sn_, cs_; sincos_(ang, sn_, cs_);
      const float ar = mg * cs_, ai = mg * sn_;
      float br = ar, bi = ai;
#pragma unroll
      for (int t = 0; t < 6; ++t) { const float nr = br * br - bi * bi, ni = 2.f * br * bi; br = nr; bi = ni; }
      const float* E = (const float*)(ws + OFF_EB) + ((size_t)g * 1024 + b * 512 + seg * 64) * 128;
      u16* Xp = (u16*)(ws + OFF_XP) + ((size_t)g * 1024 + b * 512 + seg * 64) * 128;
      float2* Ls = (float2*)smem;
      float xr = 0.f, xi = 0.f;
      for (int c0 = 0; c0 < 64; c0 += 32) {
        float er[32], ei[32];
#pragma unroll
        for (int k = 0; k < 32; ++k) { er[k] = E[(c0 + k) * 128 + n]; ei[k] = E[(c0 + k) * 128 + 64 + n]; }
#pragma unroll
        for (int k = 0; k < 32; ++k) {
          const float nr = ar * xr - ai * xi + er[k], ni = ar * xi + ai * xr + ei[k];
          xr = nr; xi = ni;
        }
      }
      Ls[seg * 64 + n] = make_float2(xr, xi);
      __syncthreads();
      xr = 0.f; xi = 0.f;
      for (int s2 = 0; s2 < seg; ++s2) {
        const float2 L = Ls[s2 * 64 + n];
        const float nr = br * xr - bi * xi + L.x, ni = br * xi + bi * xr + L.y;
        xr = nr; xi = ni;
      }
      for (int c0 = 0; c0 < 64; c0 += 32) {
        float er[32], ei[32];
#pragma unroll
        for (int k = 0; k < 32; ++k) { er[k] = E[(c0 + k) * 128 + n]; ei[k] = E[(c0 + k) * 128 + 64 + n]; }
#pragma unroll
        for (int k = 0; k < 32; ++k) {
          Xp[(c0 + k) * 128 + n] = f2bf(xr); Xp[(c0 + k) * 128 + 64 + n] = f2bf(xi);
          const float nr = ar * xr - ai * xi + er[k], ni = ar * xi + ai * xr + ei[k];
          xr = nr; xi = ni;
        }
      }
      __syncthreads();
    }
  }
}

DI void ret_out_item(const Params& p, int b, int n, int h, char* smem) {
  const int tid = opqv(threadIdx.x) & 255, lane = tid & 63, w = tid >> 6, l32 = lane & 31, hf = lane >> 5;
  char* ws = opq(p.ws);
  const u16* zr = (const u16*)(ws + OFF_ZR); u16* o = (u16*)(ws + OFF_UO);
  char* sK = smem; char* sVt = smem + 128 * 272;
  const size_t t0 = (size_t)b * S_ + n * 128;
  const float lg = lg2gamma(h);
#pragma unroll
  for (int i = 0; i < 8; ++i) {
    const int c = tid + 256 * i, row = c >> 4, ch = c & 15;
    const uint4 kv = *(const uint4*)(zr + (t0 + row) * LDZR + 512 + h * 128 + ch * 8);
    const uint4 vv = *(const uint4*)(zr + (t0 + row) * LDZR + 1024 + h * 128 + ch * 8);
    *(uint4*)(sK + row * 272 + ch * 16) = kv;
    char* vb = sVt + (ch * 8) * 272 + row * 2;
    *(u16*)(vb + 0 * 272) = (u16)(vv.x & 0xffffu); *(u16*)(vb + 1 * 272) = (u16)(vv.x >> 16);
    *(u16*)(vb + 2 * 272) = (u16)(vv.y & 0xffffu); *(u16*)(vb + 3 * 272) = (u16)(vv.y >> 16);
    *(u16*)(vb + 4 * 272) = (u16)(vv.z & 0xffffu); *(u16*)(vb + 5 * 272) = (u16)(vv.z >> 16);
    *(u16*)(vb + 6 * 272) = (u16)(vv.w & 0xffffu); *(u16*)(vb + 7 * 272) = (u16)(vv.w >> 16);
  }
  __syncthreads();
  const size_t tq = t0 + w * 32 + l32;
  const int qi = w * 32 + l32;
  bf16x8 qf[8];
#pragma unroll
  for (int s = 0; s < 8; ++s) qf[s] = *(const bf16x8*)(zr + tq * LDZR + h * 128 + s * 16 + hf * 8);
  f32x16 ot[4];
  const u16* Sp = (const u16*)(ws + OFF_SP) + ((size_t)((b * 4 + h) * 128 + n)) * 16384;
#pragma unroll
  for (int mt = 0; mt < 4; ++mt) {
    ot[mt] = zero16();
#pragma unroll
    for (int s = 0; s < 8; ++s) {
      const bf16x8 sf = *(const bf16x8*)(Sp + (mt * 32 + l32) * 128 + s * 16 + hf * 8);
      ot[mt] = MFMA(sf, qf[s], ot[mt]);
    }
  }
  const float fs = ex2((float)(qi + 1) * lg);
#pragma unroll
  for (int mt = 0; mt < 4; ++mt)
#pragma unroll
    for (int r = 0; r < 16; ++r) ot[mt][r] *= fs;
#pragma unroll
  for (int tt = 0; tt < 4; ++tt) {
    if (tt <= w) {
      f32x16 st = zero16();
#pragma unroll
      for (int s = 0; s < 8; ++s) {
        const bf16x8 kf = *(const bf16x8*)(sK + (tt * 32 + l32) * 272 + (s * 16 + hf * 8) * 2);
        st = MFMA(kf, qf[s], st);
      }
#pragma unroll
      for (int r = 0; r < 16; ++r) {
        const int dd = qi - (tt * 32 + crow(r, hf));
        st[r] = (dd >= 0) ? st[r] * ex2((float)dd * lg) : 0.f;
      }
#pragma unroll
      for (int s2 = 0; s2 < 2; ++s2) {
        const bf16x8 pf = pack8(st, s2);
#pragma unroll
        for (int mt = 0; mt < 4; ++mt) {
          const char* vp = sVt + (mt * 32 + l32) * 272 + (tt * 32 + s2 * 16 + hf * 4) * 2;
          const bf16x8 vf = join8(*(const uint2*)vp, *(const uint2*)(vp + 16));
          ot[mt] = MFMA(vf, pf, ot[mt]);
        }
      }
    }
  }
  float sum = 0.f;
#pragma unroll
  for (int mt = 0; mt < 4; ++mt)
#pragma unroll
    for (int r = 0; r < 16; ++r) sum += ot[mt][r];
  sum += __shfl_xor(sum, 32);
  const float mean = sum * (1.f / 128.f);
  float vs = 0.f;
#pragma unroll
  for (int mt = 0; mt < 4; ++mt)
#pragma unroll
    for (int r = 0; r < 16; ++r) { const float d = ot[mt][r] - mean; vs += d * d; }
  vs += __shfl_xor(vs, 32);
  const float rstd = rsqrtf(vs * (1.f / 128.f) + 1e-5f);
#pragma unroll
  for (int mt = 0; mt < 4; ++mt)
#pragma unroll
    for (int qd = 0; qd < 4; ++qd) {
      const int e0 = mt * 32 + 8 * qd + 4 * hf;
      const uint2 gv = *(const uint2*)(zr + tq * LDZR + 1536 + h * 128 + e0);
      const float g0 = bf2f(gv.x & 0xffffu), g1 = bf2f(gv.x >> 16), g2 = bf2f(gv.y & 0xffffu), g3 = bf2f(gv.y >> 16);
      const float o0 = g0 / (1.f + __expf(-g0)) * (ot[mt][4 * qd + 0] - mean) * rstd;
      const float o1 = g1 / (1.f + __expf(-g1)) * (ot[mt][4 * qd + 1] - mean) * rstd;
      const float o2 = g2 / (1.f + __expf(-g2)) * (ot[mt][4 * qd + 2] - mean) * rstd;
      const float o3 = g3 / (1.f + __expf(-g3)) * (ot[mt][4 * qd + 3] - mean) * rstd;
      *(uint2*)(o + tq * LDH + h * 128 + e0) = make_uint2(pack2(o0, o1), pack2(o2, o3));
    }
  __syncthreads();
}

DI float gelu_tanh(float y) {
  const float u = 0.7978845608028654f * (y + 0.044715f * y * y * y);
  const float e = __expf(2.f * u);
  const float th = 1.f - 2.f / (e + 1.f);
  return 0.5f * y * (1.f + th);
}

DI void rec_out_phase(const Params& p, int j, char* smem) {
  const int tid = opqv(threadIdx.x), lane = tid & 63, w = tid >> 6, wm = w >> 2, wn = w & 3, l32 = lane & 31, hf = lane >> 5;
  char* ws = opq(p.ws);
  {
    const int half = opqv(threadIdx.x) >> 8;
    char* sm = smem + half * HALF_SMEM;
    for (int it = blockIdx.x; it < 512; it += gridDim.x) { const int item = it * 2 + half; ret_out_item(p, item >> 9, (item >> 2) & 127, item & 3, sm); }
  }
  for (int it = blockIdx.x; it < 256; it += gridDim.x) {
    {
      const int k = it, g = k >> 3, mt = (k >> 1) & 3, nt = k & 1, m0 = mt * 256, n0 = nt * 256;
      const u16* Ug = (const u16*)(ws + OFF_UG) + (size_t)g * T_ * 16;
      const u16* A1 = Ug + (size_t)m0 * 512;
      const u16* A2 = (const u16*)(ws + OFF_XP) + ((size_t)g * 1024 + m0) * 128;
      const u16* Bt = (const u16*)(ws + OFF_WY) + ((size_t)g * 512 + n0) * 640;
      u16* yt = (u16*)(ws + OFF_YT);
      gemm_tile(A1, 512, 8, A2, 128, 2, Bt, 640, smem, [&](f32x16(&acc)[2][2], int moff) {
      const int m0_ = m0 + moff;
      int l32_ = l32, hf_ = hf; asm volatile("" : "+v"(l32_), "+v"(hf_));
#pragma unroll
        for (int i = 0; i < 2; ++i)
#pragma unroll
          for (int jn = 0; jn < 2; ++jn)
#pragma unroll
            for (int r = 0; r < 16; ++r) {
              const int R = m0_ + wm * 64 + i * 32 + crow(r, hf_), col = n0 + wn * 64 + jn * 32 + l32_;
              const int ii = col >> 4, pp = col & 15;
              const size_t t = (size_t)R * 32 + ii;
              const float y = acc[i][jn][r];
              yt[t * LDYT + g * 16 + pp] = f2bf(gelu_tanh(y));
            }
      });
    }
  }
}

DI void glu_phase(const Params& p, int j, char* smem) {
  const int tid = opqv(threadIdx.x), lane = tid & 63, w = tid >> 6, wm = w >> 2, wn = w & 3, l32 = lane & 31, hf = lane >> 5;
  char* ws = opq(p.ws);
  const u16* yt = (const u16*)(ws + OFF_YT);
  const u16* Wt = (const u16*)(ws + OFF_W_GLU) + (size_t)j * 512 * LDGLU;
  u16* o = (u16*)(ws + OFF_UO);
  const float* gb = p.s5_glu_b + j * 512;
  const int nN = 2;
  for (int lt = blockIdx.x >> 3; lt < 16 * nN; lt += gridDim.x >> 3) {
    int mt, nt; tile_map(lt, 16, nN, 16, 2, mt, nt);
    const int m0 = mt * 256, n0 = nt * 256;
    gemm_tile(yt + (size_t)m0 * LDYT, LDYT, 8, nullptr, 0, 0, Wt + (size_t)n0 * LDGLU, LDGLU, smem, [&](f32x16(&acc)[2][2], int moff) {
      const int m0_ = m0 + moff;
      int l32_ = l32, hf_ = hf; asm volatile("" : "+v"(l32_), "+v"(hf_));
#pragma unroll
      for (int i = 0; i < 2; ++i)
#pragma unroll
        for (int jn = 0; jn < 2; ++jn)
#pragma unroll
          for (int r = 0; r < 16; ++r) {
            const int row = m0_ + wm * 64 + i * 32 + crow(r, hf_), col = n0 + wn * 64 + jn * 32 + l32_;
            const float gt = acc[i][jn][r] + gb[col];
            const float y = bf2f(yt[(size_t)row * LDYT + col]);
            o[(size_t)row * LDH + 512 + col] = f2bf(y / (1.f + __expf(-gt)));
          }
    });
  }
}

DI void run_phase(const Params& p, int ph, char* smem, int rep) {
  char* ws = opq(p.ws);
  if (ph == 0) { phase0(p, smem); return; }
  if (ph == 1) { phase1(p); return; }
  const int q = ph - 2, pair = q / 18, r = q % 18;
  const bool odd = r >= 8;
  const int k = odd ? r - 8 : r;
  const int l = pair * 2 + (odd ? 1 : 0), j = pair;
  int op = 2, pm = 0, ls = 0;
  if (!odd) {
    if (k == 3) { op = 0; pm = 0; } else if (k == 5) { op = 0; pm = 1; } else if (k == 6) { op = 0; pm = 2; }
    else if (k == 4) { op = 1; ls = 2 * l; } else if (k == 7) { op = 1; ls = 2 * l + 1; }
  } else {
    if (k == 5) { op = 0; pm = 0; } else if (k == 7) { op = 0; pm = 1; } else if (k == 8) { op = 0; pm = 2; }
    else if (k == 6) { op = 1; ls = 2 * l; } else if (k == 9) { op = 1; ls = 2 * l + 1; }
  }
  if (op == 0) {
    const u16* A; const u16* W; u16* C; int K, N, mode, lda, ldb, ldc;
    if (pm == 0) {
      A = (const u16*)(ws + (odd ? OFF_UO : OFF_OE)); lda = LDH;
      W = (const u16*)(ws + (odd ? OFF_W_RECOUT : OFF_W_ATTOUT)) + (size_t)j * 1024 * LDW1; ldb = LDW1;
      C = (u16*)(ws + OFF_HY); ldc = LDH; K = 1024; N = 1024; mode = 0;
    } else if (pm == 1) {
      A = (const u16*)(ws + OFF_HY); lda = LDH; W = (const u16*)(ws + OFF_W1) + (size_t)l * 4096 * LDW1; ldb = LDW1;
      C = (u16*)(ws + OFF_HID); ldc = LDHID; K = 1024; N = 4096; mode = 1;
    } else {
      A = (const u16*)(ws + OFF_HID); lda = LDHID; W = (const u16*)(ws + OFF_W2) + (size_t)l * 1024 * LDW2; ldb = LDW2;
      C = (u16*)(ws + OFF_HY); ldc = LDH; K = 4096; N = 1024; mode = 0;
    }
#ifdef PROBE_VARIANT
    if (rep) gemm_plain<PROBE_VARIANT>(A, lda, K, W, ldb, N, C, ldc, mode, smem); else
#endif
    gemm_plain<0>(A, lda, K, W, ldb, N, C, ldc, mode, smem);
  } else if (op == 1) {
    ln_phase(p, ls);
  } else if (!odd) {
    if (k == 0) att_in_phase(p, j, smem);
    else if (k == 1) qkv_phase(p, j, smem);
    else attn_phase(p, j, j + 4 * rep, smem);
  } else {
    if (k == 0) { rec_in_phase(p, j, smem); s5_fill(p, j); }
    else if (k == 1) rec_state_phase(p, j, smem);
    else if (k == 2) scan_phase(p, j, smem);
    else if (k == 3) rec_out_phase(p, j, smem);
    else glu_phase(p, j, smem);
  }
}

__global__ void __launch_bounds__(512, 2) mega_kernel(Params p, int ph0, int ph1) {
  extern __shared__ __attribute__((aligned(16))) char smem[];
  cg::grid_group grid = cg::this_grid();
  __shared__ uint4 xb_words;
  if (threadIdx.x == 0) xb_words = make_uint4(0u, 0u, 0u, 0u);
  __syncthreads();
  XcdBarrier xb = xcd_barrier_post((unsigned*)(p.ws + OFF_BAR), (volatile LAS unsigned*)&xb_words);
  for (int ph = ph0; ph < ph1; ++ph) {
    run_phase(p, ph, smem, 0);
#ifdef PROBE_MASK
    if (ph >= 2 && ((PROBE_MASK >> ((ph - 2) % 18)) & 1)) { xcd_barrier(xb); run_phase(p, ph, smem, 1); }
#endif
    if (ph + 1 < ph1) { if (ph == ph0) grid.sync(); else xcd_barrier(xb); }
  }
}

__global__ void fail_fill(float* out, int n) {
  int i = blockIdx.x * 256 + threadIdx.x;
  if (i < n) out[i] = 0.f;
}

extern "C" void kernel_launch(void* const* d_in, const int* in_sizes, int n_in, void* d_out, int out_size, void* d_ws,
                              size_t ws_size, hipStream_t stream) {
  Params p{};
  const float** fp = (const float**)&p;
  for (int i = 0; i < 27; ++i) fp[i] = (const float*)d_in[i];
  p.out = (float*)d_out;
  p.ws = (char*)d_ws;
  if (ws_size < WS_NEED) {
    fail_fill<<<(out_size + 255) / 256, 256, 0, stream>>>((float*)d_out, out_size);
    return;
  }
  static int grid_blocks = 0;
  if (!grid_blocks) {
    hipFuncSetAttribute((const void*)mega_kernel, hipFuncAttributeMaxDynamicSharedMemorySize, SMEM_BYTES);
    int dev = 0, cus = 0, per_cu = 0;
    hipGetDevice(&dev);
    hipDeviceGetAttribute(&cus, hipDeviceAttributeMultiprocessorCount, dev);
    hipOccupancyMaxActiveBlocksPerMultiprocessor(&per_cu, mega_kernel, NTHR, SMEM_BYTES);
    if (per_cu > 1) per_cu = 1;
    if (per_cu < 1) per_cu = 1;
    grid_blocks = cus * per_cu;
  }
  (void)hipMemsetAsync((char*)d_ws + OFF_BAR, 0, XCD_BAR_WORDS * 4, stream);
  int ph0 = 0, ph1 = NPHASE;
  void* args[] = {&p, &ph0, &ph1};
  hipError_t e = hipLaunchCooperativeKernel((void*)mega_kernel, dim3(grid_blocks), dim3(NTHR), args, SMEM_BYTES, stream);
  if (e != hipSuccess) fprintf(stderr, "cooperative launch failed: %s (grid %d)\n", hipGetErrorString(e), grid_blocks);
}
static_assert(WS_NEED <= (size_t)536870912, "workspace budget exceeded");
```

```cpp
#include <hip/hip_runtime.h>
#include <hip/hip_cooperative_groups.h>
#include <cstdio>
namespace cg = cooperative_groups;

typedef unsigned short u16;
using bf16x8 = __attribute__((ext_vector_type(8))) short;
using f32x16 = __attribute__((ext_vector_type(16))) float;
using u32x4 = __attribute__((ext_vector_type(4))) unsigned;
typedef __attribute__((address_space(3))) unsigned lds_u32;
using f32x4 = __attribute__((ext_vector_type(4))) float;
#define DI __device__ __forceinline__
#define MFMA(a, b, c) __builtin_amdgcn_mfma_f32_32x32x16_bf16((a), (b), (c), 0, 0, 0)

constexpr int T_ = 32768, S_ = 16384;
constexpr float LOG2E = 1.4426950408889634f;
constexpr float DN_ALPHA = 1.6817928305074290f;
constexpr float MLA_QSCALE = 0.10206207261596575f * LOG2E;
constexpr float SWA_QSCALE = 0.125f * LOG2E;
constexpr float RET_KSCALE = 0.08838834764831845f;
constexpr int LDH = 1088, LDHID = 4160, LDW1 = 1088, LDW2 = 4160, LDV = S_ + 64, LDKB = 832, LDZR = 2112, LDYT = 576, LDGLU = 576;

constexpr size_t OFF_MOD = 0;
constexpr size_t OFF_CTR = OFF_MOD + 8 * 2 * 3072 * 4;
constexpr size_t OFF_BAR = OFF_CTR + 256;
constexpr size_t OFF_RT32 = OFF_BAR + 16384;
constexpr size_t OFF_RT64 = OFF_RT32 + (size_t)S_ * 16 * 8;
constexpr size_t OFF_RT128 = OFF_RT64 + (size_t)S_ * 32 * 8;
constexpr size_t OFF_S5Z = OFF_RT128 + (size_t)S_ * 64 * 8;
constexpr size_t OFF_BBAR = OFF_S5Z + 2 * 32 * 64 * 16;
constexpr size_t OFF_KTAB = OFF_BBAR + 2 * 32 * 64 * 16 * 8;
constexpr size_t OFF_W_ATTIN = OFF_KTAB + 2 * 32 * 32 * 256 * 4;
constexpr size_t OFF_W_UQ = OFF_W_ATTIN + (size_t)2 * 1536 * LDW1 * 2;
constexpr size_t OFF_W_UKV = OFF_W_UQ + (size_t)2 * 768 * 384 * 2;
constexpr size_t OFF_W_ATTOUT = OFF_W_UKV + (size_t)2 * 1024 * 256 * 2;
constexpr size_t OFF_W_RECIN = OFF_W_ATTOUT + (size_t)2 * 1024 * LDW1 * 2;
constexpr size_t OFF_W_GLU = OFF_W_RECIN + (size_t)2 * 2560 * LDW1 * 2;
constexpr size_t OFF_W_RECOUT = OFF_W_GLU + (size_t)2 * 512 * LDGLU * 2;
constexpr size_t OFF_W1 = OFF_W_RECOUT + (size_t)2 * 1024 * LDW1 * 2;
constexpr size_t OFF_W2 = OFF_W1 + (size_t)4 * 4096 * LDW1 * 2;
constexpr size_t OFF_WE = OFF_W2 + (size_t)4 * 1024 * LDW2 * 2;
constexpr size_t OFF_WY = OFF_WE + (size_t)32 * 256 * 512 * 2;
constexpr size_t OFF_HY = OFF_WY + (size_t)32 * 512 * 640 * 2;
constexpr size_t OFF_RA = OFF_HY + (size_t)T_ * LDH * 2;
constexpr size_t OFF_ZC = OFF_RA;
constexpr size_t OFF_QB = OFF_ZC + (size_t)T_ * 640 * 2;
constexpr size_t OFF_KB = OFF_QB + (size_t)T_ * 768 * 2;
constexpr size_t OFF_VT = OFF_KB + (size_t)T_ * LDKB * 2;
constexpr size_t OFF_SQ = OFF_VT + (size_t)2 * 8 * 64 * LDV * 2;
constexpr size_t OFF_SK = OFF_SQ + (size_t)T_ * 512 * 2;
constexpr size_t OFF_SV = OFF_SK + (size_t)T_ * 128 * 2;
constexpr size_t OFF_OE = OFF_SV + (size_t)T_ * 128 * 2;
constexpr size_t END_EVEN = OFF_OE + (size_t)T_ * LDH * 2;
constexpr size_t OFF_ZR = OFF_RA;
constexpr size_t OFF_UG = OFF_ZR + (size_t)T_ * LDZR * 2;
constexpr size_t OFF_UO = OFF_UG + (size_t)T_ * 512 * 2;
constexpr size_t OFF_SP = OFF_UO + (size_t)T_ * LDH * 2;
constexpr size_t OFF_EB = OFF_SP + (size_t)T_ * 512 * 2;
constexpr size_t OFF_XP = OFF_EB + (size_t)32 * 1024 * 128 * 4;
constexpr size_t OFF_YT = OFF_HY;
constexpr size_t END_ODD = OFF_XP + (size_t)32 * 1024 * 128 * 2;
constexpr size_t OFF_HID = OFF_RA;
constexpr size_t END_MLP = OFF_HID + (size_t)T_ * LDHID * 2;
constexpr size_t WS_NEED = END_ODD > END_EVEN ? (END_ODD > END_MLP ? END_ODD : END_MLP) : (END_EVEN > END_MLP ? END_EVEN : END_MLP);

constexpr int NTHR = 512;
constexpr int HALF_SMEM = 73728 + 1024;
constexpr int SMEM_GEMM = 131072;
constexpr int SMEM_BYTES = 2 * HALF_SMEM;
constexpr int NPHASE = 38;

struct Params {
  const float *x, *c, *ada_w, *ada_b, *ln_g, *ln_b, *att_w_in, *mla_q_norm, *mla_w_uq, *mla_kv_norm, *mla_w_ukv,
      *swa_sinks, *att_w_out, *rec_w_in, *s5_a_re, *s5_a_im, *s5_log_step, *s5_b_re, *s5_b_im, *s5_c_re, *s5_c_im,
      *s5_d, *s5_glu_w, *s5_glu_b, *rec_w_out, *mlp_w1, *mlp_w2;
  float* out;
  char* ws;
};

#define XB_TMO      128
#define XB_XCNT(j)  (256  + 64 * (j))
#define XB_XSUB(j)  (1280 + 64 * (j))
#define XB_XGEN(j)  (2304 + 64 * (j))
#define XB_TOP      3328
#define XB_TOPGEN   3392
#define XCD_BAR_WORDS 3456
#define XB_SPIN_CAP (1u << 18)
#define LAS __attribute__((address_space(3)))

__device__ __forceinline__ unsigned xb_ld(unsigned* p)              { return __hip_atomic_load(p, __ATOMIC_RELAXED, __HIP_MEMORY_SCOPE_AGENT); }
__device__ __forceinline__ unsigned xb_add(unsigned* p, unsigned v) { return __hip_atomic_fetch_add(p, v, __ATOMIC_RELAXED, __HIP_MEMORY_SCOPE_AGENT); }
__device__ __forceinline__ unsigned xb_xcc_id() { return (unsigned)__builtin_amdgcn_s_getreg((3 << 11) | 20) & 0xFu; }
#define XB_SPIN(cond, bar) do { unsigned _sp = 0; while (cond) { __builtin_amdgcn_s_sleep(1); \
    if ((++_sp & 255u) == 0u) { if (xb_ld(&(bar)[XB_TMO])) break; if (_sp > XB_SPIN_CAP) { atomicAdd(&(bar)[XB_TMO], 1u); break; } } } } while (0)

struct XcdBarrier {
    unsigned* bar; unsigned x;
    volatile LAS unsigned* st;
};

__device__ __forceinline__ XcdBarrier xcd_barrier_post(unsigned* bar, volatile LAS unsigned* st) {
    XcdBarrier b; b.bar = bar; b.x = xb_xcc_id(); b.st = st;
    if (threadIdx.x == 0) (void)xb_add(&bar[XB_XCNT(b.x)], 1u);
    return b;
}
__device__ __forceinline__ void xcd_barrier_complete(unsigned* bar, unsigned x, unsigned& nloc, unsigned& nx) {
    const unsigned G = gridDim.x * gridDim.y * gridDim.z;
    unsigned sum, cnt, mine, sp = 0u;
    for (;;) {
        sum = 0u; cnt = 0u; mine = 0u;
#pragma unroll
        for (unsigned j = 0; j < 16; ++j) { const unsigned c = xb_ld(&bar[XB_XCNT(j)]); sum += c; cnt += (c > 0u) ? 1u : 0u; mine = (j == x) ? c : mine; }
        if (sum == G) break;
        __builtin_amdgcn_s_sleep(1);
        if ((++sp & 255u) == 0u) { if (xb_ld(&bar[XB_TMO])) break; if (sp > XB_SPIN_CAP) { atomicAdd(&bar[XB_TMO], 1u); break; } }
    }
    nloc = mine > 0u ? mine : 1u; nx = cnt > 0u ? cnt : 1u;
}

__device__ __forceinline__ void xcd_barrier(const XcdBarrier& b) {
    asm volatile("s_waitcnt vmcnt(0)" ::: "memory");
    __syncthreads();
    if (threadIdx.x == 0) {
        unsigned* bar = b.bar;
        __builtin_amdgcn_s_waitcnt(0);
        unsigned nloc = b.st[0], nx = b.st[1];
        if (nloc == 0u) { xcd_barrier_complete(bar, b.x, nloc, nx); b.st[0] = nloc; b.st[1] = nx; }
        const unsigned old = xb_add(&bar[XB_XSUB(b.x)], 1u);
        const unsigned gen = old / nloc;
        if (old + 1u == (gen + 1u) * nloc) {
            __builtin_amdgcn_fence(__ATOMIC_RELEASE, "agent");
            asm volatile("s_waitcnt vmcnt(0)" ::: "memory");
            const unsigned og = xb_add(&bar[XB_TOP], 1u);
            const unsigned tg = og / nx;
            if (og + 1u == (tg + 1u) * nx) xb_add(&bar[XB_TOPGEN], 1u);
            else XB_SPIN(xb_ld(&bar[XB_TOPGEN]) == tg, bar);
            __builtin_amdgcn_fence(__ATOMIC_ACQUIRE, "agent");
            xb_add(&bar[XB_XGEN(b.x)], 1u);
            asm volatile("s_waitcnt vmcnt(0)" ::: "memory");
        } else {
            XB_SPIN(xb_ld(&bar[XB_XGEN(b.x)]) == gen, bar);
            __builtin_amdgcn_fence(__ATOMIC_ACQUIRE, "agent");
            asm volatile("s_waitcnt vmcnt(0)" ::: "memory");
        }
    }
    __syncthreads();
}


typedef __bf16 bf2_t __attribute__((ext_vector_type(2)));
typedef float f2_t __attribute__((ext_vector_type(2)));
DI u16 f2bf(float x) { __bf16 r = (__bf16)x; return __builtin_bit_cast(u16, r); }
DI float bf2f(unsigned h) { return __uint_as_float(h << 16); }
DI unsigned pack2(float a, float b) { f2_t v = {a, b}; bf2_t r = __builtin_convertvector(v, bf2_t); return __builtin_bit_cast(unsigned, r); }
DI int crow(int r, int hf) { return (r & 3) + 8 * (r >> 2) + 4 * hf; }
DI float ex2(float x) { return __builtin_amdgcn_exp2f(x); }
DI bf16x8 pack8(const f32x16& x, int s) {
  uint4 u;
  u.x = pack2(x[8 * s + 0], x[8 * s + 1]); u.y = pack2(x[8 * s + 2], x[8 * s + 3]);
  u.z = pack2(x[8 * s + 4], x[8 * s + 5]); u.w = pack2(x[8 * s + 6], x[8 * s + 7]);
  return __builtin_bit_cast(bf16x8, u);
}
DI bf16x8 join8(uint2 lo, uint2 hi) { uint4 u = make_uint4(lo.x, lo.y, hi.x, hi.y); return __builtin_bit_cast(bf16x8, u); }
DI f32x16 zero16() { f32x16 z; for (int i = 0; i < 16; ++i) z[i] = 0.f; return z; }
DI int opqv(int x) { asm volatile("" : "+v"(x)); return x; }
DI char* opq(char* p) { asm volatile("" : "+s"(p)); return p; }
DI void sincos_(float x, float& sn, float& cs) { float s_, c_; sincosf(x, &s_, &c_); sn = s_; cs = c_; }
DI float lg2gamma(int h) { return log2f(1.0f - exp2f(-5.0f - (float)h)); }

template <int V = 0, class Epi>
DI void gemm_tile(const u16* A1, long lda1, int nk1, const u16* A2, long lda2, int nk2, const u16* Bt, long ldb,
                  char* smem, Epi&& epi) {
  const int tid = opqv(threadIdx.x), lane = tid & 63, w = tid >> 6, wm = w >> 2, wn = w & 3, l32 = lane & 31, hf = lane >> 5;
  f32x16 acc[2][2][2];
#pragma unroll
  for (int h = 0; h < 2; ++h)
#pragma unroll
    for (int i = 0; i < 2; ++i)
#pragma unroll
      for (int j = 0; j < 2; ++j) acc[h][i][j] = zero16();
  const int nk = nk1 + nk2;
  const int drow = lane >> 3, dslot = lane & 7, x7 = (l32 >> 1) & 7;
#define GLDS(KT, BUF) { const int kt_ = (KT); const u16* Ab; long lda; \
    if (kt_ < nk1) { Ab = A1 + kt_ * 64; lda = lda1; } else { Ab = A2 + (kt_ - nk1) * 64; lda = lda2; } \
    _Pragma("unroll") for (int q = 0; q < 4; ++q) { \
      const int r = (w * 4 + q) * 8 + drow; const int c = dslot ^ ((r >> 1) & 7); \
      __builtin_amdgcn_global_load_lds((const unsigned*)(Ab + (long)r * lda + c * 8), (lds_u32*)(smem + (BUF) * 65536 + (w * 4 + q) * 1024), 16, 0, 0); \
      __builtin_amdgcn_global_load_lds((const unsigned*)(Bt + (long)r * ldb + kt_ * 64 + c * 8), (lds_u32*)(smem + (BUF) * 65536 + 32768 + (w * 4 + q) * 1024), 16, 0, 0); } }
#define LFR(AF, BF, BUF, S0) { const char* a = smem + (BUF) * 65536; const char* b = a + 32768; \
    _Pragma("unroll") for (int i = 0; i < 4; ++i) AF[i] = *(const bf16x8*)(a + (wm * 128 + i * 32 + l32) * 128 + (((2 * (S0) + hf) ^ x7) << 4)); \
    _Pragma("unroll") for (int j = 0; j < 2; ++j) BF[j] = *(const bf16x8*)(b + (wn * 64 + j * 32 + l32) * 128 + (((2 * (S0) + hf) ^ x7) << 4)); }
#define MMA8(AF, BF) { \
    _Pragma("unroll") for (int i = 0; i < 4; ++i) \
      _Pragma("unroll") for (int j = 0; j < 2; ++j) acc[i >> 1][i & 1][j] = MFMA(AF[i], BF[j], acc[i >> 1][i & 1][j]); }
#define COMPUTE(BUF) { bf16x8 af0[4], bf0[2], af1[4], bf1[2]; \
    LFR(af0, bf0, BUF, 0); __builtin_amdgcn_sched_barrier(0); \
    LFR(af1, bf1, BUF, 1); MMA8(af0, bf0); __builtin_amdgcn_sched_barrier(0); \
    LFR(af0, bf0, BUF, 2); MMA8(af1, bf1); __builtin_amdgcn_sched_barrier(0); \
    LFR(af1, bf1, BUF, 3); MMA8(af0, bf0); __builtin_amdgcn_sched_barrier(0); \
    MMA8(af1, bf1); __builtin_amdgcn_sched_barrier(0); }
#define RAWBAR() { asm volatile("s_waitcnt vmcnt(0) lgkmcnt(0)" ::: "memory"); __builtin_amdgcn_s_barrier(); }
  if (V != 1) GLDS(0, 0);
  RAWBAR();
  for (int kt = 0; kt < nk; kt += 2) {
    if (V != 1) GLDS(kt + 1, 1);
    if (V != 2) COMPUTE(0);
    RAWBAR();
    if (V != 1) if (kt + 2 < nk) GLDS(kt + 2, 0);
    if (V != 2) COMPUTE(1);
    RAWBAR();
  }
#undef GLDS
#undef LFR
#undef MMA8
#undef COMPUTE
#undef RAWBAR
  epi(acc[0], wm * 64);
  epi(acc[1], wm * 64 + 64);
}

DI void tile_map(int lt, int nM8, int nN, int GM, int GN, int& mt, int& nt) {
  const int G = GM * GN, xcd = blockIdx.x & 7, group = lt / G, within = lt - group * G, ngn = nN / GN;
  const int mg = group / ngn, ng = group - mg * ngn;
  mt = xcd * nM8 + mg * GM + within / GN;
  nt = ng * GN + within % GN;
}

DI int colmap(int mode, int n) {
  if (mode == 1) { if (n < 640) return n; if (n < 1408) return n + 32; if (n < 1440) return n - 1408 + 640; return -1; }
  if (mode == 2) { if (n < 512) return (n >> 6) * 96 + (n & 63); int m = n - 512; return (m >> 5) * 96 + 64 + (m & 31); }
  if (mode == 3) { if (n < 1024) { int dl = n & 127, b4 = dl >> 5; int sb = (b4 == 1) ? 2 : (b4 == 2 ? 1 : b4); return (n & ~127) + sb * 32 + (dl & 31); } return n; }
  return n;
}
DI void conv_job(const float* src, int K, int N, u16* dst, int ldk, int Npad, const float* kscale, int mode, float* lds) {
  const int tid = opqv(threadIdx.x);
  const int nKt = K / 64, nNt = Npad / 64;
  for (int tile = blockIdx.x; tile < nKt * nNt; tile += gridDim.x) {
    const int nt = tile / nKt, kt = tile % nKt;
    const int nl = tid & 63, kq = tid >> 6;
    const int col = colmap(mode, nt * 64 + nl);
    for (int i = 0; i < 8; ++i) {
      const int kl = kq + 8 * i, k = kt * 64 + kl;
      float v = 0.f;
      if (col >= 0) { v = src[(size_t)k * N + col]; if (kscale) v *= kscale[k]; }
      lds[kl * 65 + nl] = v;
    }
    __syncthreads();
    for (int i = 0; i < 8; ++i) {
      const int n2 = kq + 8 * i;
      dst[(size_t)(nt * 64 + n2) * ldk + kt * 64 + nl] = f2bf(lds[nl * 65 + n2]);
    }
    __syncthreads();
  }
}

DI void phase0(const Params& p, char* smem) {
  const int tid = opqv(threadIdx.x), nb = gridDim.x, bid = blockIdx.x;
  char* ws = opq(p.ws);
  if (bid == 0 && tid < 64) ((int*)(ws + OFF_CTR))[tid] = 0;
  {
    float* cond = (float*)smem; float* red = cond + 2048; float* mod = (float*)(ws + OFF_MOD);
    for (int i = tid; i < 2048; i += NTHR) { float v = p.c[i]; cond[i] = v / (1.f + expf(-v)); }
    __syncthreads();
    for (int it = bid; it < 8 * 48; it += nb) {
      const int ls = it / 48, cgp = it % 48, tx = tid & 15, ty = tid >> 4;
      const float* wp = p.ada_w + (size_t)ls * 1024 * 3072 + cgp * 64 + tx * 4;
      float4 a0 = make_float4(0, 0, 0, 0), a1 = make_float4(0, 0, 0, 0);
      for (int k = ty * 32; k < ty * 32 + 32; ++k) {
        const float4 wv = *(const float4*)(wp + (size_t)k * 3072);
        const float c0 = cond[k], c1 = cond[1024 + k];
        a0.x += c0 * wv.x; a0.y += c0 * wv.y; a0.z += c0 * wv.z; a0.w += c0 * wv.w;
        a1.x += c1 * wv.x; a1.y += c1 * wv.y; a1.z += c1 * wv.z; a1.w += c1 * wv.w;
      }
      *(float4*)(red + (ty * 2 + 0) * 64 + tx * 4) = a0;
      *(float4*)(red + (ty * 2 + 1) * 64 + tx * 4) = a1;
      __syncthreads();
      if (tid < 128) {
        const int b = tid >> 6, col = tid & 63; float s = 0.f;
        for (int y = 0; y < 32; ++y) s += red[(y * 2 + b) * 64 + col];
        const int j = cgp * 64 + col;
        mod[(ls * 2 + b) * 3072 + j] = s + p.ada_b[ls * 3072 + j];
      }
      __syncthreads();
    }
  }
  {
    float* lds = (float*)smem;
    for (int j = 0; j < 2; ++j) {
      conv_job(p.att_w_in + (size_t)j * 1024 * 1440, 1024, 1440, (u16*)(ws + OFF_W_ATTIN) + (size_t)j * 1536 * LDW1, LDW1, 1536, nullptr, 1, lds);
      conv_job(p.mla_w_uq + (size_t)j * 384 * 768, 384, 768, (u16*)(ws + OFF_W_UQ) + (size_t)j * 768 * 384, 384, 768, p.mla_q_norm + j * 384, 2, lds);
      conv_job(p.mla_w_ukv + (size_t)j * 256 * 1024, 256, 1024, (u16*)(ws + OFF_W_UKV) + (size_t)j * 1024 * 256, 256, 1024, p.mla_kv_norm + j * 256, 0, lds);
      conv_job(p.att_w_out + (size_t)j * 1024 * 1024, 1024, 1024, (u16*)(ws + OFF_W_ATTOUT) + (size_t)j * 1024 * LDW1, LDW1, 1024, nullptr, 0, lds);
      conv_job(p.rec_w_in + (size_t)j * 1024 * 2560, 1024, 2560, (u16*)(ws + OFF_W_RECIN) + (size_t)j * 2560 * LDW1, LDW1, 2560, nullptr, 3, lds);
      conv_job(p.s5_glu_w + (size_t)j * 512 * 512, 512, 512, (u16*)(ws + OFF_W_GLU) + (size_t)j * 512 * LDGLU, LDGLU, 512, nullptr, 0, lds);
      conv_job(p.rec_w_out + (size_t)j * 1024 * 1024, 1024, 1024, (u16*)(ws + OFF_W_RECOUT) + (size_t)j * 1024 * LDW1, LDW1, 1024, nullptr, 0, lds);
    }
    for (int l = 0; l < 4; ++l) {
      conv_job(p.mlp_w1 + (size_t)l * 1024 * 4096, 1024, 4096, (u16*)(ws + OFF_W1) + (size_t)l * 4096 * LDW1, LDW1, 4096, nullptr, 0, lds);
      conv_job(p.mlp_w2 + (size_t)l * 4096 * 1024, 4096, 1024, (u16*)(ws + OFF_W2) + (size_t)l * 1024 * LDW2, LDW2, 1024, nullptr, 0, lds);
    }
  }
  {
    float2* rt32 = (float2*)(ws + OFF_RT32); float2* rt64 = (float2*)(ws + OFF_RT64); float2* rt128 = (float2*)(ws + OFF_RT128);
    for (int idx = bid * NTHR + tid; idx < S_ * 112; idx += nb * NTHR) {
      const int s = idx / 112, r = idx % 112;
      int dim, i; float2* dst;
      if (r < 16) { dim = 32; i = r; dst = rt32 + s * 16 + i; }
      else if (r < 48) { dim = 64; i = r - 16; dst = rt64 + s * 32 + i; }
      else { dim = 128; i = r - 48; dst = rt128 + s * 64 + i; }
      const float inv = powf(10000.0f, -((float)(2 * i)) / (float)dim);
      const float ang = (float)s * inv;
      float sn_, cs_; sincos_(ang, sn_, cs_);
      *dst = make_float2(cs_, sn_);
    }
  }
  {
    float4* s5z = (float4*)(ws + OFF_S5Z); float2* bbar = (float2*)(ws + OFF_BBAR);
    for (int idx = bid * NTHR + tid; idx < 2 * 32 * 64; idx += nb * NTHR) {
      const int jg = idx >> 6;
      const float dt = expf(p.s5_log_step[jg]);
      const float lr = p.s5_a_re[idx], li = p.s5_a_im[idx];
      const float zr = lr * dt, zi = li * dt, mag = expf(zr);
      float sn_, cs_; sincos_(zi, sn_, cs_);
      const float ar = mag * cs_, ai = mag * sn_;
      const float den = lr * lr + li * li;
      const float cr = ((ar - 1.f) * lr + ai * li) / den, ci = (ai * lr - (ar - 1.f) * li) / den;
      s5z[idx] = make_float4(zr, zi, ar, ai);
      for (int q = 0; q < 16; ++q) {
        const float br = p.s5_b_re[idx * 16 + q], bi = p.s5_b_im[idx * 16 + q];
        bbar[idx * 16 + q] = make_float2(cr * br - ci * bi, cr * bi + ci * br);
      }
    }
  }
}

DI void phase1(const Params& p) {
  const int tid = opqv(threadIdx.x), nb = gridDim.x, bid = blockIdx.x;
  char* ws = opq(p.ws);
  const float* mod = (const float*)(ws + OFF_MOD);
  u16* hy = (u16*)(ws + OFF_HY);
  const int stp = nb * NTHR;
  for (int i0 = bid * NTHR + tid; i0 < T_ * 256; i0 += stp * 8) {
    f32x4 xv[8];
#pragma unroll
    for (int u = 0; u < 8; ++u) {
      const int i = i0 + u * stp;
      if (i < T_ * 256) xv[u] = __builtin_nontemporal_load((const f32x4*)(p.x + (size_t)i * 4));
    }
#pragma unroll
    for (int u = 0; u < 8; ++u) {
      const int i = i0 + u * stp;
      if (i < T_ * 256) {
        const int t = i >> 8, c4 = (i & 255) * 4, b = t >> 14;
        const float4 sh = *(const float4*)(mod + b * 3072 + c4);
        const float4 sc = *(const float4*)(mod + b * 3072 + 1024 + c4);
        uint2 o;
        o.x = pack2(xv[u].x * (1.f + sc.x) + sh.x, xv[u].y * (1.f + sc.y) + sh.y);
        o.y = pack2(xv[u].z * (1.f + sc.z) + sh.z, xv[u].w * (1.f + sc.w) + sh.w);
        *(uint2*)(hy + (size_t)t * LDH + c4) = o;
      }
    }
  }
  const float4* s5z = (const float4*)(ws + OFF_S5Z); const float2* bbar = (const float2*)(ws + OFF_BBAR);
  float* ktab = (float*)(ws + OFF_KTAB);
  for (int idx8 = bid * NTHR + tid; idx8 < 2 * 32 * 256 * 8; idx8 += nb * NTHR) {
    const int part = idx8 & 7, idx = idx8 >> 3;
    const int q = idx & 15, pp = (idx >> 4) & 15, jg = idx >> 8;
    float acc[32];
#pragma unroll
    for (int d = 0; d < 32; ++d) acc[d] = 0.f;
    for (int n = part * 8; n < part * 8 + 8; ++n) {
      const float4 z = s5z[jg * 64 + n];
      const float2 bb = bbar[(jg * 64 + n) * 16 + q];
      const float cr = p.s5_c_re[(jg * 16 + pp) * 64 + n], ci = p.s5_c_im[(jg * 16 + pp) * 64 + n];
      const float wr = cr * bb.x - ci * bb.y, wi = cr * bb.y + ci * bb.x;
      float er = 1.f, ei = 0.f;
#pragma unroll
      for (int d = 0; d < 32; ++d) {
        acc[d] += wr * er - wi * ei;
        const float nr = er * z.z - ei * z.w, ni = er * z.w + ei * z.z;
        er = nr; ei = ni;
      }
    }
#pragma unroll
    for (int d = 0; d < 32; ++d) {
      float a = acc[d];
      a += __shfl_xor(a, 1); a += __shfl_xor(a, 2); a += __shfl_xor(a, 4);
      if (part == 0) ktab[(jg * 32 + d) * 256 + pp * 16 + q] = a;
    }
  }
}

DI void ln_phase(const Params& p, int ls) {
  const int tid = opqv(threadIdx.x), lane = tid & 63, w = tid >> 6;
  char* ws = opq(p.ws);
  const float* mod = (const float*)(ws + OFF_MOD);
  u16* hy = (u16*)(ws + OFF_HY);
  const float* xin = (ls == 0) ? p.x : p.out;
  const float* lg = p.ln_g + ls * 1024; const float* lb = p.ln_b + ls * 1024;
  const int stride = gridDim.x * 8;
  f32x4 xc[4], xn[4]; uint2 yc[4], yn[4];
  {
    const int row = blockIdx.x * 8 + w;
#pragma unroll
    for (int i = 0; i < 4; ++i) {
      const int col = lane * 4 + 256 * i;
      xc[i] = __builtin_nontemporal_load((const f32x4*)(xin + (size_t)row * 1024 + col));
      yc[i] = *(const uint2*)(hy + (size_t)row * LDH + col);
    }
  }
  for (int row = blockIdx.x * 8 + w; row < T_; row += stride) {
    const int b = row >> 14;
    const float* gate = mod + (ls * 2 + b) * 3072 + 2048;
    const int rn = row + stride;
    if (rn < T_) {
#pragma unroll
      for (int i = 0; i < 4; ++i) {
        const int col = lane * 4 + 256 * i;
        xn[i] = __builtin_nontemporal_load((const f32x4*)(xin + (size_t)rn * 1024 + col));
        yn[i] = *(const uint2*)(hy + (size_t)rn * LDH + col);
      }
    }
    float v[16];
    float sum = 0.f;
#pragma unroll
    for (int i = 0; i < 4; ++i) {
      const int col = lane * 4 + 256 * i;
      const f32x4 xv = xc[i];
      const uint2 yv = yc[i];
      const float4 g = *(const float4*)(gate + col);
      v[4 * i + 0] = DN_ALPHA * xv.x + (1.f + g.x) * bf2f(yv.x & 0xffffu);
      v[4 * i + 1] = DN_ALPHA * xv.y + (1.f + g.y) * bf2f(yv.x >> 16);
      v[4 * i + 2] = DN_ALPHA * xv.z + (1.f + g.z) * bf2f(yv.y & 0xffffu);
      v[4 * i + 3] = DN_ALPHA * xv.w + (1.f + g.w) * bf2f(yv.y >> 16);
      sum += v[4 * i] + v[4 * i + 1] + v[4 * i + 2] + v[4 * i + 3];
    }
#pragma unroll
    for (int m = 32; m >= 1; m >>= 1) sum += __shfl_xor(sum, m);
    const float mean = sum * (1.f / 1024.f);
    float vs = 0.f;
#pragma unroll
    for (int i = 0; i < 16; ++i) { const float d = v[i] - mean; vs += d * d; }
#pragma unroll
    for (int m = 32; m >= 1; m >>= 1) vs += __shfl_xor(vs, m);
    const float rstd = rsqrtf(vs * (1.f / 1024.f) + 1e-5f);
#pragma unroll
    for (int i = 0; i < 4; ++i) {
      const int col = lane * 4 + 256 * i;
      const float4 g = *(const float4*)(lg + col); const float4 bb = *(const float4*)(lb + col);
      float4 o;
      o.x = (v[4 * i + 0] - mean) * rstd * g.x + bb.x; o.y = (v[4 * i + 1] - mean) * rstd * g.y + bb.y;
      o.z = (v[4 * i + 2] - mean) * rstd * g.z + bb.z; o.w = (v[4 * i + 3] - mean) * rstd * g.w + bb.w;
      { f32x4 ov = {o.x, o.y, o.z, o.w}; __builtin_nontemporal_store(ov, (f32x4*)(p.out + (size_t)row * 1024 + col)); }
      if (ls < 7) {
        const float* m2 = mod + ((ls + 1) * 2 + b) * 3072;
        const float4 sh = *(const float4*)(m2 + col); const float4 sc = *(const float4*)(m2 + 1024 + col);
        uint2 h;
        h.x = pack2(o.x * (1.f + sc.x) + sh.x, o.y * (1.f + sc.y) + sh.y);
        h.y = pack2(o.z * (1.f + sc.z) + sh.z, o.w * (1.f + sc.w) + sh.w);
        *(uint2*)(hy + (size_t)row * LDH + col) = h;
      }
    }
#pragma unroll
    for (int i = 0; i < 4; ++i) { xc[i] = xn[i]; yc[i] = yn[i]; }
  }
}

template <int V = 0>
DI void gemm_plain(const u16* A, int lda, int K, const u16* Wt, int ldb, int N, u16* C, int ldc, int mode, char* smem) {
  const int tid = opqv(threadIdx.x), lane = tid & 63, w = tid >> 6, wm = w >> 2, wn = w & 3, l32 = lane & 31, hf = lane >> 5;
  const int nN = N / 256;
  for (int lt = blockIdx.x >> 3; lt < 16 * nN; lt += gridDim.x >> 3) {
    int mt, nt; tile_map(lt, 16, nN, 8, 4, mt, nt);
    const int m0 = mt * 256, n0 = nt * 256;
    gemm_tile<V>(A + (size_t)m0 * lda, lda, K / 64, nullptr, 0, 0, Wt + (size_t)n0 * ldb, ldb, smem, [&](f32x16(&acc)[2][2], int moff) {
      const int m0_ = m0 + moff;
      int l32_ = l32, hf_ = hf; asm volatile("" : "+v"(l32_), "+v"(hf_));
#pragma unroll
      for (int i = 0; i < 2; ++i)
#pragma unroll
        for (int j = 0; j < 2; ++j)
#pragma unroll
          for (int r = 0; r < 16; ++r) {
            const int row = m0_ + wm * 64 + i * 32 + crow(r, hf_), col = n0 + wn * 64 + j * 32 + l32_;
            float v = acc[i][j][r];
            if (mode == 1) { v = fmaxf(v, 0.f); v = v * v; }
            if (V == 0 || v == 123456.789f) C[(size_t)row * ldc + col] = f2bf(v);
          }
    });
  }
}

DI void att_in_phase(const Params& p, int j, char* smem) {
  const int tid = opqv(threadIdx.x), lane = tid & 63, w = tid >> 6, wm = w >> 2, wn = w & 3, l32 = lane & 31, hf = lane >> 5;
  char* ws = opq(p.ws);
  const u16* A = (const u16*)(ws + OFF_HY);
  const u16* Wt = (const u16*)(ws + OFF_W_ATTIN) + (size_t)j * 1536 * LDW1;
  u16* zc = (u16*)(ws + OFF_ZC); u16* SQ = (u16*)(ws + OFF_SQ); u16* SK = (u16*)(ws + OFF_SK); u16* SV = (u16*)(ws + OFF_SV);
  u16* Kb = (u16*)(ws + OFF_KB);
  const float2* rt64 = (const float2*)(ws + OFF_RT64); const float2* rt32 = (const float2*)(ws + OFF_RT32);
  const int nN = 6;
  for (int lt = blockIdx.x >> 3; lt < 16 * nN; lt += gridDim.x >> 3) {
    int mt, nt; tile_map(lt, 16, nN, 16, 2, mt, nt);
    const int m0 = mt * 256, n0 = nt * 256;
    gemm_tile(A + (size_t)m0 * LDH, LDH, 16, nullptr, 0, 0, Wt + (size_t)n0 * LDW1, LDW1, smem, [&](f32x16(&acc)[2][2], int moff) {
      const int m0_ = m0 + moff;
      int l32_ = l32, hf_ = hf; asm volatile("" : "+v"(l32_), "+v"(hf_));
      const int C64 = n0 + wn * 64;
#pragma unroll
      for (int i = 0; i < 2; ++i) {
        const int rb = m0_ + wm * 64 + i * 32;
        if (C64 < 640) {
#pragma unroll
          for (int jn = 0; jn < 2; ++jn)
#pragma unroll
            for (int r = 0; r < 16; ++r) zc[(size_t)(rb + crow(r, hf_)) * 640 + C64 + jn * 32 + l32_] = f2bf(acc[i][jn][r]);
        } else if (C64 < 1280) {
          const bool isq = C64 < 1152;
          u16* dst = isq ? SQ : SK; const int pitch = isq ? 512 : 128; const int cb = isq ? (C64 - 640) : (C64 - 1152);
          const float sc = isq ? SWA_QSCALE : 1.f;
#pragma unroll
          for (int r = 0; r < 16; ++r) {
            const int t = rb + crow(r, hf_), pos = t & (S_ - 1);
            const float2 cs = rt64[pos * 32 + l32_];
            const float x1 = acc[i][0][r], x2 = acc[i][1][r];
            dst[(size_t)t * pitch + cb + l32_] = f2bf((x1 * cs.x - x2 * cs.y) * sc);
            dst[(size_t)t * pitch + cb + 32 + l32_] = f2bf((x2 * cs.x + x1 * cs.y) * sc);
          }
        } else if (C64 < 1408) {
#pragma unroll
          for (int jn = 0; jn < 2; ++jn)
#pragma unroll
            for (int r = 0; r < 16; ++r) SV[(size_t)(rb + crow(r, hf_)) * 128 + (C64 - 1280) + jn * 32 + l32_] = f2bf(acc[i][jn][r]);
        } else if (C64 == 1408) {
#pragma unroll
          for (int r = 0; r < 16; ++r) {
            const int t = rb + crow(r, hf_), pos = t & (S_ - 1);
            const float x = acc[i][0][r];
            const float xp = __shfl_xor(x, 16);
            const float2 cs = rt32[pos * 16 + (l32_ & 15)];
            const float o = (l32_ < 16) ? (x * cs.x - xp * cs.y) : (x * cs.x + xp * cs.y);
            const u16 v = f2bf(o);
#pragma unroll
            for (int h = 0; h < 8; ++h) Kb[(size_t)t * LDKB + h * 96 + 64 + l32_] = v;
          }
        }
      }
    });
  }
}

DI void qkv_phase(const Params& p, int j, char* smem) {
  const int tid = opqv(threadIdx.x), lane = tid & 63, w = tid >> 6, wm = w >> 2, wn = w & 3, l32 = lane & 31, hf = lane >> 5;
  char* ws = opq(p.ws);
  const u16* zc = (const u16*)(ws + OFF_ZC);
  const u16* Wq = (const u16*)(ws + OFF_W_UQ) + (size_t)j * 768 * 384;
  const u16* Wkv = (const u16*)(ws + OFF_W_UKV) + (size_t)j * 1024 * 256;
  u16* Qb = (u16*)(ws + OFF_QB); u16* Kb = (u16*)(ws + OFF_KB); u16* Vt = (u16*)(ws + OFF_VT);
  const float2* rt32 = (const float2*)(ws + OFF_RT32);
  float* rsc = (float*)(smem + SMEM_GEMM);
  for (int lt0 = blockIdx.x >> 3; lt0 < 16 * 7; lt0 += gridDim.x >> 3) {
    const bool isq = lt0 < 16 * 3;
    int mt, nt;
    if (isq) tile_map(lt0, 16, 3, 16, 1, mt, nt); else tile_map(lt0 - 16 * 3, 16, 4, 8, 4, mt, nt);
    const int m0 = mt * 256, n0 = nt * 256;
    const int coff = isq ? 0 : 384, ncols = isq ? 384 : 256;
    {
      const int row = tid >> 1, half = tid & 1, nh = ncols / 2;
      const u16* src = zc + (size_t)(m0 + row) * 640 + coff + half * nh;
      float s = 0.f;
      for (int c = 0; c < nh; c += 8) {
        const uint4 v = *(const uint4*)(src + c);
        float f;
        f = bf2f(v.x & 0xffffu); s += f * f; f = bf2f(v.x >> 16); s += f * f;
        f = bf2f(v.y & 0xffffu); s += f * f; f = bf2f(v.y >> 16); s += f * f;
        f = bf2f(v.z & 0xffffu); s += f * f; f = bf2f(v.z >> 16); s += f * f;
        f = bf2f(v.w & 0xffffu); s += f * f; f = bf2f(v.w >> 16); s += f * f;
      }
      s += __shfl_xor(s, 1);
      if (half == 0) rsc[row] = rsqrtf(s / (float)ncols + 1e-6f);
    }
    __syncthreads();
    if (isq) {
      gemm_tile(zc + (size_t)m0 * 640, 640, 6, nullptr, 0, 0, Wq + (size_t)n0 * 384, 384, smem, [&](f32x16(&acc)[2][2], int moff) {
      const int m0_ = m0 + moff;
      int l32_ = l32, hf_ = hf; asm volatile("" : "+v"(l32_), "+v"(hf_));
        const int C64 = n0 + wn * 64;
#pragma unroll
        for (int i = 0; i < 2; ++i) {
          const int rl = wm * 64 + i * 32;
#pragma unroll
          for (int jn = 0; jn < 2; ++jn)
#pragma unroll
            for (int r = 0; r < 16; ++r) {
              const int rr = rl + crow(r, hf_), t = m0_ + rr;
              const float x = acc[i][jn][r] * rsc[moff + rr] * MLA_QSCALE;
              if (C64 < 512) {
                Qb[(size_t)t * 768 + (C64 >> 6) * 96 + jn * 32 + l32_] = f2bf(x);
              } else {
                const int hq = ((C64 - 512) >> 5) + jn, pos = t & (S_ - 1);
                const float xp = __shfl_xor(x, 16);
                const float2 cs = rt32[pos * 16 + (l32_ & 15)];
                const float o = (l32_ < 16) ? (x * cs.x - xp * cs.y) : (x * cs.x + xp * cs.y);
                Qb[(size_t)t * 768 + hq * 96 + 64 + l32_] = f2bf(o);
              }
            }
        }
      });
    } else {
      gemm_tile(zc + (size_t)m0 * 640 + 384, 640, 4, nullptr, 0, 0, Wkv + (size_t)n0 * 256, 256, smem, [&](f32x16(&acc)[2][2], int moff) {
      const int m0_ = m0 + moff;
      int l32_ = l32, hf_ = hf; asm volatile("" : "+v"(l32_), "+v"(hf_));
        const int C64 = n0 + wn * 64, h = C64 >> 7, part = (C64 >> 6) & 1;
#pragma unroll
        for (int i = 0; i < 2; ++i) {
          const int rl = wm * 64 + i * 32;
#pragma unroll
          for (int jn = 0; jn < 2; ++jn) {
            if (part == 0) {
#pragma unroll
              for (int r = 0; r < 16; ++r) {
                const int rr = rl + crow(r, hf_), t = m0_ + rr;
                Kb[(size_t)t * LDKB + h * 96 + jn * 32 + l32_] = f2bf(acc[i][jn][r] * rsc[moff + rr]);
              }
            } else {
              const int e = jn * 32 + l32_;
#pragma unroll
              for (int qd = 0; qd < 4; ++qd) {
                const int rr = rl + 8 * qd + 4 * hf_, t0 = m0_ + rr, b = t0 >> 14, s0 = t0 & (S_ - 1);
                uint2 o;
                o.x = pack2(acc[i][jn][4 * qd + 0] * rsc[moff + rr + 0], acc[i][jn][4 * qd + 1] * rsc[moff + rr + 1]);
                o.y = pack2(acc[i][jn][4 * qd + 2] * rsc[moff + rr + 2], acc[i][jn][4 * qd + 3] * rsc[moff + rr + 3]);
                *(uint2*)(Vt + ((size_t)((b * 8 + h) * 64 + e)) * LDV + s0) = o;
              }
            }
          }
        }
      });
    }
    __syncthreads();
  }
}

constexpr int MLA_BUF = 64 * 208 + 64 * 136;
constexpr int MLA_SVP = 264;
constexpr int MLA_BUF2 = 128 * 208 + 64 * MLA_SVP;
DI void mla_item(const Params& p, int qb, int b, int h, char* smem) {
  const int tid = opqv(threadIdx.x), lane = tid & 63, w = tid >> 6, l32 = lane & 31, hf = lane >> 5;
  char* ws = opq(p.ws);
  const u16* Qb = (const u16*)(ws + OFF_QB); u16* o = (u16*)(ws + OFF_OE);
  const int q0 = qb * 256 + w * 32;
  const size_t tq = (size_t)b * S_ + q0 + l32;
  bf16x8 qf[6];
#pragma unroll
  for (int s = 0; s < 6; ++s) qf[s] = *(const bf16x8*)(Qb + tq * 768 + h * 96 + s * 16 + hf * 8);
  f32x16 ot[2]; ot[0] = zero16(); ot[1] = zero16();
  float m = -1e30f, l = 0.f;
  const int ntile = 2 * qb + 2;
  const u16* Kg = (const u16*)(ws + OFF_KB) + ((size_t)b * S_) * LDKB + h * 96;
  const u16* Vg = (const u16*)(ws + OFF_VT) + ((size_t)(b * 8 + h) * 64) * LDV;
  u32x4 rk[2][3], rv[2][2];
#define MGLOAD(SET, KT) { const int kt_ = (KT); \
    _Pragma("unroll") for (int i = 0; i < 3; ++i) { const int c = tid + 512 * i, row = c / 12, ch = c % 12; rk[SET][i] = *(const u32x4*)(Kg + (size_t)(kt_ * 128 + row) * LDKB + ch * 8); } \
    _Pragma("unroll") for (int i = 0; i < 2; ++i) { const int c = tid + 512 * i, row = c >> 4, ch = c & 15; rv[SET][i] = *(const u32x4*)(Vg + (size_t)row * LDV + kt_ * 128 + ch * 8); } }
#define MSWRITE(SET, BUF) { char* sk_ = smem + (BUF) * MLA_BUF2; char* sv_ = sk_ + 128 * 208; \
    _Pragma("unroll") for (int i = 0; i < 3; ++i) { const int c = tid + 512 * i, row = c / 12, ch = c % 12; *(u32x4*)(sk_ + row * 208 + ch * 16) = rk[SET][i]; } \
    _Pragma("unroll") for (int i = 0; i < 2; ++i) { const int c = tid + 512 * i, row = c >> 4, ch = c & 15; \
      *(uint2*)(sv_ + row * MLA_SVP + ch * 16) = make_uint2(rv[SET][i].x, rv[SET][i].y); \
      *(uint2*)(sv_ + row * MLA_SVP + ch * 16 + 8) = make_uint2(rv[SET][i].z, rv[SET][i].w); } }
  auto compute = [&](int kt, int sub) {
    const char* sk = smem + (kt & 1) * MLA_BUF2 + sub * (64 * 208); const char* sv = smem + (kt & 1) * MLA_BUF2 + 128 * 208 + sub * 128;
    const int k0 = kt * 128 + sub * 64;
    if (k0 <= q0 + 31) {
      f32x16 st[2];
      bf16x8 kf[2][6];
#pragma unroll
      for (int t32 = 0; t32 < 2; ++t32)
#pragma unroll
        for (int s = 0; s < 6; ++s) kf[t32][s] = *(const bf16x8*)(sk + (t32 * 32 + l32) * 208 + (s * 16 + hf * 8) * 2);
      __builtin_amdgcn_sched_barrier(0);
      __builtin_amdgcn_s_setprio(1);
#pragma unroll
      for (int t32 = 0; t32 < 2; ++t32) {
        st[t32] = zero16();
#pragma unroll
        for (int s = 0; s < 6; ++s) st[t32] = MFMA(kf[t32][s], qf[s], st[t32]);
      }
      __builtin_amdgcn_s_setprio(0);
      bf16x8 vf[2][2][2];
#pragma unroll
      for (int t32 = 0; t32 < 2; ++t32)
#pragma unroll
        for (int s = 0; s < 2; ++s)
#pragma unroll
          for (int mt = 0; mt < 2; ++mt) {
            const char* vp = sv + (mt * 32 + l32) * MLA_SVP + (t32 * 32 + s * 16 + hf * 4) * 2;
            vf[t32][s][mt] = join8(*(const uint2*)vp, *(const uint2*)(vp + 16));
          }
      __builtin_amdgcn_sched_barrier(0);
      if (k0 + 63 > q0) {
        const int qpos = q0 + l32;
#pragma unroll
        for (int t32 = 0; t32 < 2; ++t32)
#pragma unroll
          for (int r = 0; r < 16; ++r) { const int key = k0 + t32 * 32 + crow(r, hf); if (key > qpos) st[t32][r] = -1e30f; }
      }
      float mx = -1e30f;
#pragma unroll
      for (int t32 = 0; t32 < 2; ++t32)
#pragma unroll
        for (int r = 0; r < 16; ++r) mx = fmaxf(mx, st[t32][r]);
      mx = fmaxf(mx, __shfl_xor(mx, 32));
      const float mn = fmaxf(m, mx);
      const float alpha = ex2(m - mn);
      m = mn;
      float ps = 0.f;
#pragma unroll
      for (int t32 = 0; t32 < 2; ++t32)
#pragma unroll
        for (int r = 0; r < 16; ++r) { const float pv = ex2(st[t32][r] - mn); st[t32][r] = pv; ps += pv; }
      l = l * alpha + ps;
#pragma unroll
      for (int mt = 0; mt < 2; ++mt)
#pragma unroll
        for (int r = 0; r < 16; ++r) ot[mt][r] *= alpha;
      __builtin_amdgcn_s_setprio(1);
#pragma unroll
      for (int t32 = 0; t32 < 2; ++t32)
#pragma unroll
        for (int s = 0; s < 2; ++s) {
          const bf16x8 pf = pack8(st[t32], s);
#pragma unroll
          for (int mt = 0; mt < 2; ++mt) ot[mt] = MFMA(vf[t32][s][mt], pf, ot[mt]);
        }
      __builtin_amdgcn_s_setprio(0);
    }
  };
  MGLOAD(0, 0); MGLOAD(1, 1);
  MSWRITE(0, 0); __syncthreads();
  for (int kt = 0; kt < ntile; kt += 2) {
    if (kt + 2 < ntile) MGLOAD(0, kt + 2);
    __builtin_amdgcn_sched_barrier(0);
    compute(kt, 0); compute(kt, 1);
    MSWRITE(1, 1);
    __syncthreads();
    if (kt + 3 < ntile) MGLOAD(1, kt + 3);
    __builtin_amdgcn_sched_barrier(0);
    compute(kt + 1, 0); compute(kt + 1, 1);
    if (kt + 2 < ntile) MSWRITE(0, 0);
    __syncthreads();
  }
#undef MGLOAD
#undef MSWRITE
  l += __shfl_xor(l, 32);
  const float inv = 1.f / l;
#pragma unroll
  for (int mt = 0; mt < 2; ++mt)
#pragma unroll
    for (int qd = 0; qd < 4; ++qd) {
      const int e0 = mt * 32 + 8 * qd + 4 * hf;
      uint2 ov;
      ov.x = pack2(ot[mt][4 * qd + 0] * inv, ot[mt][4 * qd + 1] * inv);
      ov.y = pack2(ot[mt][4 * qd + 2] * inv, ot[mt][4 * qd + 3] * inv);
      *(uint2*)(o + tq * LDH + h * 64 + e0) = ov;
    }
}

DI void swa_item(const Params& p, int j, int b, int nblk, int kvh, char* smem) {
  const int tid = opqv(threadIdx.x) & 255, lane = tid & 63, w = tid >> 6, l32 = lane & 31, hf = lane >> 5;
  char* ws = opq(p.ws);
  const u16* SQ = (const u16*)(ws + OFF_SQ); const u16* SK = (const u16*)(ws + OFF_SK); const u16* SV = (const u16*)(ws + OFF_SV);
  u16* o = (u16*)(ws + OFF_OE);
  char* sk = smem; char* sv = smem + 256 * 144;
  const int ws0 = 128 * (nblk - 1);
#pragma unroll
  for (int i = 0; i < 8; ++i) {
    const int c = tid + 256 * i, row = c >> 3, ch = c & 7, pos = ws0 + row;
    uint4 kv = make_uint4(0, 0, 0, 0), vv = make_uint4(0, 0, 0, 0);
    if (pos >= 0) {
      kv = *(const uint4*)(SK + ((size_t)b * S_ + pos) * 128 + kvh * 64 + ch * 8);
      vv = *(const uint4*)(SV + ((size_t)b * S_ + pos) * 128 + kvh * 64 + ch * 8);
    }
    *(uint4*)(sk + row * 144 + ch * 16) = kv;
    char* vb = sv + (ch * 8) * 528 + row * 2;
    *(u16*)(vb + 0 * 528) = (u16)(vv.x & 0xffffu); *(u16*)(vb + 1 * 528) = (u16)(vv.x >> 16);
    *(u16*)(vb + 2 * 528) = (u16)(vv.y & 0xffffu); *(u16*)(vb + 3 * 528) = (u16)(vv.y >> 16);
    *(u16*)(vb + 4 * 528) = (u16)(vv.z & 0xffffu); *(u16*)(vb + 5 * 528) = (u16)(vv.z >> 16);
    *(u16*)(vb + 6 * 528) = (u16)(vv.w & 0xffffu); *(u16*)(vb + 7 * 528) = (u16)(vv.w >> 16);
  }
  __syncthreads();
  const size_t tq = (size_t)b * S_ + nblk * 128 + w * 32 + l32;
  const int qloc = 128 + w * 32 + l32;
#pragma unroll 1
  for (int g = 0; g < 4; ++g) {
    const int head = kvh * 4 + g;
    bf16x8 qf[4];
#pragma unroll
    for (int s = 0; s < 4; ++s) qf[s] = *(const bf16x8*)(SQ + tq * 512 + head * 64 + s * 16 + hf * 8);
    f32x16 st[5];
    const float sink2 = p.swa_sinks[j * 8 + head] * LOG2E;
    float mx = sink2;
#pragma unroll
    for (int tt = 0; tt < 5; ++tt) {
      const int kb = w * 32 + tt * 32;
      st[tt] = zero16();
#pragma unroll
      for (int s = 0; s < 4; ++s) {
        const bf16x8 kf = *(const bf16x8*)(sk + (kb + l32) * 144 + (s * 16 + hf * 8) * 2);
        st[tt] = MFMA(kf, qf[s], st[tt]);
      }
#pragma unroll
      for (int r = 0; r < 16; ++r) {
        const int kloc = kb + crow(r, hf);
        const bool valid = (kloc <= qloc) && (kloc > qloc - 128) && (ws0 + kloc >= 0);
        const float v = valid ? st[tt][r] : -1e30f;
        st[tt][r] = v; mx = fmaxf(mx, v);
      }
    }
    mx = fmaxf(mx, __shfl_xor(mx, 32));
    float ps = 0.f;
#pragma unroll
    for (int tt = 0; tt < 5; ++tt)
#pragma unroll
      for (int r = 0; r < 16; ++r) { const float pv = ex2(st[tt][r] - mx); st[tt][r] = pv; ps += pv; }
    ps += __shfl_xor(ps, 32);
    const float inv = 1.f / (ps + ex2(sink2 - mx));
    f32x16 ot[2]; ot[0] = zero16(); ot[1] = zero16();
#pragma unroll
    for (int tt = 0; tt < 5; ++tt) {
      const int kb = w * 32 + tt * 32;
#pragma unroll
      for (int s = 0; s < 2; ++s) {
        const bf16x8 pf = pack8(st[tt], s);
#pragma unroll
        for (int mt = 0; mt < 2; ++mt) {
          const char* vp = sv + (mt * 32 + l32) * 528 + (kb + s * 16 + hf * 4) * 2;
          const bf16x8 vf = join8(*(const uint2*)vp, *(const uint2*)(vp + 16));
          ot[mt] = MFMA(vf, pf, ot[mt]);
        }
      }
    }
#pragma unroll
    for (int mt = 0; mt < 2; ++mt)
#pragma unroll
      for (int qd = 0; qd < 4; ++qd) {
        const int e0 = mt * 32 + 8 * qd + 4 * hf;
        uint2 ov;
        ov.x = pack2(ot[mt][4 * qd + 0] * inv, ot[mt][4 * qd + 1] * inv);
        ov.y = pack2(ot[mt][4 * qd + 2] * inv, ot[mt][4 * qd + 3] * inv);
        *(uint2*)(o + tq * LDH + 512 + head * 64 + e0) = ov;
      }
  }
  __syncthreads();
}

DI void attn_phase(const Params& p, int j, int ctr_idx, char* smem) {
  __shared__ int s_item;
  const int xcd = blockIdx.x & 7;
  int* ctr = (int*)(p.ws + OFF_CTR) + 16 + ctr_idx * 8 + xcd;
  const int nmla = 128, nswa = 32;
  const int half = opqv(threadIdx.x) >> 8;
  char* sm = smem + half * HALF_SMEM;
  for (;;) {
    __syncthreads();
    if (threadIdx.x == 0) s_item = atomicAdd(ctr, 1);
    __syncthreads();
    const int it = s_item;
    if (it >= nmla + nswa) break;
    if (it < nmla) {
      const int qb = 63 - (it >> 1), bh = xcd * 2 + (it & 1);
      mla_item(p, qb, bh >> 3, bh & 7, smem);
    } else {
      const int k = (xcd * nswa + (it - nmla)) * 2 + half;
      swa_item(p, j, k >> 8, (k >> 1) & 127, k & 1, sm);
    }
  }
}

DI void rec_in_phase(const Params& p, int j, char* smem) {
  const int tid = opqv(threadIdx.x), lane = tid & 63, w = tid >> 6, wm = w >> 2, wn = w & 3, l32 = lane & 31, hf = lane >> 5;
  char* ws = opq(p.ws);
  const u16* A = (const u16*)(ws + OFF_HY);
  const u16* Wt = (const u16*)(ws + OFF_W_RECIN) + (size_t)j * 2560 * LDW1;
  u16* zr = (u16*)(ws + OFF_ZR); u16* ug = (u16*)(ws + OFF_UG);
  const float2* rt128 = (const float2*)(ws + OFF_RT128);
  const int nN = 10;
  for (int lt = blockIdx.x >> 3; lt < 16 * nN; lt += gridDim.x >> 3) {
    int mt, nt; tile_map(lt, 16, nN, 16, 2, mt, nt);
    const int m0 = mt * 256, n0 = nt * 256;
    gemm_tile(A + (size_t)m0 * LDH, LDH, 16, nullptr, 0, 0, Wt + (size_t)n0 * LDW1, LDW1, smem, [&](f32x16(&acc)[2][2], int moff) {
      const int m0_ = m0 + moff;
      int l32_ = l32, hf_ = hf; asm volatile("" : "+v"(l32_), "+v"(hf_));
      const int C64 = n0 + wn * 64;
#pragma unroll
      for (int i = 0; i < 2; ++i) {
        const int rb = m0_ + wm * 64 + i * 32;
        if (C64 < 1024) {
          const int fi = ((C64 & 127) >> 1) + l32_, cbase = C64 & ~127;
          const float sc = (C64 >= 512) ? RET_KSCALE : 1.f;
#pragma unroll
          for (int r = 0; r < 16; ++r) {
            const int t = rb + crow(r, hf_), pos = t & (S_ - 1);
            const float2 cs = rt128[pos * 64 + fi];
            const float x1 = acc[i][0][r], x2 = acc[i][1][r];
            zr[(size_t)t * LDZR + cbase + fi] = f2bf((x1 * cs.x - x2 * cs.y) * sc);
            zr[(size_t)t * LDZR + cbase + 64 + fi] = f2bf((x2 * cs.x + x1 * cs.y) * sc);
          }
        } else if (C64 < 2048) {
#pragma unroll
          for (int jn = 0; jn < 2; ++jn)
#pragma unroll
            for (int r = 0; r < 16; ++r) zr[(size_t)(rb + crow(r, hf_)) * LDZR + C64 + jn * 32 + l32_] = f2bf(acc[i][jn][r]);
        } else {
#pragma unroll
          for (int jn = 0; jn < 2; ++jn) {
            const int cl = C64 - 2048 + jn * 32 + l32_, g = cl >> 4, pp = cl & 15;
#pragma unroll
            for (int r = 0; r < 16; ++r) ug[((size_t)g * T_ + rb + crow(r, hf_)) * 16 + pp] = f2bf(acc[i][jn][r]);
          }
        }
      }
    });
  }
}

DI void s5_fill(const Params& p, int j) {
  const int tid = opqv(threadIdx.x), nb = gridDim.x, bid = blockIdx.x;
  char* ws = opq(p.ws);
  const float4* s5z = (const float4*)(ws + OFF_S5Z) + j * 2048; const float2* bbar = (const float2*)(ws + OFF_BBAR) + j * 2048 * 16;
  const float* ktab = (const float*)(ws + OFF_KTAB) + (size_t)j * 32 * 32 * 256;
  u16* WE = (u16*)(ws + OFF_WE); u16* WY = (u16*)(ws + OFF_WY);
  for (int idx = bid * NTHR + tid; idx < 32 * 256 * 512; idx += nb * NTHR) {
    const int g = idx >> 17, n2 = (idx >> 9) & 255, k = idx & 511, jj = k >> 4, q = k & 15, n = n2 & 63;
    if (n2 >= 128) { WE[idx] = 0; continue; }
    const float4 z = s5z[g * 64 + n];
    const float d = (float)(31 - jj);
    const float mg = expf(d * z.x), ang = d * z.y; float sn_, cs_; sincos_(ang, sn_, cs_);
    const float er = mg * cs_, ei = mg * sn_;
    const float2 bb = bbar[(g * 64 + n) * 16 + q];
    const float v = (n2 < 64) ? (er * bb.x - ei * bb.y) : (er * bb.y + ei * bb.x);
    WE[idx] = f2bf(v);
  }
  for (int idx = bid * NTHR + tid; idx < 32 * 512 * 640; idx += nb * NTHR) {
    const int g = idx / (512 * 640), rem = idx - g * (512 * 640), mrow = rem / 640, k = rem - mrow * 640;
    const int i = mrow >> 4, pp = mrow & 15;
    float v;
    if (k < 512) {
      const int jj = k >> 4, q = k & 15, d = i - jj;
      v = (d >= 0) ? ktab[(g * 32 + d) * 256 + pp * 16 + q] : 0.f;
      if (d == 0 && q == pp) v += p.s5_d[j * 512 + g * 16 + pp];
    } else {
      const int n2 = k - 512, n = n2 & 63;
      const float4 z = s5z[g * 64 + n];
      const float d = (float)(i + 1);
      const float mg = expf(d * z.x), ang = d * z.y; float sn_, cs_; sincos_(ang, sn_, cs_);
    const float er = mg * cs_, ei = mg * sn_;
      const float cr = p.s5_c_re[((j * 32 + g) * 16 + pp) * 64 + n], ci = p.s5_c_im[((j * 32 + g) * 16 + pp) * 64 + n];
      v = (n2 < 64) ? (cr * er - ci * ei) : -(cr * ei + ci * er);
    }
    WY[idx] = f2bf(v);
  }
}

DI void ret_u_item(const Params& p, int b, int n, int h, char* smem) {
  const int tid = opqv(threadIdx.x) & 255, lane = tid & 63, w = tid >> 6, wm = w >> 1, wn = w & 1, l32 = lane & 31, hf = lane >> 5;
  char* ws = opq(p.ws);
  const u16* zr = (const u16*)(ws + OFF_ZR); float* U = (float*)(ws + OFF_UO);
  char* sKt = smem; char* sVt = smem + 128 * 272;
  const size_t t0 = (size_t)b * S_ + n * 128;
  const float lg = lg2gamma(h);
#pragma unroll
  for (int i = 0; i < 8; ++i) {
    const int c = tid + 256 * i, row = c >> 4, ch = c & 15;
    const uint4 kv = *(const uint4*)(zr + (t0 + row) * LDZR + 512 + h * 128 + ch * 8);
    const uint4 vv = *(const uint4*)(zr + (t0 + row) * LDZR + 1024 + h * 128 + ch * 8);
    const float te = ex2((float)(127 - row) * lg);
    char* kb = sKt + (ch * 8) * 272 + row * 2; char* vb = sVt + (ch * 8) * 272 + row * 2;
    *(u16*)(kb + 0 * 272) = f2bf(bf2f(kv.x & 0xffffu) * te); *(u16*)(kb + 1 * 272) = f2bf(bf2f(kv.x >> 16) * te);
    *(u16*)(kb + 2 * 272) = f2bf(bf2f(kv.y & 0xffffu) * te); *(u16*)(kb + 3 * 272) = f2bf(bf2f(kv.y >> 16) * te);
    *(u16*)(kb + 4 * 272) = f2bf(bf2f(kv.z & 0xffffu) * te); *(u16*)(kb + 5 * 272) = f2bf(bf2f(kv.z >> 16) * te);
    *(u16*)(kb + 6 * 272) = f2bf(bf2f(kv.w & 0xffffu) * te); *(u16*)(kb + 7 * 272) = f2bf(bf2f(kv.w >> 16) * te);
    *(u16*)(vb + 0 * 272) = (u16)(vv.x & 0xffffu); *(u16*)(vb + 1 * 272) = (u16)(vv.x >> 16);
    *(u16*)(vb + 2 * 272) = (u16)(vv.y & 0xffffu); *(u16*)(vb + 3 * 272) = (u16)(vv.y >> 16);
    *(u16*)(vb + 4 * 272) = (u16)(vv.z & 0xffffu); *(u16*)(vb + 5 * 272) = (u16)(vv.z >> 16);
    *(u16*)(vb + 6 * 272) = (u16)(vv.w & 0xffffu); *(u16*)(vb + 7 * 272) = (u16)(vv.w >> 16);
  }
  __syncthreads();
  f32x16 acc[2][2];
#pragma unroll
  for (int i = 0; i < 2; ++i)
#pragma unroll
    for (int jn = 0; jn < 2; ++jn) acc[i][jn] = zero16();
#pragma unroll
  for (int s = 0; s < 8; ++s) {
    bf16x8 af[2], bfr[2];
#pragma unroll
    for (int i = 0; i < 2; ++i) af[i] = *(const bf16x8*)(sVt + (wm * 64 + i * 32 + l32) * 272 + (s * 16 + hf * 8) * 2);
#pragma unroll
    for (int jn = 0; jn < 2; ++jn) bfr[jn] = *(const bf16x8*)(sKt + (wn * 64 + jn * 32 + l32) * 272 + (s * 16 + hf * 8) * 2);
#pragma unroll
    for (int i = 0; i < 2; ++i)
#pragma unroll
      for (int jn = 0; jn < 2; ++jn) acc[i][jn] = MFMA(af[i], bfr[jn], acc[i][jn]);
  }
  float* Ub = U + ((size_t)((b * 4 + h) * 128 + n)) * 16384;
#pragma unroll
  for (int i = 0; i < 2; ++i)
#pragma unroll
    for (int jn = 0; jn < 2; ++jn)
#pragma unroll
      for (int r = 0; r < 16; ++r) Ub[(wm * 64 + i * 32 + crow(r, hf)) * 128 + wn * 64 + jn * 32 + l32] = acc[i][jn][r];
  __syncthreads();
}

DI void rec_state_phase(const Params& p, int j, char* smem) {
  const int tid = opqv(threadIdx.x), lane = tid & 63, w = tid >> 6, wm = w >> 2, wn = w & 3, l32 = lane & 31, hf = lane >> 5;
  char* ws = opq(p.ws);
  {
    const int half = opqv(threadIdx.x) >> 8;
    char* sm = smem + half * HALF_SMEM;
    for (int it = blockIdx.x; it < 512; it += gridDim.x) { const int item = it * 2 + half; ret_u_item(p, item >> 9, (item >> 2) & 127, item & 3, sm); }
  }
  for (int it = blockIdx.x; it < 128; it += gridDim.x) {
    const int g = it >> 2, mt = it & 3, m0 = mt * 256;
    const u16* A = (const u16*)(ws + OFF_UG) + (size_t)g * T_ * 16 + (size_t)m0 * 512;
    const u16* Bt = (const u16*)(ws + OFF_WE) + (size_t)g * 256 * 512;
    float* E = (float*)(ws + OFF_EB) + (size_t)g * 1024 * 128;
    gemm_tile(A, 512, 8, nullptr, 0, 0, Bt, 512, smem, [&](f32x16(&acc)[2][2], int moff) {
      int l32_ = l32, hf_ = hf; asm volatile("" : "+v"(l32_), "+v"(hf_));
      const int m0_ = m0 + moff;
      if (wn < 2) {
#pragma unroll
        for (int i = 0; i < 2; ++i)
#pragma unroll
          for (int jn = 0; jn < 2; ++jn)
#pragma unroll
            for (int r = 0; r < 16; ++r)
              E[(size_t)(m0_ + wm * 64 + i * 32 + crow(r, hf_)) * 128 + wn * 64 + jn * 32 + l32_] = acc[i][jn][r];
      }
    });
  }
}

DI void scan_phase(const Params& p, int j, char* smem) {
  const int tfull = opqv(threadIdx.x);
  const int tid = tfull & 255, half = tfull >> 8;
  char* ws = opq(p.ws);
  for (int it = blockIdx.x; it < 128; it += gridDim.x) {
    if (it < 64) {
      const int vb = it * 2 + half;
      const int idx = vb * 256 + tid, bh = idx >> 12, e4 = (idx & 4095) * 4, h = bh & 3;
      const float cd = ex2(128.f * lg2gamma(h));
      const float* U = (const float*)(ws + OFF_UO) + (size_t)bh * 128 * 16384 + e4;
      u16* Sp = (u16*)(ws + OFF_SP) + (size_t)bh * 128 * 16384 + e4;
      float4 S = make_float4(0, 0, 0, 0);
      for (int n0 = 0; n0 < 128; n0 += 16) {
        f32x4 u[16];
#pragma unroll
        for (int k = 0; k < 16; ++k) u[k] = *(const f32x4*)(U + (size_t)(n0 + k) * 16384);
#pragma unroll
        for (int k = 0; k < 16; ++k) {
          *(uint2*)(Sp + (size_t)(n0 + k) * 16384) = make_uint2(pack2(S.x, S.y), pack2(S.z, S.w));
          S.x = cd * S.x + u[k].x; S.y = cd * S.y + u[k].y; S.z = cd * S.z + u[k].z; S.w = cd * S.w + u[k].w;
        }
      }
    } else {
      const int bg = it - 64, b = bg >> 5, g = bg & 31, n = tfull & 63, seg = tfull >> 6;
      const float4 z = ((const float4*)(ws + OFF_S5Z))[(j * 32 + g) * 64 + n];
      const float mg = expf(32.f * z.x), ang = 32.f * z.y; float sn_, cs_; sincos_(ang, sn_, cs_);
      const float ar = mg * cs_, ai = mg * sn_;
      float br = ar, bi = ai;
#pragma unroll
      for (int t = 0; t < 6; ++t) { const float nr = br * br - bi * bi, ni = 2.f * br * bi; br = nr; bi = ni; }
      const float* E = (const float*)(ws + OFF_EB) + ((size_t)g * 1024 + b * 512 + seg * 64) * 128;
      u16* Xp = (u16*)(ws + OFF_XP) + ((size_t)g * 1024 + b * 512 + seg * 64) * 128;
      float2* Ls = (float2*)smem;
      float xr = 0.f, xi = 0.f;
      for (int c0 = 0; c0 < 64; c0 += 32) {
        float er[32], ei[32];
#pragma unroll
        for (int k = 0; k < 32; ++k) { er[k] = E[(c0 + k) * 128 + n]; ei[k] = E[(c0 + k) * 128 + 64 + n]; }
#pragma unroll
        for (int k = 0; k < 32; ++k) {
          const float nr = ar * xr - ai * xi + er[k], ni = ar * xi + ai * xr + ei[k];
          xr = nr; xi = ni;
        }
      }
      Ls[seg * 64 + n] = make_float2(xr, xi);
      __syncthreads();
      xr = 0.f; xi = 0.f;
      for (int s2 = 0; s2 < seg; ++s2) {
        const float2 L = Ls[s2 * 64 + n];
        const float nr = br * xr - bi * xi + L.x, ni = br * xi + bi * xr + L.y;
        xr = nr; xi = ni;
      }
      for (int c0 = 0; c0 < 64; c0 += 32) {
        float er[32], ei[32];
#pragma unroll
        for (int k = 0; k < 32; ++k) { er[k] = E[(c0 + k) * 128 + n]; ei[k] = E[(c0 + k) * 128 + 64 + n]; }
#pragma unroll
        for (int k = 0; k < 32; ++k) {
          Xp[(c0 + k) * 128 + n] = f2bf(xr); Xp[(c0 + k) * 128 + 64 + n] = f2bf(xi);
          const float nr = ar * xr - ai * xi + er[k], ni = ar * xi + ai * xr + ei[k];
          xr = nr; xi = ni;
        }
      }
      __syncthreads();
    }
  }
}

DI void ret_out_item(const Params& p, int b, int n, int h, char* smem) {
  const int tid = opqv(threadIdx.x) & 255, lane = tid & 63, w = tid >> 6, l32 = lane & 31, hf = lane >> 5;
  char* ws = opq(p.ws);
  const u16* zr = (const u16*)(ws + OFF_ZR); u16* o = (u16*)(ws + OFF_UO);
  char* sK = smem; char* sVt = smem + 128 * 272;
  const size_t t0 = (size_t)b * S_ + n * 128;
  const float lg = lg2gamma(h);
#pragma unroll
  for (int i = 0; i < 8; ++i) {
    const int c = tid + 256 * i, row = c >> 4, ch = c & 15;
    const uint4 kv = *(const uint4*)(zr + (t0 + row) * LDZR + 512 + h * 128 + ch * 8);
    const uint4 vv = *(const uint4*)(zr + (t0 + row) * LDZR + 1024 + h * 128 + ch * 8);
    *(uint4*)(sK + row * 272 + ch * 16) = kv;
    char* vb = sVt + (ch * 8) * 272 + row * 2;
    *(u16*)(vb + 0 * 272) = (u16)(vv.x & 0xffffu); *(u16*)(vb + 1 * 272) = (u16)(vv.x >> 16);
    *(u16*)(vb + 2 * 272) = (u16)(vv.y & 0xffffu); *(u16*)(vb + 3 * 272) = (u16)(vv.y >> 16);
    *(u16*)(vb + 4 * 272) = (u16)(vv.z & 0xffffu); *(u16*)(vb + 5 * 272) = (u16)(vv.z >> 16);
    *(u16*)(vb + 6 * 272) = (u16)(vv.w & 0xffffu); *(u16*)(vb + 7 * 272) = (u16)(vv.w >> 16);
  }
  __syncthreads();
  const size_t tq = t0 + w * 32 + l32;
  const int qi = w * 32 + l32;
  bf16x8 qf[8];
#pragma unroll
  for (int s = 0; s < 8; ++s) qf[s] = *(const bf16x8*)(zr + tq * LDZR + h * 128 + s * 16 + hf * 8);
  f32x16 ot[4];
  const u16* Sp = (const u16*)(ws + OFF_SP) + ((size_t)((b * 4 + h) * 128 + n)) * 16384;
#pragma unroll
  for (int mt = 0; mt < 4; ++mt) {
    ot[mt] = zero16();
#pragma unroll
    for (int s = 0; s < 8; ++s) {
      const bf16x8 sf = *(const bf16x8*)(Sp + (mt * 32 + l32) * 128 + s * 16 + hf * 8);
      ot[mt] = MFMA(sf, qf[s], ot[mt]);
    }
  }
  const float fs = ex2((float)(qi + 1) * lg);
#pragma unroll
  for (int mt = 0; mt < 4; ++mt)
#pragma unroll
    for (int r = 0; r < 16; ++r) ot[mt][r] *= fs;
#pragma unroll
  for (int tt = 0; tt < 4; ++tt) {
    if (tt <= w) {
      f32x16 st = zero16();
#pragma unroll
      for (int s = 0; s < 8; ++s) {
        const bf16x8 kf = *(const bf16x8*)(sK + (tt * 32 + l32) * 272 + (s * 16 + hf * 8) * 2);
        st = MFMA(kf, qf[s], st);
      }
#pragma unroll
      for (int r = 0; r < 16; ++r) {
        const int dd = qi - (tt * 32 + crow(r, hf));
        st[r] = (dd >= 0) ? st[r] * ex2((float)dd * lg) : 0.f;
      }
#pragma unroll
      for (int s2 = 0; s2 < 2; ++s2) {
        const bf16x8 pf = pack8(st, s2);
#pragma unroll
        for (int mt = 0; mt < 4; ++mt) {
          const char* vp = sVt + (mt * 32 + l32) * 272 + (tt * 32 + s2 * 16 + hf * 4) * 2;
          const bf16x8 vf = join8(*(const uint2*)vp, *(const uint2*)(vp + 16));
          ot[mt] = MFMA(vf, pf, ot[mt]);
        }
      }
    }
  }
  float sum = 0.f;
#pragma unroll
  for (int mt = 0; mt < 4; ++mt)
#pragma unroll
    for (int r = 0; r < 16; ++r) sum += ot[mt][r];
  sum += __shfl_xor(sum, 32);
  const float mean = sum * (1.f / 128.f);
  float vs = 0.f;
#pragma unroll
  for (int mt = 0; mt < 4; ++mt)
#pragma unroll
    for (int r = 0; r < 16; ++r) { const float d = ot[mt][r] - mean; vs += d * d; }
  vs += __shfl_xor(vs, 32);
  const float rstd = rsqrtf(vs * (1.f / 128.f) + 1e-5f);
#pragma unroll
  for (int mt = 0; mt < 4; ++mt)
#pragma unroll
    for (int qd = 0; qd < 4; ++qd) {
      const int e0 = mt * 32 + 8 * qd + 4 * hf;
      const uint2 gv = *(const uint2*)(zr + tq * LDZR + 1536 + h * 128 + e0);
      const float g0 = bf2f(gv.x & 0xffffu), g1 = bf2f(gv.x >> 16), g2 = bf2f(gv.y & 0xffffu), g3 = bf2f(gv.y >> 16);
      const float o0 = g0 / (1.f + __expf(-g0)) * (ot[mt][4 * qd + 0] - mean) * rstd;
      const float o1 = g1 / (1.f + __expf(-g1)) * (ot[mt][4 * qd + 1] - mean) * rstd;
      const float o2 = g2 / (1.f + __expf(-g2)) * (ot[mt][4 * qd + 2] - mean) * rstd;
      const float o3 = g3 / (1.f + __expf(-g3)) * (ot[mt][4 * qd + 3] - mean) * rstd;
      *(uint2*)(o + tq * LDH + h * 128 + e0) = make_uint2(pack2(o0, o1), pack2(o2, o3));
    }
  __syncthreads();
}

DI float gelu_tanh(float y) {
  const float u = 0.7978845608028654f * (y + 0.044715f * y * y * y);
  const float e = __expf(2.f * u);
  const float th = 1.f - 2.f / (e + 1.f);
  return 0.5f * y * (1.f + th);
}

DI void rec_out_phase(const Params& p, int j, char* smem) {
  const int tid = opqv(threadIdx.x), lane = tid & 63, w = tid >> 6, wm = w >> 2, wn = w & 3, l32 = lane & 31, hf = lane >> 5;
  char* ws = opq(p.ws);
  {
    const int half = opqv(threadIdx.x) >> 8;
    char* sm = smem + half * HALF_SMEM;
    for (int it = blockIdx.x; it < 512; it += gridDim.x) { const int item = it * 2 + half; ret_out_item(p, item >> 9, (item >> 2) & 127, item & 3, sm); }
  }
  for (int it = blockIdx.x; it < 256; it += gridDim.x) {
    {
      const int k = it, g = k >> 3, mt = (k >> 1) & 3, nt = k & 1, m0 = mt * 256, n0 = nt * 256;
      const u16* Ug = (const u16*)(ws + OFF_UG) + (size_t)g * T_ * 16;
      const u16* A1 = Ug + (size_t)m0 * 512;
      const u16* A2 = (const u16*)(ws + OFF_XP) + ((size_t)g * 1024 + m0) * 128;
      const u16* Bt = (const u16*)(ws + OFF_WY) + ((size_t)g * 512 + n0) * 640;
      u16* yt = (u16*)(ws + OFF_YT);
      gemm_tile(A1, 512, 8, A2, 128, 2, Bt, 640, smem, [&](f32x16(&acc)[2][2], int moff) {
      const int m0_ = m0 + moff;
      int l32_ = l32, hf_ = hf; asm volatile("" : "+v"(l32_), "+v"(hf_));
#pragma unroll
        for (int i = 0; i < 2; ++i)
#pragma unroll
          for (int jn = 0; jn < 2; ++jn)
#pragma unroll
            for (int r = 0; r < 16; ++r) {
              const int R = m0_ + wm * 64 + i * 32 + crow(r, hf_), col = n0 + wn * 64 + jn * 32 + l32_;
              const int ii = col >> 4, pp = col & 15;
              const size_t t = (size_t)R * 32 + ii;
              const float y = acc[i][jn][r];
              yt[t * LDYT + g * 16 + pp] = f2bf(gelu_tanh(y));
            }
      });
    }
  }
}

DI void glu_phase(const Params& p, int j, char* smem) {
  const int tid = opqv(threadIdx.x), lane = tid & 63, w = tid >> 6, wm = w >> 2, wn = w & 3, l32 = lane & 31, hf = lane >> 5;
  char* ws = opq(p.ws);
  const u16* yt = (const u16*)(ws + OFF_YT);
  const u16* Wt = (const u16*)(ws + OFF_W_GLU) + (size_t)j * 512 * LDGLU;
  u16* o = (u16*)(ws + OFF_UO);
  const float* gb = p.s5_glu_b + j * 512;
  const int nN = 2;
  for (int lt = blockIdx.x >> 3; lt < 16 * nN; lt += gridDim.x >> 3) {
    int mt, nt; tile_map(lt, 16, nN, 16, 2, mt, nt);
    const int m0 = mt * 256, n0 = nt * 256;
    gemm_tile(yt + (size_t)m0 * LDYT, LDYT, 8, nullptr, 0, 0, Wt + (size_t)n0 * LDGLU, LDGLU, smem, [&](f32x16(&acc)[2][2], int moff) {
      const int m0_ = m0 + moff;
      int l32_ = l32, hf_ = hf; asm volatile("" : "+v"(l32_), "+v"(hf_));
#pragma unroll
      for (int i = 0; i < 2; ++i)
#pragma unroll
        for (int jn = 0; jn < 2; ++jn)
#pragma unroll
          for (int r = 0; r < 16; ++r) {
            const int row = m0_ + wm * 64 + i * 32 + crow(r, hf_), col = n0 + wn * 64 + jn * 32 + l32_;
            const float gt = acc[i][jn][r] + gb[col];
            const float y = bf2f(yt[(size_t)row * LDYT + col]);
            o[(size_t)row * LDH + 512 + col] = f2bf(y / (1.f + __expf(-gt)));
          }
    });
  }
}

DI void run_phase(const Params& p, int ph, char* smem, int rep) {
  char* ws = opq(p.ws);
  if (ph == 0) { phase0(p, smem); return; }
  if (ph == 1) { phase1(p); return; }
  const int q = ph - 2, pair = q / 18, r = q % 18;
  const bool odd = r >= 8;
  const int k = odd ? r - 8 : r;
  const int l = pair * 2 + (odd ? 1 : 0), j = pair;
  int op = 2, pm = 0, ls = 0;
  if (!odd) {
    if (k == 3) { op = 0; pm = 0; } else if (k == 5) { op = 0; pm = 1; } else if (k == 6) { op = 0; pm = 2; }
    else if (k == 4) { op = 1; ls = 2 * l; } else if (k == 7) { op = 1; ls = 2 * l + 1; }
  } else {
    if (k == 5) { op = 0; pm = 0; } else if (k == 7) { op = 0; pm = 1; } else if (k == 8) { op = 0; pm = 2; }
    else if (k == 6) { op = 1; ls = 2 * l; } else if (k == 9) { op = 1; ls = 2 * l + 1; }
  }
  if (op == 0) {
    const u16* A; const u16* W; u16* C; int K, N, mode, lda, ldb, ldc;
    if (pm == 0) {
      A = (const u16*)(ws + (odd ? OFF_UO : OFF_OE)); lda = LDH;
      W = (const u16*)(ws + (odd ? OFF_W_RECOUT : OFF_W_ATTOUT)) + (size_t)j * 1024 * LDW1; ldb = LDW1;
      C = (u16*)(ws + OFF_HY); ldc = LDH; K = 1024; N = 1024; mode = 0;
    } else if (pm == 1) {
      A = (const u16*)(ws + OFF_HY); lda = LDH; W = (const u16*)(ws + OFF_W1) + (size_t)l * 4096 * LDW1; ldb = LDW1;
      C = (u16*)(ws + OFF_HID); ldc = LDHID; K = 1024; N = 4096; mode = 1;
    } else {
      A = (const u16*)(ws + OFF_HID); lda = LDHID; W = (const u16*)(ws + OFF_W2) + (size_t)l * 1024 * LDW2; ldb = LDW2;
      C = (u16*)(ws + OFF_HY); ldc = LDH; K = 4096; N = 1024; mode = 0;
    }
#ifdef PROBE_VARIANT
    if (rep) gemm_plain<PROBE_VARIANT>(A, lda, K, W, ldb, N, C, ldc, mode, smem); else
#endif
    gemm_plain<0>(A, lda, K, W, ldb, N, C, ldc, mode, smem);
  } else if (op == 1) {
    ln_phase(p, ls);
  } else if (!odd) {
    if (k == 0) att_in_phase(p, j, smem);
    else if (k == 1) qkv_phase(p, j, smem);
    else attn_phase(p, j, j + 4 * rep, smem);
  } else {
    if (k == 0) { rec_in_phase(p, j, smem); s5_fill(p, j); }
    else if (k == 1) rec_state_phase(p, j, smem);
    else if (k == 2) scan_phase(p, j, smem);
    else if (k == 3) rec_out_phase(p, j, smem);
    else glu_phase(p, j, smem);
  }
}

__global__ void __launch_bounds__(512, 2) mega_kernel(Params p, int ph0, int ph1) {
  extern __shared__ __attribute__((aligned(16))) char smem[];
  cg::grid_group grid = cg::this_grid();
  __shared__ uint4 xb_words;
  if (threadIdx.x == 0) xb_words = make_uint4(0u, 0u, 0u, 0u);
  __syncthreads();
  XcdBarrier xb = xcd_barrier_post((unsigned*)(p.ws + OFF_BAR), (volatile LAS unsigned*)&xb_words);
  for (int ph = ph0; ph < ph1; ++ph) {
    run_phase(p, ph, smem, 0);
#ifdef PROBE_MASK
    if (ph >= 2 && ((PROBE_MASK >> ((ph - 2) % 18)) & 1)) { xcd_barrier(xb); run_phase(p, ph, smem, 1); }
#endif
    if (ph + 1 < ph1) { if (ph == ph0) grid.sync(); else xcd_barrier(xb); }
  }
}

__global__ void fail_fill(float* out, int n) {
  int i = blockIdx.x * 256 + threadIdx.x;
  if (i < n) out[i] = 0.f;
}

extern "C" void kernel_launch(void* const* d_in, const int* in_sizes, int n_in, void* d_out, int out_size, void* d_ws,
                              size_t ws_size, hipStream_t stream) {
  Params p{};
  const float** fp = (const float**)&p;
  for (int i = 0; i < 27; ++i) fp[i] = (const float*)d_in[i];
  p.out = (float*)d_out;
  p.ws = (char*)d_ws;
  if (ws_size < WS_NEED) {
    fail_fill<<<(out_size + 255) / 256, 256, 0, stream>>>((float*)d_out, out_size);
    return;
  }
  static int grid_blocks = 0;
  if (!grid_blocks) {
    hipFuncSetAttribute((const void*)mega_kernel, hipFuncAttributeMaxDynamicSharedMemorySize, SMEM_BYTES);
    int dev = 0, cus = 0, per_cu = 0;
    hipGetDevice(&dev);
    hipDeviceGetAttribute(&cus, hipDeviceAttributeMultiprocessorCount, dev);
    hipOccupancyMaxActiveBlocksPerMultiprocessor(&per_cu, mega_kernel, NTHR, SMEM_BYTES);
    if (per_cu > 1) per_cu = 1;
    if (per_cu < 1) per_cu = 1;
    grid_blocks = cus * per_cu;
  }
  (void)hipMemsetAsync((char*)d_ws + OFF_BAR, 0, XCD_BAR_WORDS * 4, stream);
  int ph0 = 0, ph1 = NPHASE;
  void* args[] = {&p, &ph0, &ph1};
  hipError_t e = hipLaunchCooperativeKernel((void*)mega_kernel, dim3(grid_blocks), dim3(NTHR), args, SMEM_BYTES, stream);
  if (e != hipSuccess) fprintf(stderr, "cooperative launch failed: %s (grid %d)\n", hipGetErrorString(e), grid_blocks);
}
static_assert(WS_NEED <= (size_t)536870912, "workspace budget exceeded");
```

```cpp
#include <hip/hip_runtime.h>
#include <hip/hip_cooperative_groups.h>
#include <cstdio>
namespace cg = cooperative_groups;

typedef unsigned short u16;
using bf16x8 = __attribute__((ext_vector_type(8))) short;
using f32x16 = __attribute__((ext_vector_type(16))) float;
using u32x4 = __attribute__((ext_vector_type(4))) unsigned;
typedef __attribute__((address_space(3))) unsigned lds_u32;
using f32x4 = __attribute__((ext_vector_type(4))) float;
#define DI __device__ __forceinline__
#define MFMA(a, b, c) __builtin_amdgcn_mfma_f32_32x32x16_bf16((a), (b), (c), 0, 0, 0)

constexpr int T_ = 32768, S_ = 16384;
constexpr float LOG2E = 1.4426950408889634f;
constexpr float DN_ALPHA = 1.6817928305074290f;
constexpr float MLA_QSCALE = 0.10206207261596575f * LOG2E;
constexpr float SWA_QSCALE = 0.125f * LOG2E;
constexpr float RET_KSCALE = 0.08838834764831845f;
constexpr int LDH = 1088, LDHID = 4160, LDW1 = 1088, LDW2 = 4160, LDV = S_ + 64, LDKB = 832, LDZR = 2112, LDYT = 576, LDGLU = 576;

constexpr size_t OFF_MOD = 0;
constexpr size_t OFF_CTR = OFF_MOD + 8 * 2 * 3072 * 4;
constexpr size_t OFF_BAR = OFF_CTR + 256;
constexpr size_t OFF_RT32 = OFF_BAR + 16384;
constexpr size_t OFF_RT64 = OFF_RT32 + (size_t)S_ * 16 * 8;
constexpr size_t OFF_RT128 = OFF_RT64 + (size_t)S_ * 32 * 8;
constexpr size_t OFF_S5Z = OFF_RT128 + (size_t)S_ * 64 * 8;
constexpr size_t OFF_BBAR = OFF_S5Z + 2 * 32 * 64 * 16;
constexpr size_t OFF_KTAB = OFF_BBAR + 2 * 32 * 64 * 16 * 8;
constexpr size_t OFF_W_ATTIN = OFF_KTAB + 2 * 32 * 32 * 256 * 4;
constexpr size_t OFF_W_UQ = OFF_W_ATTIN + (size_t)2 * 1536 * LDW1 * 2;
constexpr size_t OFF_W_UKV = OFF_W_UQ + (size_t)2 * 768 * 384 * 2;
constexpr size_t OFF_W_ATTOUT = OFF_W_UKV + (size_t)2 * 1024 * 256 * 2;
constexpr size_t OFF_W_RECIN = OFF_W_ATTOUT + (size_t)2 * 1024 * LDW1 * 2;
constexpr size_t OFF_W_GLU = OFF_W_RECIN + (size_t)2 * 2560 * LDW1 * 2;
constexpr size_t OFF_W_RECOUT = OFF_W_GLU + (size_t)2 * 512 * LDGLU * 2;
constexpr size_t OFF_W1 = OFF_W_RECOUT + (size_t)2 * 1024 * LDW1 * 2;
constexpr size_t OFF_W2 = OFF_W1 + (size_t)4 * 4096 * LDW1 * 2;
constexpr size_t OFF_WE = OFF_W2 + (size_t)4 * 1024 * LDW2 * 2;
constexpr size_t OFF_WY = OFF_WE + (size_t)32 * 256 * 512 * 2;
constexpr size_t OFF_HY = OFF_WY + (size_t)32 * 512 * 640 * 2;
constexpr size_t OFF_RA = OFF_HY + (size_t)T_ * LDH * 2;
constexpr size_t OFF_ZC = OFF_RA;
constexpr size_t OFF_QB = OFF_ZC + (size_t)T_ * 640 * 2;
constexpr size_t OFF_KB = OFF_QB + (size_t)T_ * 768 * 2;
constexpr size_t OFF_VT = OFF_KB + (size_t)T_ * LDKB * 2;
constexpr size_t OFF_SQ = OFF_VT + (size_t)2 * 8 * 64 * LDV * 2;
constexpr size_t OFF_SK = OFF_SQ + (size_t)T_ * 512 * 2;
constexpr size_t OFF_SV = OFF_SK + (size_t)T_ * 128 * 2;
constexpr size_t OFF_OE = OFF_SV + (size_t)T_ * 128 * 2;
constexpr size_t END_EVEN = OFF_OE + (size_t)T_ * LDH * 2;
constexpr size_t OFF_ZR = OFF_RA;
constexpr size_t OFF_UG = OFF_ZR + (size_t)T_ * LDZR * 2;
constexpr size_t OFF_UO = OFF_UG + (size_t)T_ * 512 * 2;
constexpr size_t OFF_SP = OFF_UO + (size_t)T_ * LDH * 2;
constexpr size_t OFF_EB = OFF_SP + (size_t)T_ * 512 * 2;
constexpr size_t OFF_XP = OFF_EB + (size_t)32 * 1024 * 128 * 4;
constexpr size_t OFF_YT = OFF_HY;
constexpr size_t END_ODD = OFF_XP + (size_t)32 * 1024 * 128 * 2;
constexpr size_t OFF_HID = OFF_RA;
constexpr size_t END_MLP = OFF_HID + (size_t)T_ * LDHID * 2;
constexpr size_t WS_NEED = END_ODD > END_EVEN ? (END_ODD > END_MLP ? END_ODD : END_MLP) : (END_EVEN > END_MLP ? END_EVEN : END_MLP);

constexpr int NTHR = 512;
constexpr int HALF_SMEM = 73728 + 1024;
constexpr int SMEM_GEMM = 131072;
constexpr int SMEM_BYTES = 2 * HALF_SMEM;
constexpr int NPHASE = 38;

struct Params {
  const float *x, *c, *ada_w, *ada_b, *ln_g, *ln_b, *att_w_in, *mla_q_norm, *mla_w_uq, *mla_kv_norm, *mla_w_ukv,
      *swa_sinks, *att_w_out, *rec_w_in, *s5_a_re, *s5_a_im, *s5_log_step, *s5_b_re, *s5_b_im, *s5_c_re, *s5_c_im,
      *s5_d, *s5_glu_w, *s5_glu_b, *rec_w_out, *mlp_w1, *mlp_w2;
  float* out;
  char* ws;
};

#define XB_TMO      128
#define XB_XCNT(j)  (256  + 64 * (j))
#define XB_XSUB(j)  (1280 + 64 * (j))
#define XB_XGEN(j)  (2304 + 64 * (j))
#define XB_TOP      3328
#define XB_TOPGEN   3392
#define XCD_BAR_WORDS 3456
#define XB_SPIN_CAP (1u << 18)
#define LAS __attribute__((address_space(3)))

__device__ __forceinline__ unsigned xb_ld(unsigned* p)              { return __hip_atomic_load(p, __ATOMIC_RELAXED, __HIP_MEMORY_SCOPE_AGENT); }
__device__ __forceinline__ unsigned xb_add(unsigned* p, unsigned v) { return __hip_atomic_fetch_add(p, v, __ATOMIC_RELAXED, __HIP_MEMORY_SCOPE_AGENT); }
__device__ __forceinline__ unsigned xb_xcc_id() { return (unsigned)__builtin_amdgcn_s_getreg((3 << 11) | 20) & 0xFu; }
#define XB_SPIN(cond, bar) do { unsigned _sp = 0; while (cond) { __builtin_amdgcn_s_sleep(1); \
    if ((++_sp & 255u) == 0u) { if (xb_ld(&(bar)[XB_TMO])) break; if (_sp > XB_SPIN_CAP) { atomicAdd(&(bar)[XB_TMO], 1u); break; } } } } while (0)

struct XcdBarrier {
    unsigned* bar; unsigned x;
    volatile LAS unsigned* st;
};

__device__ __forceinline__ XcdBarrier xcd_barrier_post(unsigned* bar, volatile LAS unsigned* st) {
    XcdBarrier b; b.bar = bar; b.x = xb_xcc_id(); b.st = st;
    if (threadIdx.x == 0) (void)xb_add(&bar[XB_XCNT(b.x)], 1u);
    return b;
}
__device__ __forceinline__ void xcd_barrier_complete(unsigned* bar, unsigned x, unsigned& nloc, unsigned& nx) {
    const unsigned G = gridDim.x * gridDim.y * gridDim.z;
    unsigned sum, cnt, mine, sp = 0u;
    for (;;) {
        sum = 0u; cnt = 0u; mine = 0u;
#pragma unroll
        for (unsigned j = 0; j < 16; ++j) { const unsigned c = xb_ld(&bar[XB_XCNT(j)]); sum += c; cnt += (c > 0u) ? 1u : 0u; mine = (j == x) ? c : mine; }
        if (sum == G) break;
        __builtin_amdgcn_s_sleep(1);
        if ((++sp & 255u) == 0u) { if (xb_ld(&bar[XB_TMO])) break; if (sp > XB_SPIN_CAP) { atomicAdd(&bar[XB_TMO], 1u); break; } }
    }
    nloc = mine > 0u ? mine : 1u; nx = cnt > 0u ? cnt : 1u;
}

__device__ __forceinline__ void xcd_barrier(const XcdBarrier& b) {
    asm volatile("s_waitcnt vmcnt(0)" ::: "memory");
    __syncthreads();
    if (threadIdx.x == 0) {
        unsigned* bar = b.bar;
        __builtin_amdgcn_s_waitcnt(0);
        unsigned nloc = b.st[0], nx = b.st[1];
        if (nloc == 0u) { xcd_barrier_complete(bar, b.x, nloc, nx); b.st[0] = nloc; b.st[1] = nx; }
        const unsigned old = xb_add(&bar[XB_XSUB(b.x)], 1u);
        const unsigned gen = old / nloc;
        if (old + 1u == (gen + 1u) * nloc) {
            __builtin_amdgcn_fence(__ATOMIC_RELEASE, "agent");
            asm volatile("s_waitcnt vmcnt(0)" ::: "memory");
            const unsigned og = xb_add(&bar[XB_TOP], 1u);
            const unsigned tg = og / nx;
            if (og + 1u == (tg + 1u) * nx) xb_add(&bar[XB_TOPGEN], 1u);
            else XB_SPIN(xb_ld(&bar[XB_TOPGEN]) == tg, bar);
            __builtin_amdgcn_fence(__ATOMIC_ACQUIRE, "agent");
            xb_add(&bar[XB_XGEN(b.x)], 1u);
            asm volatile("s_waitcnt vmcnt(0)" ::: "memory");
        } else {
            XB_SPIN(xb_ld(&bar[XB_XGEN(b.x)]) == gen, bar);
            __builtin_amdgcn_fence(__ATOMIC_ACQUIRE, "agent");
            asm volatile("s_waitcnt vmcnt(0)" ::: "memory");
        }
    }
    __syncthreads();
}


typedef __bf16 bf2_t __attribute__((ext_vector_type(2)));
typedef float f2_t __attribute__((ext_vector_type(2)));
DI u16 f2bf(float x) { __bf16 r = (__bf16)x; return __builtin_bit_cast(u16, r); }
DI float bf2f(unsigned h) { return __uint_as_float(h << 16); }
DI unsigned pack2(float a, float b) { f2_t v = {a, b}; bf2_t r = __builtin_convertvector(v, bf2_t); return __builtin_bit_cast(unsigned, r); }
DI int crow(int r, int hf) { return (r & 3) + 8 * (r >> 2) + 4 * hf; }
DI float ex2(float x) { return __builtin_amdgcn_exp2f(x); }
DI bf16x8 pack8(const f32x16& x, int s) {
  uint4 u;
  u.x = pack2(x[8 * s + 0], x[8 * s + 1]); u.y = pack2(x[8 * s + 2], x[8 * s + 3]);
  u.z = pack2(x[8 * s + 4], x[8 * s + 5]); u.w = pack2(x[8 * s + 6], x[8 * s + 7]);
  return __builtin_bit_cast(bf16x8, u);
}
DI bf16x8 join8(uint2 lo, uint2 hi) { uint4 u = make_uint4(lo.x, lo.y, hi.x, hi.y); return __builtin_bit_cast(bf16x8, u); }
DI f32x16 zero16() { f32x16 z; for (int i = 0; i < 16; ++i) z[i] = 0.f; return z; }
DI int opqv(int x) { asm volatile("" : "+v"(x)); return x; }
DI char* opq(char* p) { asm volatile("" : "+s"(p)); return p; }
DI void sincos_(float x, float& sn, float& cs) { float s_, c_; sincosf(x, &s_, &c_); sn = s_; cs = c_; }
DI float lg2gamma(int h) { return log2f(1.0f - exp2f(-5.0f - (float)h)); }

template <int V = 0, class Epi>
DI void gemm_tile(const u16* A1, long lda1, int nk1, const u16* A2, long lda2, int nk2, const u16* Bt, long ldb,
                  char* smem, Epi&& epi) {
  const int tid = opqv(threadIdx.x), lane = tid & 63, w = tid >> 6, wm = w >> 2, wn = w & 3, l32 = lane & 31, hf = lane >> 5;
  f32x16 acc[2][2][2];
#pragma unroll
  for (int h = 0; h < 2; ++h)
#pragma unroll
    for (int i = 0; i < 2; ++i)
#pragma unroll
      for (int j = 0; j < 2; ++j) acc[h][i][j] = zero16();
  const int nk = nk1 + nk2;
  const int drow = lane >> 3, dslot = lane & 7, x7 = (l32 >> 1) & 7;
#define GLDS(KT, BUF) { const int kt_ = (KT); const u16* Ab; long lda; \
    if (kt_ < nk1) { Ab = A1 + kt_ * 64; lda = lda1; } else { Ab = A2 + (kt_ - nk1) * 64; lda = lda2; } \
    _Pragma("unroll") for (int q = 0; q < 4; ++q) { \
      const int r = (w * 4 + q) * 8 + drow; const int c = dslot ^ ((r >> 1) & 7); \
      __builtin_amdgcn_global_load_lds((const unsigned*)(Ab + (long)r * lda + c * 8), (lds_u32*)(smem + (BUF) * 65536 + (w * 4 + q) * 1024), 16, 0, 0); \
      __builtin_amdgcn_global_load_lds((const unsigned*)(Bt + (long)r * ldb + kt_ * 64 + c * 8), (lds_u32*)(smem + (BUF) * 65536 + 32768 + (w * 4 + q) * 1024), 16, 0, 0); } }
#define LFR(AF, BF, BUF, S0) { const char* a = smem + (BUF) * 65536; const char* b = a + 32768; \
    _Pragma("unroll") for (int i = 0; i < 4; ++i) AF[i] = *(const bf16x8*)(a + (wm * 128 + i * 32 + l32) * 128 + (((2 * (S0) + hf) ^ x7) << 4)); \
    _Pragma("unroll") for (int j = 0; j < 2; ++j) BF[j] = *(const bf16x8*)(b + (wn * 64 + j * 32 + l32) * 128 + (((2 * (S0) + hf) ^ x7) << 4)); }
#define MMA8(AF, BF) { \
    _Pragma("unroll") for (int i = 0; i < 4; ++i) \
      _Pragma("unroll") for (int j = 0; j < 2; ++j) acc[i >> 1][i & 1][j] = MFMA(AF[i], BF[j], acc[i >> 1][i & 1][j]); }
#define COMPUTE(BUF) { bf16x8 af0[4], bf0[2], af1[4], bf1[2]; \
    LFR(af0, bf0, BUF, 0); __builtin_amdgcn_sched_barrier(0); \
    LFR(af1, bf1, BUF, 1); MMA8(af0, bf0); __builtin_amdgcn_sched_barrier(0); \
    LFR(af0, bf0, BUF, 2); MMA8(af1, bf1); __builtin_amdgcn_sched_barrier(0); \
    LFR(af1, bf1, BUF, 3); MMA8(af0, bf0); __builtin_amdgcn_sched_barrier(0); \
    MMA8(af1, bf1); __builtin_amdgcn_sched_barrier(0); }
#define RAWBAR() { asm volatile("s_waitcnt vmcnt(0) lgkmcnt(0)" ::: "memory"); __builtin_amdgcn_s_barrier(); }
  if (V != 1) GLDS(0, 0);
  RAWBAR();
  for (int kt = 0; kt < nk; kt += 2) {
    if (V != 1) GLDS(kt + 1, 1);
    if (V != 2) COMPUTE(0);
    RAWBAR();
    if (V != 1) if (kt + 2 < nk) GLDS(kt + 2, 0);
    if (V != 2) COMPUTE(1);
    RAWBAR();
  }
#undef GLDS
#undef LFR
#undef MMA8
#undef COMPUTE
#undef RAWBAR
  epi(acc[0], wm * 64);
  epi(acc[1], wm * 64 + 64);
}

DI void tile_map(int lt, int nM8, int nN, int GM, int GN, int& mt, int& nt) {
  const int G = GM * GN, xcd = blockIdx.x & 7, group = lt / G, within = lt - group * G, ngn = nN / GN;
  const int mg = group / ngn, ng = group - mg * ngn;
  mt = xcd * nM8 + mg * GM + within / GN;
  nt = ng * GN + within % GN;
}

DI int colmap(int mode, int n) {
  if (mode == 1) { if (n < 640) return n; if (n < 1408) return n + 32; if (n < 1440) return n - 1408 + 640; return -1; }
  if (mode == 2) { if (n < 512) return (n >> 6) * 96 + (n & 63); int m = n - 512; return (m >> 5) * 96 + 64 + (m & 31); }
  if (mode == 3) { if (n < 1024) { int dl = n & 127, b4 = dl >> 5; int sb = (b4 == 1) ? 2 : (b4 == 2 ? 1 : b4); return (n & ~127) + sb * 32 + (dl & 31); } return n; }
  return n;
}
DI void conv_job(const float* src, int K, int N, u16* dst, int ldk, int Npad, const float* kscale, int mode, float* lds) {
  const int tid = opqv(threadIdx.x);
  const int nKt = K / 64, nNt = Npad / 64;
  for (int tile = blockIdx.x; tile < nKt * nNt; tile += gridDim.x) {
    const int nt = tile / nKt, kt = tile % nKt;
    const int nl = tid & 63, kq = tid >> 6;
    const int col = colmap(mode, nt * 64 + nl);
    for (int i = 0; i < 8; ++i) {
      const int kl = kq + 8 * i, k = kt * 64 + kl;
      float v = 0.f;
      if (col >= 0) { v = src[(size_t)k * N + col]; if (kscale) v *= kscale[k]; }
      lds[kl * 65 + nl] = v;
    }
    __syncthreads();
    for (int i = 0; i < 8; ++i) {
      const int n2 = kq + 8 * i;
      dst[(size_t)(nt * 64 + n2) * ldk + kt * 64 + nl] = f2bf(lds[nl * 65 + n2]);
    }
    __syncthreads();
  }
}

DI void phase0(const Params& p, char* smem) {
  const int tid = opqv(threadIdx.x), nb = gridDim.x, bid = blockIdx.x;
  char* ws = opq(p.ws);
  if (bid == 0 && tid < 64) ((int*)(ws + OFF_CTR))[tid] = 0;
  {
    float* cond = (float*)smem; float* red = cond + 2048; float* mod = (float*)(ws + OFF_MOD);
    for (int i = tid; i < 2048; i += NTHR) { float v = p.c[i]; cond[i] = v / (1.f + expf(-v)); }
    __syncthreads();
    for (int it = bid; it < 8 * 48; it += nb) {
      const int ls = it / 48, cgp = it % 48, tx = tid & 15, ty = tid >> 4;
      const float* wp = p.ada_w + (size_t)ls * 1024 * 3072 + cgp * 64 + tx * 4;
      float4 a0 = make_float4(0, 0, 0, 0), a1 = make_float4(0, 0, 0, 0);
      for (int k = ty * 32; k < ty * 32 + 32; ++k) {
        const float4 wv = *(const float4*)(wp + (size_t)k * 3072);
        const float c0 = cond[k], c1 = cond[1024 + k];
        a0.x += c0 * wv.x; a0.y += c0 * wv.y; a0.z += c0 * wv.z; a0.w += c0 * wv.w;
        a1.x += c1 * wv.x; a1.y += c1 * wv.y; a1.z += c1 * wv.z; a1.w += c1 * wv.w;
      }
      *(float4*)(red + (ty * 2 + 0) * 64 + tx * 4) = a0;
      *(float4*)(red + (ty * 2 + 1) * 64 + tx * 4) = a1;
      __syncthreads();
      if (tid < 128) {
        const int b = tid >> 6, col = tid & 63; float s = 0.f;
        for (int y = 0; y < 32; ++y) s += red[(y * 2 + b) * 64 + col];
        const int j = cgp * 64 + col;
        mod[(ls * 2 + b) * 3072 + j] = s + p.ada_b[ls * 3072 + j];
      }
      __syncthreads();
    }
  }
  {
    float* lds = (float*)smem;
    for (int j = 0; j < 2; ++j) {
      conv_job(p.att_w_in + (size_t)j * 1024 * 1440, 1024, 1440, (u16*)(ws + OFF_W_ATTIN) + (size_t)j * 1536 * LDW1, LDW1, 1536, nullptr, 1, lds);
      conv_job(p.mla_w_uq + (size_t)j * 384 * 768, 384, 768, (u16*)(ws + OFF_W_UQ) + (size_t)j * 768 * 384, 384, 768, p.mla_q_norm + j * 384, 2, lds);
      conv_job(p.mla_w_ukv + (size_t)j * 256 * 1024, 256, 1024, (u16*)(ws + OFF_W_UKV) + (size_t)j * 1024 * 256, 256, 1024, p.mla_kv_norm + j * 256, 0, lds);
      conv_job(p.att_w_out + (size_t)j * 1024 * 1024, 1024, 1024, (u16*)(ws + OFF_W_ATTOUT) + (size_t)j * 1024 * LDW1, LDW1, 1024, nullptr, 0, lds);
      conv_job(p.rec_w_in + (size_t)j * 1024 * 2560, 1024, 2560, (u16*)(ws + OFF_W_RECIN) + (size_t)j * 2560 * LDW1, LDW1, 2560, nullptr, 3, lds);
      conv_job(p.s5_glu_w + (size_t)j * 512 * 512, 512, 512, (u16*)(ws + OFF_W_GLU) + (size_t)j * 512 * LDGLU, LDGLU, 512, nullptr, 0, lds);
      conv_job(p.rec_w_out + (size_t)j * 1024 * 1024, 1024, 1024, (u16*)(ws + OFF_W_RECOUT) + (size_t)j * 1024 * LDW1, LDW1, 1024, nullptr, 0, lds);
    }
    for (int l = 0; l < 4; ++l) {
      conv_job(p.mlp_w1 + (size_t)l * 1024 * 4096, 1024, 4096, (u16*)(ws + OFF_W1) + (size_t)l * 4096 * LDW1, LDW1, 4096, nullptr, 0, lds);
      conv_job(p.mlp_w2 + (size_t)l * 4096 * 1024, 4096, 1024, (u16*)(ws + OFF_W2) + (size_t)l * 1024 * LDW2, LDW2, 1024, nullptr, 0, lds);
    }
  }
  {
    float2* rt32 = (float2*)(ws + OFF_RT32); float2* rt64 = (float2*)(ws + OFF_RT64); float2* rt128 = (float2*)(ws + OFF_RT128);
    for (int idx = bid * NTHR + tid; idx < S_ * 112; idx += nb * NTHR) {
      const int s = idx / 112, r = idx % 112;
      int dim, i; float2* dst;
      if (r < 16) { dim = 32; i = r; dst = rt32 + s * 16 + i; }
      else if (r < 48) { dim = 64; i = r - 16; dst = rt64 + s * 32 + i; }
      else { dim = 128; i = r - 48; dst = rt128 + s * 64 + i; }
      const float inv = powf(10000.0f, -((float)(2 * i)) / (float)dim);
      const float ang = (float)s * inv;
      float sn_, cs_; sincos_(ang, sn_, cs_);
      *dst = make_float2(cs_, sn_);
    }
  }
  {
    float4* s5z = (float4*)(ws + OFF_S5Z); float2* bbar = (float2*)(ws + OFF_BBAR);
    for (int idx = bid * NTHR + tid; idx < 2 * 32 * 64; idx += nb * NTHR) {
      const int jg = idx >> 6;
      const float dt = expf(p.s5_log_step[jg]);
      const float lr = p.s5_a_re[idx], li = p.s5_a_im[idx];
      const float zr = lr * dt, zi = li * dt, mag = expf(zr);
      float sn_, cs_; sincos_(zi, sn_, cs_);
      const float ar = mag * cs_, ai = mag * sn_;
      const float den = lr * lr + li * li;
      const float cr = ((ar - 1.f) * lr + ai * li) / den, ci = (ai * lr - (ar - 1.f) * li) / den;
      s5z[idx] = make_float4(zr, zi, ar, ai);
      for (int q = 0; q < 16; ++q) {
        const float br = p.s5_b_re[idx * 16 + q], bi = p.s5_b_im[idx * 16 + q];
        bbar[idx * 16 + q] = make_float2(cr * br - ci * bi, cr * bi + ci * br);
      }
    }
  }
}

DI void phase1(const Params& p) {
  const int tid = opqv(threadIdx.x), nb = gridDim.x, bid = blockIdx.x;
  char* ws = opq(p.ws);
  const float* mod = (const float*)(ws + OFF_MOD);
  u16* hy = (u16*)(ws + OFF_HY);
  const int stp = nb * NTHR;
  for (int i0 = bid * NTHR + tid; i0 < T_ * 256; i0 += stp * 8) {
    f32x4 xv[8];
#pragma unroll
    for (int u = 0; u < 8; ++u) {
      const int i = i0 + u * stp;
      if (i < T_ * 256) xv[u] = __builtin_nontemporal_load((const f32x4*)(p.x + (size_t)i * 4));
    }
#pragma unroll
    for (int u = 0; u < 8; ++u) {
      const int i = i0 + u * stp;
      if (i < T_ * 256) {
        const int t = i >> 8, c4 = (i & 255) * 4, b = t >> 14;
        const float4 sh = *(const float4*)(mod + b * 3072 + c4);
        const float4 sc = *(const float4*)(mod + b * 3072 + 1024 + c4);
        uint2 o;
        o.x = pack2(xv[u].x * (1.f + sc.x) + sh.x, xv[u].y * (1.f + sc.y) + sh.y);
        o.y = pack2(xv[u].z * (1.f + sc.z) + sh.z, xv[u].w * (1.f + sc.w) + sh.w);
        *(uint2*)(hy + (size_t)t * LDH + c4) = o;
      }
    }
  }
  const float4* s5z = (const float4*)(ws + OFF_S5Z); const float2* bbar = (const float2*)(ws + OFF_BBAR);
  float* ktab = (float*)(ws + OFF_KTAB);
  for (int idx8 = bid * NTHR + tid; idx8 < 2 * 32 * 256 * 8; idx8 += nb * NTHR) {
    const int part = idx8 & 7, idx = idx8 >> 3;
    const int q = idx & 15, pp = (idx >> 4) & 15, jg = idx >> 8;
    float acc[32];
#pragma unroll
    for (int d = 0; d < 32; ++d) acc[d] = 0.f;
    for (int n = part * 8; n < part * 8 + 8; ++n) {
      const float4 z = s5z[jg * 64 + n];
      const float2 bb = bbar[(jg * 64 + n) * 16 + q];
      const float cr = p.s5_c_re[(jg * 16 + pp) * 64 + n], ci = p.s5_c_im[(jg * 16 + pp) * 64 + n];
      const float wr = cr * bb.x - ci * bb.y, wi = cr * bb.y + ci * bb.x;
      float er = 1.f, ei = 0.f;
#pragma unroll
      for (int d = 0; d < 32; ++d) {
        acc[d] += wr * er - wi * ei;
        const float nr = er * z.z - ei * z.w, ni = er * z.w + ei * z.z;
        er = nr; ei = ni;
      }
    }
#pragma unroll
    for (int d = 0; d < 32; ++d) {
      float a = acc[d];
      a += __shfl_xor(a, 1); a += __shfl_xor(a, 2); a += __shfl_xor(a, 4);
      if (part == 0) ktab[(jg * 32 + d) * 256 + pp * 16 + q] = a;
    }
  }
}

DI void ln_phase(const Params& p, int ls) {
  const int tid = opqv(threadIdx.x), lane = tid & 63, w = tid >> 6;
  char* ws = opq(p.ws);
  const float* mod = (const float*)(ws + OFF_MOD);
  u16* hy = (u16*)(ws + OFF_HY);
  const float* xin = (ls == 0) ? p.x : p.out;
  const float* lg = p.ln_g + ls * 1024; const float* lb = p.ln_b + ls * 1024;
  const int stride = gridDim.x * 8;
  f32x4 xc[4], xn[4]; uint2 yc[4], yn[4];
  {
    const int row = blockIdx.x * 8 + w;
#pragma unroll
    for (int i = 0; i < 4; ++i) {
      const int col = lane * 4 + 256 * i;
      xc[i] = __builtin_nontemporal_load((const f32x4*)(xin + (size_t)row * 1024 + col));
      yc[i] = *(const uint2*)(hy + (size_t)row * LDH + col);
    }
  }
  for (int row = blockIdx.x * 8 + w; row < T_; row += stride) {
    const int b = row >> 14;
    const float* gate = mod + (ls * 2 + b) * 3072 + 2048;
    const int rn = row + stride;
    if (rn < T_) {
#pragma unroll
      for (int i = 0; i < 4; ++i) {
        const int col = lane * 4 + 256 * i;
        xn[i] = __builtin_nontemporal_load((const f32x4*)(xin + (size_t)rn * 1024 + col));
        yn[i] = *(const uint2*)(hy + (size_t)rn * LDH + col);
      }
    }
    float v[16];
    float sum = 0.f;
#pragma unroll
    for (int i = 0; i < 4; ++i) {
      const int col = lane * 4 + 256 * i;
      const f32x4 xv = xc[i];
      const uint2 yv = yc[i];
      const float4 g = *(const float4*)(gate + col);
      v[4 * i + 0] = DN_ALPHA * xv.x + (1.f + g.x) * bf2f(yv.x & 0xffffu);
      v[4 * i + 1] = DN_ALPHA * xv.y + (1.f + g.y) * bf2f(yv.x >> 16);
      v[4 * i + 2] = DN_ALPHA * xv.z + (1.f + g.z) * bf2f(yv.y & 0xffffu);
      v[4 * i + 3] = DN_ALPHA * xv.w + (1.f + g.w) * bf2f(yv.y >> 16);
      sum += v[4 * i] + v[4 * i + 1] + v[4 * i + 2] + v[4 * i + 3];
    }
#pragma unroll
    for (int m = 32; m >= 1; m >>= 1) sum += __shfl_xor(sum, m);
    const float mean = sum * (1.f / 1024.f);
    float vs = 0.f;
#pragma unroll
    for (int i = 0; i < 16; ++i) { const float d = v[i] - mean; vs += d * d; }
#pragma unroll
    for (int m = 32; m >= 1; m >>= 1) vs += __shfl_xor(vs, m);
    const float rstd = rsqrtf(vs * (1.f / 1024.f) + 1e-5f);
#pragma unroll
    for (int i = 0; i < 4; ++i) {
      const int col = lane * 4 + 256 * i;
      const float4 g = *(const float4*)(lg + col); const float4 bb = *(const float4*)(lb + col);
      float4 o;
      o.x = (v[4 * i + 0] - mean) * rstd * g.x + bb.x; o.y = (v[4 * i + 1] - mean) * rstd * g.y + bb.y;
      o.z = (v[4 * i + 2] - mean) * rstd * g.z + bb.z; o.w = (v[4 * i + 3] - mean) * rstd * g.w + bb.w;
      { f32x4 ov = {o.x, o.y, o.z, o.w}; __builtin_nontemporal_store(ov, (f32x4*)(p.out + (size_t)row * 1024 + col)); }
      if (ls < 7) {
        const float* m2 = mod + ((ls + 1) * 2 + b) * 3072;
        const float4 sh = *(const float4*)(m2 + col); const float4 sc = *(const float4*)(m2 + 1024 + col);
        uint2 h;
        h.x = pack2(o.x * (1.f + sc.x) + sh.x, o.y * (1.f + sc.y) + sh.y);
        h.y = pack2(o.z * (1.f + sc.z) + sh.z, o.w * (1.f + sc.w) + sh.w);
        *(uint2*)(hy + (size_t)row * LDH + col) = h;
      }
    }
#pragma unroll
    for (int i = 0; i < 4; ++i) { xc[i] = xn[i]; yc[i] = yn[i]; }
  }
}

template <int V = 0>
DI void gemm_plain(const u16* A, int lda, int K, const u16* Wt, int ldb, int N, u16* C, int ldc, int mode, char* smem) {
  const int tid = opqv(threadIdx.x), lane = tid & 63, w = tid >> 6, wm = w >> 2, wn = w & 3, l32 = lane & 31, hf = lane >> 5;
  const int nN = N / 256;
  for (int lt = blockIdx.x >> 3; lt < 16 * nN; lt += gridDim.x >> 3) {
    int mt, nt; tile_map(lt, 16, nN, 8, 4, mt, nt);
    const int m0 = mt * 256, n0 = nt * 256;
    gemm_tile<V>(A + (size_t)m0 * lda, lda, K / 64, nullptr, 0, 0, Wt + (size_t)n0 * ldb, ldb, smem, [&](f32x16(&acc)[2][2], int moff) {
      const int m0_ = m0 + moff;
      int l32_ = l32, hf_ = hf; asm volatile("" : "+v"(l32_), "+v"(hf_));
#pragma unroll
      for (int i = 0; i < 2; ++i)
#pragma unroll
        for (int j = 0; j < 2; ++j)
#pragma unroll
          for (int r = 0; r < 16; ++r) {
            const int row = m0_ + wm * 64 + i * 32 + crow(r, hf_), col = n0 + wn * 64 + j * 32 + l32_;
            float v = acc[i][j][r];
            if (mode == 1) { v = fmaxf(v, 0.f); v = v * v; }
            if (V == 0 || v == 123456.789f) C[(size_t)row * ldc + col] = f2bf(v);
          }
    });
  }
}

DI void att_in_phase(const Params& p, int j, char* smem) {
  const int tid = opqv(threadIdx.x), lane = tid & 63, w = tid >> 6, wm = w >> 2, wn = w & 3, l32 = lane & 31, hf = lane >> 5;
  char* ws = opq(p.ws);
  const u16* A = (const u16*)(ws + OFF_HY);
  const u16* Wt = (const u16*)(ws + OFF_W_ATTIN) + (size_t)j * 1536 * LDW1;
  u16* zc = (u16*)(ws + OFF_ZC); u16* SQ = (u16*)(ws + OFF_SQ); u16* SK = (u16*)(ws + OFF_SK); u16* SV = (u16*)(ws + OFF_SV);
  u16* Kb = (u16*)(ws + OFF_KB);
  const float2* rt64 = (const float2*)(ws + OFF_RT64); const float2* rt32 = (const float2*)(ws + OFF_RT32);
  const int nN = 6;
  for (int lt = blockIdx.x >> 3; lt < 16 * nN; lt += gridDim.x >> 3) {
    int mt, nt; tile_map(lt, 16, nN, 16, 2, mt, nt);
    const int m0 = mt * 256, n0 = nt * 256;
    gemm_tile(A + (size_t)m0 * LDH, LDH, 16, nullptr, 0, 0, Wt + (size_t)n0 * LDW1, LDW1, smem, [&](f32x16(&acc)[2][2], int moff) {
      const int m0_ = m0 + moff;
      int l32_ = l32, hf_ = hf; asm volatile("" : "+v"(l32_), "+v"(hf_));
      const int C64 = n0 + wn * 64;
#pragma unroll
      for (int i = 0; i < 2; ++i) {
        const int rb = m0_ + wm * 64 + i * 32;
        if (C64 < 640) {
#pragma unroll
          for (int jn = 0; jn < 2; ++jn)
#pragma unroll
            for (int r = 0; r < 16; ++r) zc[(size_t)(rb + crow(r, hf_)) * 640 + C64 + jn * 32 + l32_] = f2bf(acc[i][jn][r]);
        } else if (C64 < 1280) {
          const bool isq = C64 < 1152;
          u16* dst = isq ? SQ : SK; const int pitch = isq ? 512 : 128; const int cb = isq ? (C64 - 640) : (C64 - 1152);
          const float sc = isq ? SWA_QSCALE : 1.f;
#pragma unroll
          for (int r = 0; r < 16; ++r) {
            const int t = rb + crow(r, hf_), pos = t & (S_ - 1);
            const float2 cs = rt64[pos * 32 + l32_];
            const float x1 = acc[i][0][r], x2 = acc[i][1][r];
            dst[(size_t)t * pitch + cb + l32_] = f2bf((x1 * cs.x - x2 * cs.y) * sc);
            dst[(size_t)t * pitch + cb + 32 + l32_] = f2bf((x2 * cs.x + x1 * cs.y) * sc);
          }
        } else if (C64 < 1408) {
#pragma unroll
          for (int jn = 0; jn < 2; ++jn)
#pragma unroll
            for (int r = 0; r < 16; ++r) SV[(size_t)(rb + crow(r, hf_)) * 128 + (C64 - 1280) + jn * 32 + l32_] = f2bf(acc[i][jn][r]);
        } else if (C64 == 1408) {
#pragma unroll
          for (int r = 0; r < 16; ++r) {
            const int t = rb + crow(r, hf_), pos = t & (S_ - 1);
            const float x = acc[i][0][r];
            const float xp = __shfl_xor(x, 16);
            const float2 cs = rt32[pos * 16 + (l32_ & 15)];
            const float o = (l32_ < 16) ? (x * cs.x - xp * cs.y) : (x * cs.x + xp * cs.y);
            const u16 v = f2bf(o);
#pragma unroll
            for (int h = 0; h < 8; ++h) Kb[(size_t)t * LDKB + h * 96 + 64 + l32_] = v;
          }
        }
      }
    });
  }
}

DI void qkv_phase(const Params& p, int j, char* smem) {
  const int tid = opqv(threadIdx.x), lane = tid & 63, w = tid >> 6, wm = w >> 2, wn = w & 3, l32 = lane & 31, hf = lane >> 5;
  char* ws = opq(p.ws);
  const u16* zc = (const u16*)(ws + OFF_ZC);
  const u16* Wq = (const u16*)(ws + OFF_W_UQ) + (size_t)j * 768 * 384;
  const u16* Wkv = (const u16*)(ws + OFF_W_UKV) + (size_t)j * 1024 * 256;
  u16* Qb = (u16*)(ws + OFF_QB); u16* Kb = (u16*)(ws + OFF_KB); u16* Vt = (u16*)(ws + OFF_VT);
  const float2* rt32 = (const float2*)(ws + OFF_RT32);
  float* rsc = (float*)(smem + SMEM_GEMM);
  for (int lt0 = blockIdx.x >> 3; lt0 < 16 * 7; lt0 += gridDim.x >> 3) {
    const bool isq = lt0 < 16 * 3;
    int mt, nt;
    if (isq) tile_map(lt0, 16, 3, 16, 1, mt, nt); else tile_map(lt0 - 16 * 3, 16, 4, 8, 4, mt, nt);
    const int m0 = mt * 256, n0 = nt * 256;
    const int coff = isq ? 0 : 384, ncols = isq ? 384 : 256;
    {
      const int row = tid >> 1, half = tid & 1, nh = ncols / 2;
      const u16* src = zc + (size_t)(m0 + row) * 640 + coff + half * nh;
      float s = 0.f;
      for (int c = 0; c < nh; c += 8) {
        const uint4 v = *(const uint4*)(src + c);
        float f;
        f = bf2f(v.x & 0xffffu); s += f * f; f = bf2f(v.x >> 16); s += f * f;
        f = bf2f(v.y & 0xffffu); s += f * f; f = bf2f(v.y >> 16); s += f * f;
        f = bf2f(v.z & 0xffffu); s += f * f; f = bf2f(v.z >> 16); s += f * f;
        f = bf2f(v.w & 0xffffu); s += f * f; f = bf2f(v.w >> 16); s += f * f;
      }
      s += __shfl_xor(s, 1);
      if (half == 0) rsc[row] = rsqrtf(s / (float)ncols + 1e-6f);
    }
    __syncthreads();
    if (isq) {
      gemm_tile(zc + (size_t)m0 * 640, 640, 6, nullptr, 0, 0, Wq + (size_t)n0 * 384, 384, smem, [&](f32x16(&acc)[2][2], int moff) {
      const int m0_ = m0 + moff;
      int l32_ = l32, hf_ = hf; asm volatile("" : "+v"(l32_), "+v"(hf_));
        const int C64 = n0 + wn * 64;
#pragma unroll
        for (int i = 0; i < 2; ++i) {
          const int rl = wm * 64 + i * 32;
#pragma unroll
          for (int jn = 0; jn < 2; ++jn)
#pragma unroll
            for (int r = 0; r < 16; ++r) {
              const int rr = rl + crow(r, hf_), t = m0_ + rr;
              const float x = acc[i][jn][r] * rsc[moff + rr] * MLA_QSCALE;
              if (C64 < 512) {
                Qb[(size_t)t * 768 + (C64 >> 6) * 96 + jn * 32 + l32_] = f2bf(x);
              } else {
                const int hq = ((C64 - 512) >> 5) + jn, pos = t & (S_ - 1);
                const float xp = __shfl_xor(x, 16);
                const float2 cs = rt32[pos * 16 + (l32_ & 15)];
                const float o = (l32_ < 16) ? (x * cs.x - xp * cs.y) : (x * cs.x + xp * cs.y);
                Qb[(size_t)t * 768 + hq * 96 + 64 + l32_] = f2bf(o);
              }
            }
        }
      });
    } else {
      gemm_tile(zc + (size_t)m0 * 640 + 384, 640, 4, nullptr, 0, 0, Wkv + (size_t)n0 * 256, 256, smem, [&](f32x16(&acc)[2][2], int moff) {
      const int m0_ = m0 + moff;
      int l32_ = l32, hf_ = hf; asm volatile("" : "+v"(l32_), "+v"(hf_));
        const int C64 = n0 + wn * 64, h = C64 >> 7, part = (C64 >> 6) & 1;
#pragma unroll
        for (int i = 0; i < 2; ++i) {
          const int rl = wm * 64 + i * 32;
#pragma unroll
          for (int jn = 0; jn < 2; ++jn) {
            if (part == 0) {
#pragma unroll
              for (int r = 0; r < 16; ++r) {
                const int rr = rl + crow(r, hf_), t = m0_ + rr;
                Kb[(size_t)t * LDKB + h * 96 + jn * 32 + l32_] = f2bf(acc[i][jn][r] * rsc[moff + rr]);
              }
            } else {
              const int e = jn * 32 + l32_;
#pragma unroll
              for (int qd = 0; qd < 4; ++qd) {
                const int rr = rl + 8 * qd + 4 * hf_, t0 = m0_ + rr, b = t0 >> 14, s0 = t0 & (S_ - 1);
                uint2 o;
                o.x = pack2(acc[i][jn][4 * qd + 0] * rsc[moff + rr + 0], acc[i][jn][4 * qd + 1] * rsc[moff + rr + 1]);
                o.y = pack2(acc[i][jn][4 * qd + 2] * rsc[moff + rr + 2], acc[i][jn][4 * qd + 3] * rsc[moff + rr + 3]);
                *(uint2*)(Vt + ((size_t)((b * 8 + h) * 64 + e)) * LDV + s0) = o;
              }
            }
          }
        }
      });
    }
    __syncthreads();
  }
}

constexpr int MLA_BUF = 64 * 208 + 64 * 136;
constexpr int MLA_SVP = 264;
constexpr int MLA_BUF2 = 128 * 208 + 64 * MLA_SVP;
DI void mla_item(const Params& p, int qb, int b, int h, char* smem) {
  const int tid = opqv(threadIdx.x), lane = tid & 63, w = tid >> 6, l32 = lane & 31, hf = lane >> 5;
  char* ws = opq(p.ws);
  const u16* Qb = (const u16*)(ws + OFF_QB); u16* o = (u16*)(ws + OFF_OE);
  const int q0 = qb * 256 + w * 32;
  const size_t tq = (size_t)b * S_ + q0 + l32;
  bf16x8 qf[6];
#pragma unroll
  for (int s = 0; s < 6; ++s) qf[s] = *(const bf16x8*)(Qb + tq * 768 + h * 96 + s * 16 + hf * 8);
  f32x16 ot[2]; ot[0] = zero16(); ot[1] = zero16();
  float m = -1e30f, l = 0.f;
  const int ntile = 2 * qb + 2;
  const u16* Kg = (const u16*)(ws + OFF_KB) + ((size_t)b * S_) * LDKB + h * 96;
  const u16* Vg = (const u16*)(ws + OFF_VT) + ((size_t)(b * 8 + h) * 64) * LDV;
  u32x4 rk[2][3], rv[2][2];
#define MGLOAD(SET, KT) { const int kt_ = (KT); \
    _Pragma("unroll") for (int i = 0; i < 3; ++i) { const int c = tid + 512 * i, row = c / 12, ch = c % 12; rk[SET][i] = *(const u32x4*)(Kg + (size_t)(kt_ * 128 + row) * LDKB + ch * 8); } \
    _Pragma("unroll") for (int i = 0; i < 2; ++i) { const int c = tid + 512 * i, row = c >> 4, ch = c & 15; rv[SET][i] = *(const u32x4*)(Vg + (size_t)row * LDV + kt_ * 128 + ch * 8); } }
#define MSWRITE(SET, BUF) { char* sk_ = smem + (BUF) * MLA_BUF2; char* sv_ = sk_ + 128 * 208; \
    _Pragma("unroll") for (int i = 0; i < 3; ++i) { const int c = tid + 512 * i, row = c / 12, ch = c % 12; *(u32x4*)(sk_ + row * 208 + ch * 16) = rk[SET][i]; } \
    _Pragma("unroll") for (int i = 0; i < 2; ++i) { const int c = tid + 512 * i, row = c >> 4, ch = c & 15; \
      *(uint2*)(sv_ + row * MLA_SVP + ch * 16) = make_uint2(rv[SET][i].x, rv[SET][i].y); \
      *(uint2*)(sv_ + row * MLA_SVP + ch * 16 + 8) = make_uint2(rv[SET][i].z, rv[SET][i].w); } }
  auto compute = [&](int kt, int sub) {
    const char* sk = smem + (kt & 1) * MLA_BUF2 + sub * (64 * 208); const char* sv = smem + (kt & 1) * MLA_BUF2 + 128 * 208 + sub * 128;
    const int k0 = kt * 128 + sub * 64;
    if (k0 <= q0 + 31) {
      f32x16 st[2];
      bf16x8 kf[2][6];
#pragma unroll
      for (int t32 = 0; t32 < 2; ++t32)
#pragma unroll
        for (int s = 0; s < 6; ++s) kf[t32][s] = *(const bf16x8*)(sk + (t32 * 32 + l32) * 208 + (s * 16 + hf * 8) * 2);
      __builtin_amdgcn_sched_barrier(0);
      __builtin_amdgcn_s_setprio(1);
#pragma unroll
      for (int t32 = 0; t32 < 2; ++t32) {
        st[t32] = zero16();
#pragma unroll
        for (int s = 0; s < 6; ++s) st[t32] = MFMA(kf[t32][s], qf[s], st[t32]);
      }
      __builtin_amdgcn_s_setprio(0);
      bf16x8 vf[2][2][2];
#pragma unroll
      for (int t32 = 0; t32 < 2; ++t32)
#pragma unroll
        for (int s = 0; s < 2; ++s)
#pragma unroll
          for (int mt = 0; mt < 2; ++mt) {
            const char* vp = sv + (mt * 32 + l32) * MLA_SVP + (t32 * 32 + s * 16 + hf * 4) * 2;
            vf[t32][s][mt] = join8(*(const uint2*)vp, *(const uint2*)(vp + 16));
          }
      __builtin_amdgcn_sched_barrier(0);
      if (k0 + 63 > q0) {
        const int qpos = q0 + l32;
#pragma unroll
        for (int t32 = 0; t32 < 2; ++t32)
#pragma unroll
          for (int r = 0; r < 16; ++r) { const int key = k0 + t32 * 32 + crow(r, hf); if (key > qpos) st[t32][r] = -1e30f; }
      }
      float mx = -1e30f;
#pragma unroll
      for (int t32 = 0; t32 < 2; ++t32)
#pragma unroll
        for (int r = 0; r < 16; ++r) mx = fmaxf(mx, st[t32][r]);
      mx = fmaxf(mx, __shfl_xor(mx, 32));
      const float mn = fmaxf(m, mx);
      const float alpha = ex2(m - mn);
      m = mn;
      float ps = 0.f;
#pragma unroll
      for (int t32 = 0; t32 < 2; ++t32)
#pragma unroll
        for (int r = 0; r < 16; ++r) { const float pv = ex2(st[t32][r] - mn); st[t32][r] = pv; ps += pv; }
      l = l * alpha + ps;
#pragma unroll
      for (int mt = 0; mt < 2; ++mt)
#pragma unroll
        for (int r = 0; r < 16; ++r) ot[mt][r] *= alpha;
      __builtin_amdgcn_s_setprio(1);
#pragma unroll
      for (int t32 = 0; t32 < 2; ++t32)
#pragma unroll
        for (int s = 0; s < 2; ++s) {
          const bf16x8 pf = pack8(st[t32], s);
#pragma unroll
          for (int mt = 0; mt < 2; ++mt) ot[mt] = MFMA(vf[t32][s][mt], pf, ot[mt]);
        }
      __builtin_amdgcn_s_setprio(0);
    }
  };
  MGLOAD(0, 0); MGLOAD(1, 1);
  MSWRITE(0, 0); __syncthreads();
  for (int kt = 0; kt < ntile; kt += 2) {
    if (kt + 2 < ntile) MGLOAD(0, kt + 2);
    __builtin_amdgcn_sched_barrier(0);
    compute(kt, 0); compute(kt, 1);
    MSWRITE(1, 1);
    __syncthreads();
    if (kt + 3 < ntile) MGLOAD(1, kt + 3);
    __builtin_amdgcn_sched_barrier(0);
    compute(kt + 1, 0); compute(kt + 1, 1);
    if (kt + 2 < ntile) MSWRITE(0, 0);
    __syncthreads();
  }
#undef MGLOAD
#undef MSWRITE
  l += __shfl_xor(l, 32);
  const float inv = 1.f / l;
#pragma unroll
  for (int mt = 0; mt < 2; ++mt)
#pragma unroll
    for (int qd = 0; qd < 4; ++qd) {
      const int e0 = mt * 32 + 8 * qd + 4 * hf;
      uint2 ov;
      ov.x = pack2(ot[mt][4 * qd + 0] * inv, ot[mt][4 * qd + 1] * inv);
      ov.y = pack2(ot[mt][4 * qd + 2] * inv, ot[mt][4 * qd + 3] * inv);
      *(uint2*)(o + tq * LDH + h * 64 + e0) = ov;
    }
}

DI void swa_item(const Params& p, int j, int b, int nblk, int kvh, char* smem) {
  const int tid = opqv(threadIdx.x) & 255, lane = tid & 63, w = tid >> 6, l32 = lane & 31, hf = lane >> 5;
  char* ws = opq(p.ws);
  const u16* SQ = (const u16*)(ws + OFF_SQ); const u16* SK = (const u16*)(ws + OFF_SK); const u16* SV = (const u16*)(ws + OFF_SV);
  u16* o = (u16*)(ws + OFF_OE);
  char* sk = smem; char* sv = smem + 256 * 144;
  const int ws0 = 128 * (nblk - 1);
#pragma unroll
  for (int i = 0; i < 8; ++i) {
    const int c = tid + 256 * i, row = c >> 3, ch = c & 7, pos = ws0 + row;
    uint4 kv = make_uint4(0, 0, 0, 0), vv = make_uint4(0, 0, 0, 0);
    if (pos >= 0) {
      kv = *(const uint4*)(SK + ((size_t)b * S_ + pos) * 128 + kvh * 64 + ch * 8);
      vv = *(const uint4*)(SV + ((size_t)b * S_ + pos) * 128 + kvh * 64 + ch * 8);
    }
    *(uint4*)(sk + row * 144 + ch * 16) = kv;
    char* vb = sv + (ch * 8) * 528 + row * 2;
    *(u16*)(vb + 0 * 528) = (u16)(vv.x & 0xffffu); *(u16*)(vb + 1 * 528) = (u16)(vv.x >> 16);
    *(u16*)(vb + 2 * 528) = (u16)(vv.y & 0xffffu); *(u16*)(vb + 3 * 528) = (u16)(vv.y >> 16);
    *(u16*)(vb + 4 * 528) = (u16)(vv.z & 0xffffu); *(u16*)(vb + 5 * 528) = (u16)(vv.z >> 16);
    *(u16*)(vb + 6 * 528) = (u16)(vv.w & 0xffffu); *(u16*)(vb + 7 * 528) = (u16)(vv.w >> 16);
  }
  __syncthreads();
  const size_t tq = (size_t)b * S_ + nblk * 128 + w * 32 + l32;
  const int qloc = 128 + w * 32 + l32;
#pragma unroll 1
  for (int g = 0; g < 4; ++g) {
    const int head = kvh * 4 + g;
    bf16x8 qf[4];
#pragma unroll
    for (int s = 0; s < 4; ++s) qf[s] = *(const bf16x8*)(SQ + tq * 512 + head * 64 + s * 16 + hf * 8);
    f32x16 st[5];
    const float sink2 = p.swa_sinks[j * 8 + head] * LOG2E;
    float mx = sink2;
#pragma unroll
    for (int tt = 0; tt < 5; ++tt) {
      const int kb = w * 32 + tt * 32;
      st[tt] = zero16();
#pragma unroll
      for (int s = 0; s < 4; ++s) {
        const bf16x8 kf = *(const bf16x8*)(sk + (kb + l32) * 144 + (s * 16 + hf * 8) * 2);
        st[tt] = MFMA(kf, qf[s], st[tt]);
      }
#pragma unroll
      for (int r = 0; r < 16; ++r) {
        const int kloc = kb + crow(r, hf);
        const bool valid = (kloc <= qloc) && (kloc > qloc - 128) && (ws0 + kloc >= 0);
        const float v = valid ? st[tt][r] : -1e30f;
        st[tt][r] = v; mx = fmaxf(mx, v);
      }
    }
    mx = fmaxf(mx, __shfl_xor(mx, 32));
    float ps = 0.f;
#pragma unroll
    for (int tt = 0; tt < 5; ++tt)
#pragma unroll
      for (int r = 0; r < 16; ++r) { const float pv = ex2(st[tt][r] - mx); st[tt][r] = pv; ps += pv; }
    ps += __shfl_xor(ps, 32);
    const float inv = 1.f / (ps + ex2(sink2 - mx));
    f32x16 ot[2]; ot[0] = zero16(); ot[1] = zero16();
#pragma unroll
    for (int tt = 0; tt < 5; ++tt) {
      const int kb = w * 32 + tt * 32;
#pragma unroll
      for (int s = 0; s < 2; ++s) {
        const bf16x8 pf = pack8(st[tt], s);
#pragma unroll
        for (int mt = 0; mt < 2; ++mt) {
          const char* vp = sv + (mt * 32 + l32) * 528 + (kb + s * 16 + hf * 4) * 2;
          const bf16x8 vf = join8(*(const uint2*)vp, *(const uint2*)(vp + 16));
          ot[mt] = MFMA(vf, pf, ot[mt]);
        }
      }
    }
#pragma unroll
    for (int mt = 0; mt < 2; ++mt)
#pragma unroll
      for (int qd = 0; qd < 4; ++qd) {
        const int e0 = mt * 32 + 8 * qd + 4 * hf;
        uint2 ov;
        ov.x = pack2(ot[mt][4 * qd + 0] * inv, ot[mt][4 * qd + 1] * inv);
        ov.y = pack2(ot[mt][4 * qd + 2] * inv, ot[mt][4 * qd + 3] * inv);
        *(uint2*)(o + tq * LDH + 512 + head * 64 + e0) = ov;
      }
  }
  __syncthreads();
}

DI void attn_phase(const Params& p, int j, int ctr_idx, char* smem) {
  __shared__ int s_item;
  const int xcd = blockIdx.x & 7;
  int* ctr = (int*)(p.ws + OFF_CTR) + 16 + ctr_idx * 8 + xcd;
  const int nmla = 128, nswa = 32;
  const int half = opqv(threadIdx.x) >> 8;
  char* sm = smem + half * HALF_SMEM;
  for (;;) {
    __syncthreads();
    if (threadIdx.x == 0) s_item = atomicAdd(ctr, 1);
    __syncthreads();
    const int it = s_item;
    if (it >= nmla + nswa) break;
    if (it < nmla) {
      const int qb = 63 - (it >> 1), bh = xcd * 2 + (it & 1);
      mla_item(p, qb, bh >> 3, bh & 7, smem);
    } else {
      const int k = (xcd * nswa + (it - nmla)) * 2 + half;
      swa_item(p, j, k >> 8, (k >> 1) & 127, k & 1, sm);
    }
  }
}

DI void rec_in_phase(const Params& p, int j, char* smem) {
  const int tid = opqv(threadIdx.x), lane = tid & 63, w = tid >> 6, wm = w >> 2, wn = w & 3, l32 = lane & 31, hf = lane >> 5;
  char* ws = opq(p.ws);
  const u16* A = (const u16*)(ws + OFF_HY);
  const u16* Wt = (const u16*)(ws + OFF_W_RECIN) + (size_t)j * 2560 * LDW1;
  u16* zr = (u16*)(ws + OFF_ZR); u16* ug = (u16*)(ws + OFF_UG);
  const float2* rt128 = (const float2*)(ws + OFF_RT128);
  const int nN = 10;
  for (int lt = blockIdx.x >> 3; lt < 16 * nN; lt += gridDim.x >> 3) {
    int mt, nt; tile_map(lt, 16, nN, 16, 2, mt, nt);
    const int m0 = mt * 256, n0 = nt * 256;
    gemm_tile(A + (size_t)m0 * LDH, LDH, 16, nullptr, 0, 0, Wt + (size_t)n0 * LDW1, LDW1, smem, [&](f32x16(&acc)[2][2], int moff) {
      const int m0_ = m0 + moff;
      int l32_ = l32, hf_ = hf; asm volatile("" : "+v"(l32_), "+v"(hf_));
      const int C64 = n0 + wn * 64;
#pragma unroll
      for (int i = 0; i < 2; ++i) {
        const int rb = m0_ + wm * 64 + i * 32;
        if (C64 < 1024) {
          const int fi = ((C64 & 127) >> 1) + l32_, cbase = C64 & ~127;
          const float sc = (C64 >= 512) ? RET_KSCALE : 1.f;
#pragma unroll
          for (int r = 0; r < 16; ++r) {
            const int t = rb + crow(r, hf_), pos = t & (S_ - 1);
            const float2 cs = rt128[pos * 64 + fi];
            const float x1 = acc[i][0][r], x2 = acc[i][1][r];
            zr[(size_t)t * LDZR + cbase + fi] = f2bf((x1 * cs.x - x2 * cs.y) * sc);
            zr[(size_t)t * LDZR + cbase + 64 + fi] = f2bf((x2 * cs.x + x1 * cs.y) * sc);
          }
        } else if (C64 < 2048) {
#pragma unroll
          for (int jn = 0; jn < 2; ++jn)
#pragma unroll
            for (int r = 0; r < 16; ++r) zr[(size_t)(rb + crow(r, hf_)) * LDZR + C64 + jn * 32 + l32_] = f2bf(acc[i][jn][r]);
        } else {
#pragma unroll
          for (int jn = 0; jn < 2; ++jn) {
            const int cl = C64 - 2048 + jn * 32 + l32_, g = cl >> 4, pp = cl & 15;
#pragma unroll
            for (int r = 0; r < 16; ++r) ug[((size_t)g * T_ + rb + crow(r, hf_)) * 16 + pp] = f2bf(acc[i][jn][r]);
          }
        }
      }
    });
  }
}

DI void s5_fill(const Params& p, int j) {
  const int tid = opqv(threadIdx.x), nb = gridDim.x, bid = blockIdx.x;
  char* ws = opq(p.ws);
  const float4* s5z = (const float4*)(ws + OFF_S5Z) + j * 2048; const float2* bbar = (const float2*)(ws + OFF_BBAR) + j * 2048 * 16;
  const float* ktab = (const float*)(ws + OFF_KTAB) + (size_t)j * 32 * 32 * 256;
  u16* WE = (u16*)(ws + OFF_WE); u16* WY = (u16*)(ws + OFF_WY);
  for (int idx = bid * NTHR + tid; idx < 32 * 256 * 512; idx += nb * NTHR) {
    const int g = idx >> 17, n2 = (idx >> 9) & 255, k = idx & 511, jj = k >> 4, q = k & 15, n = n2 & 63;
    if (n2 >= 128) { WE[idx] = 0; continue; }
    const float4 z = s5z[g * 64 + n];
    const float d = (float)(31 - jj);
    const float mg = expf(d * z.x), ang = d * z.y; float sn_, cs_; sincos_(ang, sn_, cs_);
    const float er = mg * cs_, ei = mg * sn_;
    const float2 bb = bbar[(g * 64 + n) * 16 + q];
    const float v = (n2 < 64) ? (er * bb.x - ei * bb.y) : (er * bb.y + ei * bb.x);
    WE[idx] = f2bf(v);
  }
  for (int idx = bid * NTHR + tid; idx < 32 * 512 * 640; idx += nb * NTHR) {
    const int g = idx / (512 * 640), rem = idx - g * (512 * 640), mrow = rem / 640, k = rem - mrow * 640;
    const int i = mrow >> 4, pp = mrow & 15;
    float v;
    if (k < 512) {
      const int jj = k >> 4, q = k & 15, d = i - jj;
      v = (d >= 0) ? ktab[(g * 32 + d) * 256 + pp * 16 + q] : 0.f;
      if (d == 0 && q == pp) v += p.s5_d[j * 512 + g * 16 + pp];
    } else {
      const int n2 = k - 512, n = n2 & 63;
      const float4 z = s5z[g * 64 + n];
      const float d = (float)(i + 1);
      const float mg = expf(d * z.x), ang = d * z.y; float sn_, cs_; sincos_(ang, sn_, cs_);
    const float er = mg * cs_, ei = mg * sn_;
      const float cr = p.s5_c_re[((j * 32 + g) * 16 + pp) * 64 + n], ci = p.s5_c_im[((j * 32 + g) * 16 + pp) * 64 + n];
      v = (n2 < 64) ? (cr * er - ci * ei) : -(cr * ei + ci * er);
    }
    WY[idx] = f2bf(v);
  }
}

DI void ret_u_item(const Params& p, int b, int n, int h, char* smem) {
  const int tid = opqv(threadIdx.x) & 255, lane = tid & 63, w = tid >> 6, wm = w >> 1, wn = w & 1, l32 = lane & 31, hf = lane >> 5;
  char* ws = opq(p.ws);
  const u16* zr = (const u16*)(ws + OFF_ZR); float* U = (float*)(ws + OFF_UO);
  char* sKt = smem; char* sVt = smem + 128 * 272;
  const size_t t0 = (size_t)b * S_ + n * 128;
  const float lg = lg2gamma(h);
#pragma unroll
  for (int i = 0; i < 8; ++i) {
    const int c = tid + 256 * i, row = c >> 4, ch = c & 15;
    const uint4 kv = *(const uint4*)(zr + (t0 + row) * LDZR + 512 + h * 128 + ch * 8);
    const uint4 vv = *(const uint4*)(zr + (t0 + row) * LDZR + 1024 + h * 128 + ch * 8);
    const float te = ex2((float)(127 - row) * lg);
    const int colb = (((row >> 3) ^ ch) << 4) + (row & 7) * 2;
    char* kb = sKt + (ch * 8) * 272 + colb; char* vb = sVt + (ch * 8) * 272 + colb;
    *(u16*)(kb + 0 * 272) = f2bf(bf2f(kv.x & 0xffffu) * te); *(u16*)(kb + 1 * 272) = f2bf(bf2f(kv.x >> 16) * te);
    *(u16*)(kb + 2 * 272) = f2bf(bf2f(kv.y & 0xffffu) * te); *(u16*)(kb + 3 * 272) = f2bf(bf2f(kv.y >> 16) * te);
    *(u16*)(kb + 4 * 272) = f2bf(bf2f(kv.z & 0xffffu) * te); *(u16*)(kb + 5 * 272) = f2bf(bf2f(kv.z >> 16) * te);
    *(u16*)(kb + 6 * 272) = f2bf(bf2f(kv.w & 0xffffu) * te); *(u16*)(kb + 7 * 272) = f2bf(bf2f(kv.w >> 16) * te);
    *(u16*)(vb + 0 * 272) = (u16)(vv.x & 0xffffu); *(u16*)(vb + 1 * 272) = (u16)(vv.x >> 16);
    *(u16*)(vb + 2 * 272) = (u16)(vv.y & 0xffffu); *(u16*)(vb + 3 * 272) = (u16)(vv.y >> 16);
    *(u16*)(vb + 4 * 272) = (u16)(vv.z & 0xffffu); *(u16*)(vb + 5 * 272) = (u16)(vv.z >> 16);
    *(u16*)(vb + 6 * 272) = (u16)(vv.w & 0xffffu); *(u16*)(vb + 7 * 272) = (u16)(vv.w >> 16);
  }
  __syncthreads();
  f32x16 acc[2][2];
#pragma unroll
  for (int i = 0; i < 2; ++i)
#pragma unroll
    for (int jn = 0; jn < 2; ++jn) acc[i][jn] = zero16();
#pragma unroll
  for (int s = 0; s < 8; ++s) {
    bf16x8 af[2], bfr[2];
#pragma unroll
    for (int i = 0; i < 2; ++i) { const int e_ = wm * 64 + i * 32 + l32; af[i] = *(const bf16x8*)(sVt + e_ * 272 + (((s * 2 + hf) ^ ((e_ >> 3) & 15)) << 4)); }
#pragma unroll
    for (int jn = 0; jn < 2; ++jn) { const int d_ = wn * 64 + jn * 32 + l32; bfr[jn] = *(const bf16x8*)(sKt + d_ * 272 + (((s * 2 + hf) ^ ((d_ >> 3) & 15)) << 4)); }
#pragma unroll
    for (int i = 0; i < 2; ++i)
#pragma unroll
      for (int jn = 0; jn < 2; ++jn) acc[i][jn] = MFMA(af[i], bfr[jn], acc[i][jn]);
  }
  float* Ub = U + ((size_t)((b * 4 + h) * 128 + n)) * 16384;
#pragma unroll
  for (int i = 0; i < 2; ++i)
#pragma unroll
    for (int jn = 0; jn < 2; ++jn)
#pragma unroll
      for (int r = 0; r < 16; ++r) Ub[(wm * 64 + i * 32 + crow(r, hf)) * 128 + wn * 64 + jn * 32 + l32] = acc[i][jn][r];
  __syncthreads();
}

DI void rec_state_phase(const Params& p, int j, char* smem) {
  const int tid = opqv(threadIdx.x), lane = tid & 63, w = tid >> 6, wm = w >> 2, wn = w & 3, l32 = lane & 31, hf = lane >> 5;
  char* ws = opq(p.ws);
  {
    const int half = opqv(threadIdx.x) >> 8;
    char* sm = smem + half * HALF_SMEM;
    for (int it = blockIdx.x; it < 512; it += gridDim.x) { const int item = it * 2 + half; ret_u_item(p, item >> 9, (item >> 2) & 127, item & 3, sm); }
  }
  for (int it = blockIdx.x; it < 128; it += gridDim.x) {
    const int g = it >> 2, mt = it & 3, m0 = mt * 256;
    const u16* A = (const u16*)(ws + OFF_UG) + (size_t)g * T_ * 16 + (size_t)m0 * 512;
    const u16* Bt = (const u16*)(ws + OFF_WE) + (size_t)g * 256 * 512;
    float* E = (float*)(ws + OFF_EB) + (size_t)g * 1024 * 128;
    gemm_tile(A, 512, 8, nullptr, 0, 0, Bt, 512, smem, [&](f32x16(&acc)[2][2], int moff) {
      int l32_ = l32, hf_ = hf; asm volatile("" : "+v"(l32_), "+v"(hf_));
      const int m0_ = m0 + moff;
      if (wn < 2) {
#pragma unroll
        for (int i = 0; i < 2; ++i)
#pragma unroll
          for (int jn = 0; jn < 2; ++jn)
#pragma unroll
            for (int r = 0; r < 16; ++r)
              E[(size_t)(m0_ + wm * 64 + i * 32 + crow(r, hf_)) * 128 + wn * 64 + jn * 32 + l32_] = acc[i][jn][r];
      }
    });
  }
}

DI void scan_phase(const Params& p, int j, char* smem) {
  const int tfull = opqv(threadIdx.x);
  const int tid = tfull & 255, half = tfull >> 8;
  char* ws = opq(p.ws);
  for (int it = blockIdx.x; it < 128; it += gridDim.x) {
    if (it < 64) {
      const int vb = it * 2 + half;
      const int idx = vb * 256 + tid, bh = idx >> 12, e4 = (idx & 4095) * 4, h = bh & 3;
      const float cd = ex2(128.f * lg2gamma(h));
      const float* U = (const float*)(ws + OFF_UO) + (size_t)bh * 128 * 16384 + e4;
      u16* Sp = (u16*)(ws + OFF_SP) + (size_t)bh * 128 * 16384 + e4;
      float4 S = make_float4(0, 0, 0, 0);
      for (int n0 = 0; n0 < 128; n0 += 16) {
        f32x4 u[16];
#pragma unroll
        for (int k = 0; k < 16; ++k) u[k] = *(const f32x4*)(U + (size_t)(n0 + k) * 16384);
#pragma unroll
        for (int k = 0; k < 16; ++k) {
          *(uint2*)(Sp + (size_t)(n0 + k) * 16384) = make_uint2(pack2(S.x, S.y), pack2(S.z, S.w));
          S.x = cd * S.x + u[k].x; S.y = cd * S.y + u[k].y; S.z = cd * S.z + u[k].z; S.w = cd * S.w + u[k].w;
        }
      }
    } else {
      const int bg = it - 64, b = bg >> 5, g = bg & 31, n = tfull & 63, seg = tfull >> 6;
      const float4 z = ((const float4*)(ws + OFF_S5Z))[(j * 32 + g) * 64 + n];
      const float mg = expf(32.f * z.x), ang = 32.f * z.y; float sn_, cs_; sincos_(ang, sn_, cs_);
      const float ar = mg * cs_, ai = mg * sn_;
      float br = ar, bi = ai;
#pragma unroll
      for (int t = 0; t < 6; ++t) { const float nr = br * br - bi * bi, ni = 2.f * br * bi; br = nr; bi = ni; }
      const float* E = (const float*)(ws + OFF_EB) + ((size_t)g * 1024 + b * 512 + seg * 64) * 128;
      u16* Xp = (u16*)(ws + OFF_XP) + ((size_t)g * 1024 + b * 512 + seg * 64) * 128;
      float2* Ls = (float2*)smem;
      float xr = 0.f, xi = 0.f;
      for (int c0 = 0; c0 < 64; c0 += 32) {
        float er[32], ei[32];
#pragma unroll
        for (int k = 0; k < 32; ++k) { er[k] = E[(c0 + k) * 128 + n]; ei[k] = E[(c0 + k) * 128 + 64 + n]; }
#pragma unroll
        for (int k = 0; k < 32; ++k) {
          const float nr = ar * xr - ai * xi + er[k], ni = ar * xi + ai * xr + ei[k];
          xr = nr; xi = ni;
        }
      }
      Ls[seg * 64 + n] = make_float2(xr, xi);
      __syncthreads();
      xr = 0.f; xi = 0.f;
      for (int s2 = 0; s2 < seg; ++s2) {
        const float2 L = Ls[s2 * 64 + n];
        const float nr = br * xr - bi * xi + L.x, ni = br * xi + bi * xr + L.y;
        xr = nr; xi = ni;
      }
      for (int c0 = 0; c0 < 64; c0 += 32) {
        float er[32], ei[32];
#pragma unroll
        for (int k = 0; k < 32; ++k) { er[k] = E[(c0 + k) * 128 + n]; ei[k] = E[(c0 + k) * 128 + 64 + n]; }
#pragma unroll
        for (int k = 0; k < 32; ++k) {
          Xp[(c0 + k) * 128 + n] = f2bf(xr); Xp[(c0 + k) * 128 + 64 + n] = f2bf(xi);
          const float nr = ar * xr - ai * xi + er[k], ni = ar * xi + ai * xr + ei[k];
          xr = nr; xi = ni;
        }
      }
      __syncthreads();
    }
  }
}

DI void ret_out_item(const Params& p, int b, int n, int h, char* smem) {
  const int tid = opqv(threadIdx.x) & 255, lane = tid & 63, w = tid >> 6, l32 = lane & 31, hf = lane >> 5;
  char* ws = opq(p.ws);
  const u16* zr = (const u16*)(ws + OFF_ZR); u16* o = (u16*)(ws + OFF_UO);
  char* sK = smem; char* sVt = smem + 128 * 272;
  const size_t t0 = (size_t)b * S_ + n * 128;
  const float lg = lg2gamma(h);
#pragma unroll
  for (int i = 0; i < 8; ++i) {
    const int c = tid + 256 * i, row = c >> 4, ch = c & 15;
    const uint4 kv = *(const uint4*)(zr + (t0 + row) * LDZR + 512 + h * 128 + ch * 8);
    const uint4 vv = *(const uint4*)(zr + (t0 + row) * LDZR + 1024 + h * 128 + ch * 8);
    *(uint4*)(sK + row * 272 + ch * 16) = kv;
    char* vb = sVt + (ch * 8) * 272 + (((row >> 3) ^ ch) << 4) + (row & 7) * 2;
    *(u16*)(vb + 0 * 272) = (u16)(vv.x & 0xffffu); *(u16*)(vb + 1 * 272) = (u16)(vv.x >> 16);
    *(u16*)(vb + 2 * 272) = (u16)(vv.y & 0xffffu); *(u16*)(vb + 3 * 272) = (u16)(vv.y >> 16);
    *(u16*)(vb + 4 * 272) = (u16)(vv.z & 0xffffu); *(u16*)(vb + 5 * 272) = (u16)(vv.z >> 16);
    *(u16*)(vb + 6 * 272) = (u16)(vv.w & 0xffffu); *(u16*)(vb + 7 * 272) = (u16)(vv.w >> 16);
  }
  __syncthreads();
  const size_t tq = t0 + w * 32 + l32;
  const int qi = w * 32 + l32;
  bf16x8 qf[8];
#pragma unroll
  for (int s = 0; s < 8; ++s) qf[s] = *(const bf16x8*)(zr + tq * LDZR + h * 128 + s * 16 + hf * 8);
  f32x16 ot[4];
  const u16* Sp = (const u16*)(ws + OFF_SP) + ((size_t)((b * 4 + h) * 128 + n)) * 16384;
#pragma unroll
  for (int mt = 0; mt < 4; ++mt) {
    ot[mt] = zero16();
#pragma unroll
    for (int s = 0; s < 8; ++s) {
      const bf16x8 sf = *(const bf16x8*)(Sp + (mt * 32 + l32) * 128 + s * 16 + hf * 8);
      ot[mt] = MFMA(sf, qf[s], ot[mt]);
    }
  }
  const float fs = ex2((float)(qi + 1) * lg);
#pragma unroll
  for (int mt = 0; mt < 4; ++mt)
#pragma unroll
    for (int r = 0; r < 16; ++r) ot[mt][r] *= fs;
#pragma unroll
  for (int tt = 0; tt < 4; ++tt) {
    if (tt <= w) {
      f32x16 st = zero16();
#pragma unroll
      for (int s = 0; s < 8; ++s) {
        const bf16x8 kf = *(const bf16x8*)(sK + (tt * 32 + l32) * 272 + (s * 16 + hf * 8) * 2);
        st = MFMA(kf, qf[s], st);
      }
#pragma unroll
      for (int r = 0; r < 16; ++r) {
        const int dd = qi - (tt * 32 + crow(r, hf));
        st[r] = (dd >= 0) ? st[r] * ex2((float)dd * lg) : 0.f;
      }
#pragma unroll
      for (int s2 = 0; s2 < 2; ++s2) {
        const bf16x8 pf = pack8(st, s2);
#pragma unroll
        for (int mt = 0; mt < 4; ++mt) {
          const int e_ = mt * 32 + l32, key_ = (e_ >> 3) & 15, c0_ = tt * 4 + s2 * 2;
          const char* vr = sVt + e_ * 272 + hf * 8;
          const bf16x8 vf = join8(*(const uint2*)(vr + ((c0_ ^ key_) << 4)), *(const uint2*)(vr + (((c0_ + 1) ^ key_) << 4)));
          ot[mt] = MFMA(vf, pf, ot[mt]);
        }
      }
    }
  }
  float sum = 0.f;
#pragma unroll
  for (int mt = 0; mt < 4; ++mt)
#pragma unroll
    for (int r = 0; r < 16; ++r) sum += ot[mt][r];
  sum += __shfl_xor(sum, 32);
  const float mean = sum * (1.f / 128.f);
  float vs = 0.f;
#pragma unroll
  for (int mt = 0; mt < 4; ++mt)
#pragma unroll
    for (int r = 0; r < 16; ++r) { const float d = ot[mt][r] - mean; vs += d * d; }
  vs += __shfl_xor(vs, 32);
  const float rstd = rsqrtf(vs * (1.f / 128.f) + 1e-5f);
#pragma unroll
  for (int mt = 0; mt < 4; ++mt)
#pragma unroll
    for (int qd = 0; qd < 4; ++qd) {
      const int e0 = mt * 32 + 8 * qd + 4 * hf;
      const uint2 gv = *(const uint2*)(zr + tq * LDZR + 1536 + h * 128 + e0);
      const float g0 = bf2f(gv.x & 0xffffu), g1 = bf2f(gv.x >> 16), g2 = bf2f(gv.y & 0xffffu), g3 = bf2f(gv.y >> 16);
      const float o0 = g0 / (1.f + __expf(-g0)) * (ot[mt][4 * qd + 0] - mean) * rstd;
      const float o1 = g1 / (1.f + __expf(-g1)) * (ot[mt][4 * qd + 1] - mean) * rstd;
      const float o2 = g2 / (1.f + __expf(-g2)) * (ot[mt][4 * qd + 2] - mean) * rstd;
      const float o3 = g3 / (1.f + __expf(-g3)) * (ot[mt][4 * qd + 3] - mean) * rstd;
      *(uint2*)(o + tq * LDH + h * 128 + e0) = make_uint2(pack2(o0, o1), pack2(o2, o3));
    }
  __syncthreads();
}

DI float gelu_tanh(float y) {
  const float u = 0.7978845608028654f * (y + 0.044715f * y * y * y);
  const float e = __expf(2.f * u);
  const float th = 1.f - 2.f / (e + 1.f);
  return 0.5f * y * (1.f + th);
}

DI void rec_out_phase(const Params& p, int j, char* smem) {
  const int tid = opqv(threadIdx.x), lane = tid & 63, w = tid >> 6, wm = w >> 2, wn = w & 3, l32 = lane & 31, hf = lane >> 5;
  char* ws = opq(p.ws);
  {
    const int half = opqv(threadIdx.x) >> 8;
    char* sm = smem + half * HALF_SMEM;
    for (int it = blockIdx.x; it < 512; it += gridDim.x) { const int item = it * 2 + half; ret_out_item(p, item >> 9, (item >> 2) & 127, item & 3, sm); }
  }
  for (int it = blockIdx.x; it < 256; it += gridDim.x) {
    {
      const int k = it, g = k >> 3, mt = (k >> 1) & 3, nt = k & 1, m0 = mt * 256, n0 = nt * 256;
      const u16* Ug = (const u16*)(ws + OFF_UG) + (size_t)g * T_ * 16;
      const u16* A1 = Ug + (size_t)m0 * 512;
      const u16* A2 = (const u16*)(ws + OFF_XP) + ((size_t)g * 1024 + m0) * 128;
      const u16* Bt = (const u16*)(ws + OFF_WY) + ((size_t)g * 512 + n0) * 640;
      u16* yt = (u16*)(ws + OFF_YT);
      gemm_tile(A1, 512, 8, A2, 128, 2, Bt, 640, smem, [&](f32x16(&acc)[2][2], int moff) {
      const int m0_ = m0 + moff;
      int l32_ = l32, hf_ = hf; asm volatile("" : "+v"(l32_), "+v"(hf_));
#pragma unroll
        for (int i = 0; i < 2; ++i)
#pragma unroll
          for (int jn = 0; jn < 2; ++jn)
#pragma unroll
            for (int r = 0; r < 16; ++r) {
              const int R = m0_ + wm * 64 + i * 32 + crow(r, hf_), col = n0 + wn * 64 + jn * 32 + l32_;
              const int ii = col >> 4, pp = col & 15;
              const size_t t = (size_t)R * 32 + ii;
              const float y = acc[i][jn][r];
              yt[t * LDYT + g * 16 + pp] = f2bf(gelu_tanh(y));
            }
      });
    }
  }
}

DI void glu_phase(const Params& p, int j, char* smem) {
  const int tid = opqv(threadIdx.x), lane = tid & 63, w = tid >> 6, wm = w >> 2, wn = w & 3, l32 = lane & 31, hf = lane >> 5;
  char* ws = opq(p.ws);
  const u16* yt = (const u16*)(ws + OFF_YT);
  const u16* Wt = (const u16*)(ws + OFF_W_GLU) + (size_t)j * 512 * LDGLU;
  u16* o = (u16*)(ws + OFF_UO);
  const float* gb = p.s5_glu_b + j * 512;
  const int nN = 2;
  for (int lt = blockIdx.x >> 3; lt < 16 * nN; lt += gridDim.x >> 3) {
    int mt, nt; tile_map(lt, 16, nN, 16, 2, mt, nt);
    const int m0 = mt * 256, n0 = nt * 256;
    gemm_tile(yt + (size_t)m0 * LDYT, LDYT, 8, nullptr, 0, 0, Wt + (size_t)n0 * LDGLU, LDGLU, smem, [&](f32x16(&acc)[2][2], int moff) {
      const int m0_ = m0 + moff;
      int l32_ = l32, hf_ = hf; asm volatile("" : "+v"(l32_), "+v"(hf_));
#pragma unroll
      for (int i = 0; i < 2; ++i)
#pragma unroll
        for (int jn = 0; jn < 2; ++jn)
#pragma unroll
          for (int r = 0; r < 16; ++r) {
            const int row = m0_ + wm * 64 + i * 32 + crow(r, hf_), col = n0 + wn * 64 + jn * 32 + l32_;
            const float gt = acc[i][jn][r] + gb[col];
            const float y = bf2f(yt[(size_t)row * LDYT + col]);
            o[(size_t)row * LDH + 512 + col] = f2bf(y / (1.f + __expf(-gt)));
          }
    });
  }
}

DI void run_phase(const Params& p, int ph, char* smem, int rep) {
  char* ws = opq(p.ws);
  if (ph == 0) { phase0(p, smem); return; }
  if (ph == 1) { phase1(p); return; }
  const int q = ph - 2, pair = q / 18, r = q % 18;
  const bool odd = r >= 8;
  const int k = odd ? r - 8 : r;
  const int l = pair * 2 + (odd ? 1 : 0), j = pair;
  int op = 2, pm = 0, ls = 0;
  if (!odd) {
    if (k == 3) { op = 0; pm = 0; } else if (k == 5) { op = 0; pm = 1; } else if (k == 6) { op = 0; pm = 2; }
    else if (k == 4) { op = 1; ls = 2 * l; } else if (k == 7) { op = 1; ls = 2 * l + 1; }
  } else {
    if (k == 5) { op = 0; pm = 0; } else if (k == 7) { op = 0; pm = 1; } else if (k == 8) { op = 0; pm = 2; }
    else if (k == 6) { op = 1; ls = 2 * l; } else if (k == 9) { op = 1; ls = 2 * l + 1; }
  }
  if (op == 0) {
    const u16* A; const u16* W; u16* C; int K, N, mode, lda, ldb, ldc;
    if (pm == 0) {
      A = (const u16*)(ws + (odd ? OFF_UO : OFF_OE)); lda = LDH;
      W = (const u16*)(ws + (odd ? OFF_W_RECOUT : OFF_W_ATTOUT)) + (size_t)j * 1024 * LDW1; ldb = LDW1;
      C = (u16*)(ws + OFF_HY); ldc = LDH; K = 1024; N = 1024; mode = 0;
    } else if (pm == 1) {
      A = (const u16*)(ws + OFF_HY); lda = LDH; W = (const u16*)(ws + OFF_W1) + (size_t)l * 4096 * LDW1; ldb = LDW1;
      C = (u16*)(ws + OFF_HID); ldc = LDHID; K = 1024; N = 4096; mode = 1;
    } else {
      A = (const u16*)(ws + OFF_HID); lda = LDHID; W = (const u16*)(ws + OFF_W2) + (size_t)l * 1024 * LDW2; ldb = LDW2;
      C = (u16*)(ws + OFF_HY); ldc = LDH; K = 4096; N = 1024; mode = 0;
    }
#ifdef PROBE_VARIANT
    if (rep) gemm_plain<PROBE_VARIANT>(A, lda, K, W, ldb, N, C, ldc, mode, smem); else
#endif
    gemm_plain<0>(A, lda, K, W, ldb, N, C, ldc, mode, smem);
  } else if (op == 1) {
    ln_phase(p, ls);
  } else if (!odd) {
    if (k == 0) att_in_phase(p, j, smem);
    else if (k == 1) qkv_phase(p, j, smem);
    else attn_phase(p, j, j + 4 * rep, smem);
  } else {
    if (k == 0) { rec_in_phase(p, j, smem); s5_fill(p, j); }
    else if (k == 1) rec_state_phase(p, j, smem);
    else if (k == 2) scan_phase(p, j, smem);
    else if (k == 3) rec_out_phase(p, j, smem);
    else glu_phase(p, j, smem);
  }
}

__global__ void __launch_bounds__(512, 2) mega_kernel(Params p, int ph0, int ph1) {
  extern __shared__ __attribute__((aligned(16))) char smem[];
  cg::grid_group grid = cg::this_grid();
  __shared__ uint4 xb_words;
  if (threadIdx.x == 0) xb_words = make_uint4(0u, 0u, 0u, 0u);
  __syncthreads();
  XcdBarrier xb = xcd_barrier_post((unsigned*)(p.ws + OFF_BAR), (volatile LAS unsigned*)&xb_words);
  for (int ph = ph0; ph < ph1; ++ph) {
    run_phase(p, ph, smem, 0);
#ifdef PROBE_MASK
    if (ph >= 2 && ((PROBE_MASK >> ((ph - 2) % 18)) & 1)) { xcd_barrier(xb); run_phase(p, ph, smem, 1); }
#endif
    if (ph + 1 < ph1) { if (ph == ph0) grid.sync(); else xcd_barrier(xb); }
  }
}

__global__ void fail_fill(float* out, int n) {
  int i = blockIdx.x * 256 + threadIdx.x;
  if (i < n) out[i] = 0.f;
}

extern "C" void kernel_launch(void* const* d_in, const int* in_sizes, int n_in, void* d_out, int out_size, void* d_ws,
                              size_t ws_size, hipStream_t stream) {
  Params p{};
  const float** fp = (const float**)&p;
  for (int i = 0; i < 27; ++i) fp[i] = (const float*)d_in[i];
  p.out = (float*)d_out;
  p.ws = (char*)d_ws;
  if (ws_size < WS_NEED) {
    fail_fill<<<(out_size + 255) / 256, 256, 0, stream>>>((float*)d_out, out_size);
    return;
  }
  static int grid_blocks = 0;
  if (!grid_blocks) {
    hipFuncSetAttribute((const void*)mega_kernel, hipFuncAttributeMaxDynamicSharedMemorySize, SMEM_BYTES);
    int dev = 0, cus = 0, per_cu = 0;
    hipGetDevice(&dev);
    hipDeviceGetAttribute(&cus, hipDeviceAttributeMultiprocessorCount, dev);
    hipOccupancyMaxActiveBlocksPerMultiprocessor(&per_cu, mega_kernel, NTHR, SMEM_BYTES);
    if (per_cu > 1) per_cu = 1;
    if (per_cu < 1) per_cu = 1;
    grid_blocks = cus * per_cu;
  }
  (void)hipMemsetAsync((char*)d_ws + OFF_BAR, 0, XCD_BAR_WORDS * 4, stream);
  int ph0 = 0, ph1 = NPHASE;
  void* args[] = {&p, &ph0, &ph1};
  hipError_t e = hipLaunchCooperativeKernel((void*)mega_kernel, dim3(grid_blocks), dim3(NTHR), args, SMEM_BYTES, stream);
  if (e != hipSuccess) fprintf(stderr, "cooperative launch failed: %s (grid %d)\n", hipGetErrorString(e), grid_blocks);
}
static_assert(WS_NEED <= (size_t)536870912, "workspace budget exceeded");
```
